# Optimizing an MI355X kernel written in HIP

```python
import jax, jax.numpy as jnp
from jax import lax
import numpy as np

D_MODEL = 2048
BATCH = 4
SEQ = 2048
DEPTH = 1
DEC_BATCH = 128
DEC_SEQ = 8
PAST_LEN = 16384
PAGE_SIZE = 128

N_META = 16
D_CONV = D_MODEL
CONV_W = 3
D_POOL = D_MODEL // 2
POOL_WINDOWS = (2, 4, 8, 16)
N_POOL_GROUPS = len(POOL_WINDOWS)
POOL_GROUP = D_POOL // N_POOL_GROUPS
POOL_OUT_GROUP = D_MODEL // N_POOL_GROUPS
MAX_WIN = max(POOL_WINDOWS)
D_FF = ((8 * D_MODEL // 3 + 255) // 256) * 256
D_IN = 3 * D_CONV + D_POOL + 2 * D_MODEL
SPLITS = (D_CONV, 2 * D_CONV, 3 * D_CONV, 3 * D_CONV + D_POOL, 3 * D_CONV + D_POOL + D_MODEL)
EPS = 1e-6

kernel_name = "gated_conv_pool_macaron_decoder_step"


def _rmsnorm(x, g):
    xf = x.astype(jnp.float32)
    r = lax.rsqrt(jnp.mean(xf * xf, axis=-1, keepdims=True) + EPS)
    return (xf * r).astype(x.dtype) * g


def _swiglu(x, wg, wu, wd):
    return (jax.nn.silu(x @ wg) * (x @ wu)) @ wd


def _short_conv(z, buf, w):
    L = z.shape[1]
    zp = jnp.concatenate([buf.astype(z.dtype), z], axis=1)
    y = w[0] * zp[:, 0:L]
    for k in range(1, CONV_W):
        y = y + w[k] * zp[:, k:k + L]
    return y, zp[:, -(CONV_W - 1):]


def _multiscale_pool(z, buf, pos):
    L = z.shape[1]
    P = MAX_WIN - 1
    zp = jnp.concatenate([buf.astype(z.dtype), z], axis=1)
    cs = jnp.cumsum(zp.astype(jnp.float32), axis=1)
    cs = jnp.concatenate([jnp.zeros_like(cs[:, :1]), cs], axis=1)
    outs = []
    for g, k in enumerate(POOL_WINDOWS):
        c0, c1 = g * POOL_GROUP, (g + 1) * POOL_GROUP
        s = cs[:, P + 1:P + 1 + L, c0:c1] - cs[:, P + 1 - k:P + 1 - k + L, c0:c1]
        cnt = jnp.minimum(k, pos + 1).astype(jnp.float32)[None, :, None]
        outs.append(s / cnt - z[:, :, c0:c1].astype(jnp.float32))
    pooled = jnp.stack(outs, axis=2).astype(z.dtype)
    return pooled, zp[:, -P:]


def _layer(x, conv_buf, pool_buf, pos, norm_ffn1, w1g, w1u, w1d, norm_mix, w_in, conv_w,
           w_conv_out, w_pool_group, pool_scale, w_o, norm_ffn2, w2g, w2u, w2d):
    b, L, _ = x.shape
    h = x + 0.5 * _swiglu(_rmsnorm(x, norm_ffn1), w1g, w1u, w1d)
    u = _rmsnorm(h, norm_mix)
    proj = u @ w_in
    b_gate, c_gate, v, z_pool, g_conv, g_pool = jnp.split(proj, SPLITS, axis=-1)
    conv_y, conv_state = _short_conv(c_gate * v, conv_buf, conv_w)
    y_conv = (b_gate * conv_y) @ w_conv_out
    pooled, pool_state = _multiscale_pool(z_pool, pool_buf, pos)
    y_pool = jnp.einsum('blgc,gcd->blgd', pooled, w_pool_group).reshape(b, L, D_MODEL) * pool_scale
    merged = jax.nn.sigmoid(g_conv) * y_conv + jax.nn.sigmoid(g_pool) * y_pool
    h = h + merged @ w_o
    h = h + 0.5 * _swiglu(_rmsnorm(h, norm_ffn2), w2g, w2u, w2d)
    return h, conv_state, pool_state


def setup_inputs(seed: int = 0) -> dict:
    key = jax.random.key(seed)
    ks = jax.random.split(key, 24)
    f32 = jnp.float32

    def nrm(k, shape, fan_in):
        return jax.random.normal(k, shape, f32) * (fan_in ** -0.5)

    def gain(k, shape):
        return 1.0 + 0.02 * jax.random.normal(k, shape, f32)

    return {
        "x_prompt": jax.random.normal(ks[0], (BATCH, SEQ, D_MODEL), f32),
        "x_sample": jax.random.normal(ks[1], (DEC_BATCH, DEC_SEQ, D_MODEL), f32),
        "state_conv": jax.random.normal(ks[2], (DEPTH, DEC_BATCH, CONV_W - 1, D_CONV), f32),
        "state_pool": jax.random.normal(ks[3], (DEPTH, DEC_BATCH, MAX_WIN - 1, D_POOL), f32),
        "meta_tokens": jax.random.normal(ks[4], (N_META, D_MODEL), f32),
        "norm_ffn1": gain(ks[5], (DEPTH, D_MODEL)),
        "w_ffn1_gate": nrm(ks[6], (DEPTH, D_MODEL, D_FF), D_MODEL),
        "w_ffn1_up": nrm(ks[7], (DEPTH, D_MODEL, D_FF), D_MODEL),
        "w_ffn1_down": nrm(ks[8], (DEPTH, D_FF, D_MODEL), D_FF),
        "norm_mix": gain(ks[9], (DEPTH, D_MODEL)),
        "w_in": nrm(ks[10], (DEPTH, D_MODEL, D_IN), D_MODEL),
        "conv_w": nrm(ks[11], (DEPTH, CONV_W, D_CONV), CONV_W),
        "w_conv_out": nrm(ks[12], (DEPTH, D_CONV, D_MODEL), D_CONV),
        "w_pool_group": nrm(ks[13], (DEPTH, N_POOL_GROUPS, POOL_GROUP, POOL_OUT_GROUP), POOL_GROUP),
        "pool_scale": gain(ks[14], (DEPTH, D_MODEL)),
        "w_o": nrm(ks[15], (DEPTH, D_MODEL, D_MODEL), D_MODEL),
        "norm_ffn2": gain(ks[16], (DEPTH, D_MODEL)),
        "w_ffn2_gate": nrm(ks[17], (DEPTH, D_MODEL, D_FF), D_MODEL),
        "w_ffn2_up": nrm(ks[18], (DEPTH, D_MODEL, D_FF), D_MODEL),
        "w_ffn2_down": nrm(ks[19], (DEPTH, D_FF, D_MODEL), D_FF),
        "norm_final": gain(ks[20], (D_MODEL,)),
    }


def reference(x_prompt, x_sample, state_conv, state_pool, meta_tokens, norm_ffn1, w_ffn1_gate,
              w_ffn1_up, w_ffn1_down, norm_mix, w_in, conv_w, w_conv_out, w_pool_group,
              pool_scale, w_o, norm_ffn2, w_ffn2_gate, w_ffn2_up, w_ffn2_down, norm_final):
    meta = jnp.broadcast_to(meta_tokens.astype(x_prompt.dtype)[None], (BATCH, N_META, D_MODEL))
    hp = jnp.concatenate([meta, x_prompt], axis=1)
    pos_p = jnp.arange(N_META + SEQ, dtype=jnp.int32)
    pos_s = PAST_LEN + jnp.arange(DEC_SEQ, dtype=jnp.int32)
    hs = x_sample
    conv_p, pool_p, conv_s, pool_s = [], [], [], []
    for l in range(DEPTH):
        lw = (norm_ffn1[l], w_ffn1_gate[l], w_ffn1_up[l], w_ffn1_down[l], norm_mix[l], w_in[l],
              conv_w[l], w_conv_out[l], w_pool_group[l], pool_scale[l], w_o[l], norm_ffn2[l],
              w_ffn2_gate[l], w_ffn2_up[l], w_ffn2_down[l])
        zbuf_c = jnp.zeros((BATCH, CONV_W - 1, D_CONV), hp.dtype)
        zbuf_p = jnp.zeros((BATCH, MAX_WIN - 1, D_POOL), hp.dtype)
        hp, cp, pp = _layer(hp, zbuf_c, zbuf_p, pos_p, *lw)
        hs, cs_, ps_ = _layer(hs, state_conv[l], state_pool[l], pos_s, *lw)
        conv_p.append(cp)
        pool_p.append(pp)
        conv_s.append(cs_)
        pool_s.append(ps_)
    y_prompt = _rmsnorm(hp[:, N_META:], norm_final)
    y_sample = _rmsnorm(hs, norm_final)
    new_conv_prompt = jnp.stack(conv_p, axis=0)
    new_pool_prompt = jnp.stack(pool_p, axis=0)
    new_conv_sample = jnp.stack(conv_s, axis=0)
    new_pool_sample = jnp.stack(pool_s, axis=0)
    return (y_prompt, y_sample, new_conv_prompt, new_pool_prompt, new_conv_sample, new_pool_sample)
```

```cpp
#include <hip/hip_runtime.h>
#include <hip/hip_cooperative_groups.h>
#include <cstdio>
#include <cstdint>
namespace cg = cooperative_groups;

namespace pg8 {
#define PG8_LAS __attribute__((address_space(3)))
typedef unsigned short bf16_t;
typedef short bf16x8 __attribute__((ext_vector_type(8)));
typedef float f32x4 __attribute__((ext_vector_type(4)));
typedef unsigned u32x4 __attribute__((ext_vector_type(4)));
constexpr int BM = 256, BK = 64, HALF = 128, HTB = HALF * BK * 2  , STAGE_BYTES = 8 * HTB, NXCD = 8, WGM = 8;

__host__ __device__ __forceinline__ int lds_byte(int r, int c) { const int st = (r >> 4) * 2 + (c >> 5), rr = r & 15, cc = c & 31, ob = rr * 64 + cc * 2; return st * 1024 + (ob ^ (((ob >> 9) & 1) << 5)); }
__host__ __device__ __forceinline__ void stage_rc(int b, int& R, int& C) { const int st = b / 1024, sb = b % 1024, swz = sb ^ (((sb >> 9) & 1) << 5); R = (st >> 1) * 16 + swz / 64; C = (st & 1) * 32 + (swz % 64) / 2; }
__host__ __device__ __forceinline__ int perm32(int rho) { const int n = rho >> 4, i = rho & 15; return 8 * (i >> 2) + 4 * n + (i & 3); }

struct Unit { int pm, pn; };
struct Gemm { const bf16_t* A; const bf16_t* Bt; int M, N, K, lda, ldb, agrp; };
__device__ __forceinline__ size_t acolb(const Gemm& g, const Unit& u) { return g.agrp ? (size_t)((u.pn >> 1) * 256) * 2 : (size_t)0; }

struct StaticOrder {
    int nM, nN, nwg, G, c;
    __host__ __device__ void init(int M, int N, int G_, int c_) { nM = M / BM; nN = N / BM; nwg = nM * nN; G = G_; c = c_; }
    __host__ __device__ bool next(int i, Unit& u) const {
        const long L = (long)i * G + c; if (L >= nwg) return false;
        int wgid = (int)L; { const int q = nwg / NXCD, r = nwg % NXCD, xcd = wgid % NXCD, off = wgid / NXCD; wgid = (xcd < r ? xcd * (q + 1) : r * (q + 1) + (xcd - r) * q) + off; }
        const int nig = WGM * nN, gid = wgid / nig, fm = gid * WGM, gsz = (nM - fm) < WGM ? (nM - fm) : WGM;
        u.pm = fm + ((wgid % nig) % gsz); u.pn = (wgid % nig) / gsz; return true;
    }
    __device__ __forceinline__ void a_ready(const Unit&) const {}
    __device__ __forceinline__ void done(const Unit&) const {}
};

__device__ __forceinline__ unsigned cvt_pk_bf16(float lo, float hi) { unsigned r; asm volatile("v_cvt_pk_bf16_f32 %0, %1, %2" : "=v"(r) : "v"(lo), "v"(hi)); return r; }
__device__ __forceinline__ float bf_lo(unsigned w) { return __uint_as_float(w << 16); }
__device__ __forceinline__ float bf_hi(unsigned w) { return __uint_as_float(w & 0xffff0000u); }
__device__ __forceinline__ float sigmoidf_(float x) { return __builtin_amdgcn_rcpf(1.0f + __builtin_amdgcn_exp2f(-1.4426950408889634f * x)); }
__device__ __forceinline__ u32x4 pack8(const f32x4& a, const f32x4& b) { u32x4 w; w.x = cvt_pk_bf16(a[0], a[1]); w.y = cvt_pk_bf16(a[2], a[3]); w.z = cvt_pk_bf16(b[0], b[1]); w.w = cvt_pk_bf16(b[2], b[3]); return w; }
__device__ __forceinline__ void unpack8(const u32x4& w, f32x4& a, f32x4& b) { a = (f32x4){bf_lo(w.x), bf_hi(w.x), bf_lo(w.y), bf_hi(w.y)}; b = (f32x4){bf_lo(w.z), bf_hi(w.z), bf_lo(w.w), bf_hi(w.w)}; }

struct EpiSwiglu {
    static constexpr bool PERM = true, AFTER_DRAIN = false;
    bf16_t* O; int ldc;
    __device__ __forceinline__ void operator()(const f32x4 (&acc)[2][2][4][2], const Unit& u, int wr, int wc, int fr, int fq) const {
        const int row0 = u.pm * BM + wr * 64 + fr, col0 = u.pn * HALF + wc * 32 + 8 * fq;
#pragma unroll
        for (int ai = 0; ai < 2; ++ai)
#pragma unroll
            for (int m = 0; m < 4; ++m) {
                f32x4 v[2];
#pragma unroll
                for (int n = 0; n < 2; ++n) { const f32x4 gt = acc[ai][0][m][n], up = acc[ai][1][m][n];
#pragma unroll
                    for (int e = 0; e < 4; ++e) v[n][e] = gt[e] * sigmoidf_(gt[e]) * up[e]; }
                *(u32x4*)(O + (size_t)(row0 + ai * HALF + m * 16) * ldc + col0) = pack8(v[0], v[1]);
            }
    }
};
struct EpiResid {
    static constexpr bool PERM = false, AFTER_DRAIN = false;
    float* H; int ldc; float s;
    __device__ __forceinline__ void operator()(const f32x4 (&acc)[2][2][4][2], const Unit& u, int wr, int wc, int fr, int fq) const {
        const int row0 = u.pm * BM + wr * 64 + fr, col0 = u.pn * BM + wc * 32 + 4 * fq;
#pragma unroll
        for (int ai = 0; ai < 2; ++ai)
#pragma unroll
            for (int m = 0; m < 4; ++m) { float* rowp = H + (size_t)(row0 + ai * HALF + m * 16) * ldc + col0;
#pragma unroll
                for (int bj = 0; bj < 2; ++bj)
#pragma unroll
                    for (int n = 0; n < 2; ++n) { f32x4* p = (f32x4*)(rowp + bj * HALF + n * 16); const f32x4 h = *p; *p = h + acc[ai][bj][m][n] * s; }
                if (m & 1) asm volatile("" ::: "memory"); }
    }
};
struct EpiProj {
    static constexpr bool PERM = true, AFTER_DRAIN = false;
    bf16_t *BG, *CV, *Z, *SGC, *SGP;
    __device__ __forceinline__ void operator()(const f32x4 (&acc)[2][2][4][2], const Unit& u, int wr, int wc, int fr, int fq) const {
        const int row0 = u.pm * BM + wr * 64 + fr, pn = u.pn;
        if (pn >= 8 && pn < 24) {
            const int col0 = (pn - 8) * HALF + wc * 32 + 8 * fq;
#pragma unroll
            for (int ai = 0; ai < 2; ++ai)
#pragma unroll
                for (int m = 0; m < 4; ++m)
                    *(u32x4*)(CV + (size_t)(row0 + ai * HALF + m * 16) * 2048 + col0) = pack8(acc[ai][0][m][0] * acc[ai][1][m][0], acc[ai][0][m][1] * acc[ai][1][m][1]);
        } else {
            bf16_t* base; int ld, ct; bool sg;
            if (pn < 8) { base = BG; ld = 2048; ct = pn; sg = false; }
            else if (pn < 28) { base = Z; ld = 1024; ct = pn - 24; sg = false; }
            else if (pn < 36) { base = SGC; ld = 2048; ct = pn - 28; sg = true; }
            else { base = SGP; ld = 2048; ct = pn - 36; sg = true; }
            const int col0 = ct * BM + wc * 32 + 8 * fq;
#pragma unroll
            for (int ai = 0; ai < 2; ++ai)
#pragma unroll
                for (int m = 0; m < 4; ++m) { bf16_t* rowp = base + (size_t)(row0 + ai * HALF + m * 16) * ld + col0;
#pragma unroll
                    for (int bj = 0; bj < 2; ++bj) { f32x4 v0 = acc[ai][bj][m][0], v1 = acc[ai][bj][m][1];
                        if (sg) {
#pragma unroll
                            for (int e = 0; e < 4; ++e) { v0[e] = sigmoidf_(v0[e]); v1[e] = sigmoidf_(v1[e]); } }
                        *(u32x4*)(rowp + bj * HALF) = pack8(v0, v1); } }
        }
    }
};
struct EpiPool {
    static constexpr bool PERM = true, AFTER_DRAIN = false;
    bf16_t* SGP; const float* ps;
    __device__ __forceinline__ void operator()(const f32x4 (&acc)[2][2][4][2], const Unit& u, int wr, int wc, int fr, int fq) const {
        const int row0 = u.pm * BM + wr * 64 + fr, col0 = u.pn * BM + wc * 32 + 8 * fq;
#pragma unroll
        for (int ai = 0; ai < 2; ++ai)
#pragma unroll
            for (int m = 0; m < 4; ++m) { bf16_t* rowp = SGP + (size_t)(row0 + ai * HALF + m * 16) * 2048 + col0;
#pragma unroll
                for (int bj = 0; bj < 2; ++bj) { u32x4* p = (u32x4*)(rowp + bj * HALF); f32x4 g0, g1; unpack8(*p, g0, g1);
                    const f32x4 s0 = *(const f32x4*)(ps + col0 + bj * HALF), s1 = *(const f32x4*)(ps + col0 + bj * HALF + 4);
                    *p = pack8(g0 * s0 * acc[ai][bj][m][0], g1 * s1 * acc[ai][bj][m][1]); }
                asm volatile("" ::: "memory"); }
    }
};
struct EpiMerge {
    static constexpr bool PERM = true, AFTER_DRAIN = false;
    bf16_t* SGC; const bf16_t* MP;
    __device__ __forceinline__ void operator()(const f32x4 (&acc)[2][2][4][2], const Unit& u, int wr, int wc, int fr, int fq) const {
        const int row0 = u.pm * BM + wr * 64 + fr, col0 = u.pn * BM + wc * 32 + 8 * fq;
#pragma unroll
        for (int ai = 0; ai < 2; ++ai)
#pragma unroll
            for (int m = 0; m < 4; ++m) { const size_t off = (size_t)(row0 + ai * HALF + m * 16) * 2048 + col0;
#pragma unroll
                for (int bj = 0; bj < 2; ++bj) { u32x4* p = (u32x4*)(SGC + off + bj * HALF); f32x4 g0, g1, q0, q1; unpack8(*p, g0, g1); unpack8(*(const u32x4*)(MP + off + bj * HALF), q0, q1);
                    *p = pack8(g0 * acc[ai][bj][m][0] + q0, g1 * acc[ai][bj][m][1] + q1); }
                if (m & 1) asm volatile("" ::: "memory"); }
    }
};

template <class Epi, class Sched, bool ALIGN_EPI = false, bool SP2 = false>
__device__ __forceinline__ void gemm_phase(PG8_LAS unsigned char* lds, const Gemm g, const Sched& S, const Epi& E) {
    int tid_ = threadIdx.x; asm volatile("" : "+v"(tid_));
    const int tid = tid_, wid = __builtin_amdgcn_readfirstlane(tid >> 6), lane = tid & 63, wr = wid >> 2, wc = wid & 3, fr = lane & 15, fq = lane >> 4;
    const int K = g.K, nt = K / BK;
    unsigned voffA[2], voffB[2];
#pragma unroll
    for (int i = 0; i < 2; ++i) { int R, C; stage_rc(tid * 16 + i * 8192, R, C); const int Rb = Epi::PERM ? ((R & ~31) + perm32(R & 31)) : R;
        voffA[i] = (unsigned)(R * g.lda + C) * 2u; voffB[i] = (unsigned)(Rb * g.ldb + C) * 2u; }
    const size_t kstep = (size_t)(BK * 2);
    const size_t hstepA = (size_t)HALF * g.lda * 2, hstepB = (size_t)HALF * g.ldb * 2;
    const size_t tstepA = 2 * hstepA, tstepB = 2 * hstepB;
    const unsigned ldsw = (unsigned)wid * 1024u;
    const int aoff = lds_byte(wr * 64 + fr, fq * 8), boff = lds_byte(wc * 32 + fr, fq * 8);
#define PG8_SA(b, h) (((b) * 2 + (h)) * HTB)
#define PG8_SB(b, h) ((4 + (b) * 2 + (h)) * HTB)
#define PG8_STAGE(bufoff, gbase, voff) do { _Pragma("unroll") for (int _i = 0; _i < 2; ++_i) \
        __builtin_amdgcn_global_load_lds((const unsigned*)((const char*)(gbase) + (voff)[_i]), (PG8_LAS unsigned*)(lds + (bufoff) + ldsw + _i * 8192), 16, 0, 0); } while (0)
#define PG8_LDA(dst, b, h) do { _Pragma("unroll") for (int m = 0; m < 4; ++m) _Pragma("unroll") for (int k = 0; k < 2; ++k) dst[m][k] = *(const PG8_LAS bf16x8*)(lds + PG8_SA(b, h) + aoff + m * 2048 + k * 1024); } while (0)
#define PG8_LDB(dst, b, h) do { _Pragma("unroll") for (int n = 0; n < 2; ++n) _Pragma("unroll") for (int k = 0; k < 2; ++k) dst[n][k] = *(const PG8_LAS bf16x8*)(lds + PG8_SB(b, h) + boff + n * 2048 + k * 1024); } while (0)
#define PG8_MMA(ai, bj, At, Bt) do { __builtin_amdgcn_s_setprio(1); _Pragma("unroll") for (int m = 0; m < 4; ++m) _Pragma("unroll") for (int n = 0; n < 2; ++n) _Pragma("unroll") for (int k = 0; k < 2; ++k) \
        acc[ai][bj][m][n] = __builtin_amdgcn_mfma_f32_16x16x32_bf16(Bt[n][k], At[m][k], acc[ai][bj][m][n], 0, 0, 0); __builtin_amdgcn_s_setprio(0); } while (0)
#define PG8_WAIT_V(n) asm volatile("s_waitcnt vmcnt(" #n ")" ::: "memory")
#define PG8_WAIT_L(n) asm volatile("s_waitcnt lgkmcnt(" #n ")" ::: "memory")
#define PG8_BAR __builtin_amdgcn_s_barrier()
#define PG8_SCHED __builtin_amdgcn_sched_barrier(0)
    Unit cur, nxt; int ui = 0;
    if (!S.next(0, cur)) return;
    f32x4 acc[2][2][4][2];
#pragma unroll
    for (int a = 0; a < 2; ++a)
#pragma unroll
        for (int b = 0; b < 2; ++b)
#pragma unroll
            for (int m = 0; m < 4; ++m)
#pragma unroll
                for (int n = 0; n < 2; ++n) acc[a][b][m][n] = (f32x4){0.f, 0.f, 0.f, 0.f};
    bf16x8 At[4][2], B0[2][2], B1[2][2];
    const char* cA = (const char*)g.A + (size_t)cur.pm * tstepA + acolb(g, cur); const char* cB = (const char*)g.Bt + (size_t)cur.pn * tstepB;
    S.a_ready(cur);
    if constexpr (SP2) {
        PG8_STAGE(PG8_SB(0, 0), cB, voffB); PG8_STAGE(PG8_SB(0, 1), cB + hstepB, voffB); PG8_STAGE(PG8_SA(0, 0), cA, voffA); PG8_STAGE(PG8_SA(0, 1), cA + hstepA, voffA);
        if (wr == 1) PG8_BAR;
        PG8_WAIT_V(2); PG8_BAR;
        PG8_STAGE(PG8_SB(1, 0), cB + kstep, voffB); PG8_STAGE(PG8_SA(1, 0), cA + kstep, voffA); PG8_STAGE(PG8_SB(1, 1), cB + hstepB + kstep, voffB);
        PG8_WAIT_V(6); PG8_BAR;
    } else {
        PG8_STAGE(PG8_SB(0, 0), cB, voffB); PG8_STAGE(PG8_SA(0, 0), cA, voffA); PG8_STAGE(PG8_SB(0, 1), cB + hstepB, voffB); PG8_STAGE(PG8_SA(0, 1), cA + hstepA, voffA);
        if (wr == 1) PG8_BAR;
        PG8_WAIT_V(4); PG8_BAR;
        PG8_STAGE(PG8_SB(1, 0), cB + kstep, voffB); PG8_STAGE(PG8_SA(1, 0), cA + kstep, voffA); PG8_STAGE(PG8_SB(1, 1), cB + hstepB + kstep, voffB);
        PG8_WAIT_V(6); PG8_BAR;
    }
    for (;;) {
        const bool has_next = S.next(ui + 1, nxt);
        const char* nA = has_next ? (const char*)g.A + (size_t)nxt.pm * tstepA + acolb(g, nxt) : cA; const char* nB = has_next ? (const char*)g.Bt + (size_t)nxt.pn * tstepB : cB;
        for (int t = 0; t < nt; t += 2) {
            const bool last = (t == nt - 2);
            const char* a1 = cA + (size_t)(t + 1) * kstep;
            const char* a2 = last ? nA : cA + (size_t)(t + 2) * kstep; const char* b2 = last ? nB : cB + (size_t)(t + 2) * kstep;
            const char* a3 = a2 + kstep; const char* b3 = b2 + kstep;
            if (last && has_next) S.a_ready(nxt);
            if constexpr (SP2) {
            PG8_LDB(B0, 0, 0); PG8_LDB(B1, 0, 1); PG8_SCHED; PG8_LDA(At, 0, 0); PG8_STAGE(PG8_SA(1, 1), a1 + hstepA, voffA);
            PG8_WAIT_V(8); PG8_WAIT_L(0); PG8_BAR; PG8_MMA(0, 0, At, B0); PG8_MMA(0, 1, At, B1); PG8_BAR; PG8_SCHED;
            PG8_LDA(At, 0, 1); PG8_STAGE(PG8_SB(0, 0), b2, voffB); PG8_STAGE(PG8_SB(0, 1), b2 + hstepB, voffB); PG8_STAGE(PG8_SA(0, 0), a2, voffA);
            PG8_WAIT_V(8); PG8_WAIT_L(0); PG8_BAR; PG8_MMA(1, 0, At, B0); PG8_MMA(1, 1, At, B1); PG8_BAR; PG8_SCHED;
            PG8_LDB(B0, 1, 0); PG8_LDB(B1, 1, 1); PG8_SCHED; PG8_LDA(At, 1, 0); PG8_STAGE(PG8_SA(0, 1), a2 + hstepA, voffA);
            PG8_WAIT_V(8); PG8_WAIT_L(0); PG8_BAR; PG8_MMA(0, 0, At, B0); PG8_MMA(0, 1, At, B1); PG8_BAR; PG8_SCHED;
            PG8_LDA(At, 1, 1); PG8_STAGE(PG8_SB(1, 0), b3, voffB); PG8_STAGE(PG8_SB(1, 1), b3 + hstepB, voffB); PG8_STAGE(PG8_SA(1, 0), a3, voffA);
            PG8_WAIT_V(8); PG8_WAIT_L(0); PG8_BAR; PG8_MMA(1, 0, At, B0); PG8_MMA(1, 1, At, B1); PG8_BAR; PG8_SCHED;
            } else {
            PG8_LDB(B0, 0, 0); PG8_SCHED; PG8_LDA(At, 0, 0); PG8_STAGE(PG8_SA(1, 1), a1 + hstepA, voffA);
            PG8_WAIT_L(8); PG8_BAR; PG8_WAIT_L(0); PG8_MMA(0, 0, At, B0); PG8_BAR; PG8_SCHED;
            PG8_LDB(B1, 0, 1); PG8_STAGE(PG8_SB(0, 0), b2, voffB);
            PG8_BAR; PG8_WAIT_L(0); PG8_MMA(0, 1, At, B1); PG8_BAR;
            PG8_LDA(At, 0, 1); PG8_STAGE(PG8_SA(0, 0), a2, voffA);
            PG8_BAR; PG8_WAIT_L(0); PG8_MMA(1, 0, At, B0); PG8_BAR; PG8_SCHED;
            PG8_STAGE(PG8_SB(0, 1), b2 + hstepB, voffB);
            PG8_WAIT_V(6); PG8_BAR; PG8_MMA(1, 1, At, B1); PG8_BAR;
            PG8_LDB(B0, 1, 0); PG8_SCHED; PG8_LDA(At, 1, 0); PG8_STAGE(PG8_SA(0, 1), a2 + hstepA, voffA);
            PG8_WAIT_L(8); PG8_BAR; PG8_WAIT_L(0); PG8_MMA(0, 0, At, B0); PG8_BAR; PG8_SCHED;
            PG8_LDB(B1, 1, 1); PG8_STAGE(PG8_SB(1, 0), b3, voffB);
            PG8_BAR; PG8_WAIT_L(0); PG8_MMA(0, 1, At, B1); PG8_BAR;
            PG8_LDA(At, 1, 1); PG8_STAGE(PG8_SA(1, 0), a3, voffA);
            PG8_BAR; PG8_WAIT_L(0); PG8_MMA(1, 0, At, B0); PG8_BAR; PG8_SCHED;
            PG8_STAGE(PG8_SB(1, 1), b3 + hstepB, voffB);
            PG8_WAIT_V(6); PG8_BAR; PG8_MMA(1, 1, At, B1); PG8_BAR;
            }
        }
        if constexpr (ALIGN_EPI) { if (wr == 0) PG8_BAR; }
        if constexpr (!Epi::AFTER_DRAIN) { E(acc, cur, wr, wc, fr, fq); S.done(cur); }
        if (!has_next) break;
#pragma unroll
        for (int a = 0; a < 2; ++a)
#pragma unroll
            for (int b = 0; b < 2; ++b)
#pragma unroll
                for (int m = 0; m < 4; ++m)
#pragma unroll
                    for (int n = 0; n < 2; ++n) acc[a][b][m][n] = (f32x4){0.f, 0.f, 0.f, 0.f};
        cur = nxt; cA = nA; cB = nB; ++ui;
        if constexpr (ALIGN_EPI) { if (wr == 1) PG8_BAR; }
    }
    PG8_WAIT_V(0);
    if constexpr (!ALIGN_EPI) { if (wr == 0) PG8_BAR; }
    PG8_BAR;
    if constexpr (Epi::AFTER_DRAIN) { E.fused(acc, cur, wr, wc, fr, fq, lds, wid, lane); S.done(cur); }
#undef PG8_SA
#undef PG8_SB
#undef PG8_STAGE
#undef PG8_LDA
#undef PG8_LDB
#undef PG8_MMA
#undef PG8_WAIT_V
#undef PG8_WAIT_L
#undef PG8_BAR
#undef PG8_SCHED
}
}

constexpr int DM = 2048, NB = 4, SEQ = 2048, NMETA = 16, LP = SEQ + NMETA  , DECB = 128, DECS = 8;
constexpr int DFF = 5632, DPOOL = 1024, DIN = 11264;
constexpr int MP_ROWS = NB * LP;
constexpr int MS_ROWS = DECB * DECS;
constexpr int MREAL = MP_ROWS + MS_ROWS;
constexpr int MPAD = 9472;
constexpr float EPS = 1e-6f;
constexpr int NWAVES = 8;

constexpr size_t O_YP = 0, O_YS = O_YP + (size_t)NB * SEQ * DM, O_NCP = O_YS + (size_t)MS_ROWS * DM, O_NPP = O_NCP + (size_t)NB * 2 * DM,
                 O_NCS = O_NPP + (size_t)NB * 15 * DPOOL, O_NPS = O_NCS + (size_t)DECB * 2 * DM, O_END = O_NPS + (size_t)DECB * 15 * DPOOL;

constexpr size_t MiB = 1u << 20;
constexpr size_t WS_W1GU = 1 * MiB;
constexpr size_t WS_W1D = WS_W1GU + 44 * MiB;
constexpr size_t WS_WIN = WS_W1D + 22 * MiB;
constexpr size_t WS_WCO = WS_WIN + 44 * MiB;
constexpr size_t WS_WPG = WS_WCO + 8 * MiB;
constexpr size_t WS_WO = WS_WPG + 1 * MiB;
constexpr size_t WS_W2GU = WS_WO + 8 * MiB;
constexpr size_t WS_W2D = WS_W2GU + 44 * MiB;
constexpr size_t WS_H = WS_W2D + 22 * MiB;
constexpr size_t WS_R = WS_H + 74 * MiB;
constexpr size_t WS_BG = WS_R, WS_CV = WS_R + 37 * MiB, WS_SGC = WS_R + 74 * MiB, WS_SGP = WS_R + 111 * MiB, WS_Z = WS_R + 148 * MiB, WS_PL = WS_Z + 19 * MiB;
constexpr size_t WS_XN1 = WS_SGP;
constexpr size_t WS_END = WS_PL + 19 * MiB;
static_assert((size_t)MPAD * DFF * 2 <= 111 * MiB, "ACT fits below XN1");

#define GAS __attribute__((address_space(1)))
#define LAS __attribute__((address_space(3)))
typedef unsigned short bf16;
typedef unsigned v4u __attribute__((ext_vector_type(4)));
typedef float f32x4 __attribute__((ext_vector_type(4)));
#define LDS_WAIT() asm volatile("s_waitcnt lgkmcnt(0)" ::: "memory")
constexpr int LDS_BYTES = 147456;

struct Args {
    const float *x_prompt, *x_sample, *state_conv, *state_pool, *meta, *norm_ffn1, *w1g, *w1u, *w1d, *norm_mix, *w_in, *conv_w, *w_conv_out, *w_pool, *pool_scale, *w_o, *norm_ffn2, *w2g, *w2u, *w2d, *norm_final;
    float* out; unsigned char* ws;
};

__device__ __forceinline__ unsigned pk2(float lo, float hi) { return pg8::cvt_pk_bf16(lo, hi); }
__device__ __forceinline__ float wave_sum(float v) {
#pragma unroll
    for (int o = 1; o < 64; o <<= 1) v += __shfl_xor(v, o);
    return v;
}
__device__ __forceinline__ const float* src_row(const Args& a, int r) {
    if (r < MP_ROWS) { const int b = r / LP, t = r - b * LP; return t < NMETA ? a.meta + (size_t)t * DM : a.x_prompt + ((size_t)b * SEQ + (t - NMETA)) * DM; }
    if (r < MREAL) return a.x_sample + (size_t)(r - MP_ROWS) * DM;
    return nullptr;
}
__device__ __forceinline__ void p0_transpose_item(const float* W, int N, bf16* WT, int K, int k0, int n0, int drow0, LAS float* scr, int lane) {
    const int lr = lane >> 4, lc = (lane & 15) * 4;
    f32x4 v[16];
#pragma unroll
    for (int i = 0; i < 16; ++i) v[i] = *(const f32x4*)(W + (size_t)(k0 + 4 * i + lr) * N + n0 + lc);
#pragma unroll
    for (int i = 0; i < 16; ++i) { LAS float* s = scr + (4 * i + lr) * 65 + lc; s[0] = v[i].x; s[1] = v[i].y; s[2] = v[i].z; s[3] = v[i].w; }
    LDS_WAIT(); asm volatile("" ::: "memory");
    const int c = lane & 7;
#pragma unroll
    for (int j = 0; j < 8; ++j) { const int n = (lane >> 3) + 8 * j; const LAS float* s = scr + (8 * c) * 65 + n;
        v4u o; o.x = pk2(s[0 * 65], s[1 * 65]); o.y = pk2(s[2 * 65], s[3 * 65]); o.z = pk2(s[4 * 65], s[5 * 65]); o.w = pk2(s[6 * 65], s[7 * 65]);
        *(v4u*)(WT + (size_t)(drow0 + n) * K + k0 + 8 * c) = o; }
    LDS_WAIT(); asm volatile("" ::: "memory");
}
__device__ __forceinline__ bool p0_job(int& r, const float* W, int K, int N, bf16* WT, int kind, int roff, LAS float* scr, int lane) {
    const int nb = N / 64, items = (K / 64) * nb;
    if (r >= items) { r -= items; return false; }
    const int kb = r / nb, n0 = (r % nb) * 64;
    int d;
    if (kind == 0) d = roff + n0;
    else if (kind == 1) d = (n0 >> 7) * 256 + (n0 & 127);
    else if (kind == 2) d = (n0 >> 7) * 256 + 128 + (n0 & 127);
    else { if (n0 < 2048 || n0 >= 6144) d = n0; else if (n0 < 4096) { const int j = n0 - 2048; d = 2048 + (j >> 7) * 256 + (j & 127); } else { const int j = n0 - 4096; d = 2048 + (j >> 7) * 256 + 128 + (j & 127); } }
    p0_transpose_item(W, N, WT, K, kb * 64, n0, d, scr, lane);
    return true;
}
__device__ __forceinline__ void rms_row_bf16(const float* xrow, const float* g, bf16* orow, float* hcopy, int lane) {
    f32x4 v[8]; float s = 0.f;
    if (xrow) {
#pragma unroll
        for (int j = 0; j < 8; ++j) { v[j] = ((const f32x4*)xrow)[lane + 64 * j]; s += (v[j].x * v[j].x + v[j].y * v[j].y) + (v[j].z * v[j].z + v[j].w * v[j].w); }
    } else {
#pragma unroll
        for (int j = 0; j < 8; ++j) v[j] = (f32x4){0.f, 0.f, 0.f, 0.f};
    }
    const float r = 1.0f / sqrtf(wave_sum(s) * (1.0f / DM) + EPS);
#pragma unroll
    for (int j = 0; j < 8; ++j) {
        if (hcopy) ((f32x4*)hcopy)[lane + 64 * j] = v[j];
        const f32x4 gg = ((const f32x4*)g)[lane + 64 * j];
        const unsigned lo = pk2(v[j].x * r * gg.x, v[j].y * r * gg.y), hi = pk2(v[j].z * r * gg.z, v[j].w * r * gg.w);
        ((unsigned long long*)orow)[lane + 64 * j] = (unsigned long long)lo | ((unsigned long long)hi << 32);
    }
}
__device__ __forceinline__ void load8_bf16(const bf16* p, float (&o)[8]) { const v4u w = *(const v4u*)p; o[0] = pg8::bf_lo(w.x); o[1] = pg8::bf_hi(w.x); o[2] = pg8::bf_lo(w.y); o[3] = pg8::bf_hi(w.y); o[4] = pg8::bf_lo(w.z); o[5] = pg8::bf_hi(w.z); o[6] = pg8::bf_lo(w.w); o[7] = pg8::bf_hi(w.w); }
__device__ __forceinline__ void load8_f32(const float* p, float (&o)[8]) { const f32x4 a = ((const f32x4*)p)[0], b = ((const f32x4*)p)[1]; o[0] = a.x; o[1] = a.y; o[2] = a.z; o[3] = a.w; o[4] = b.x; o[5] = b.y; o[6] = b.z; o[7] = b.w; }
__device__ __forceinline__ void store8_f32(float* p, const float (&o)[8]) { ((f32x4*)p)[0] = (f32x4){o[0], o[1], o[2], o[3]}; ((f32x4*)p)[1] = (f32x4){o[4], o[5], o[6], o[7]}; }

__global__ void __launch_bounds__(NWAVES * 64) fwd_megakernel(Args a) {
    extern __shared__ __attribute__((aligned(16))) unsigned char lds_raw[];
    cg::grid_group grid = cg::this_grid();
    LAS unsigned char* lds = (LAS unsigned char*)lds_raw;
    const int tid = threadIdx.x, lane = tid & 63, wave = __builtin_amdgcn_readfirstlane(tid >> 6);
    const int G = gridDim.x, bx = blockIdx.x;
    const int gw = bx * NWAVES + wave, NGW = G * NWAVES;
    unsigned char* ws = a.ws;
    bf16 *W1GU = (bf16*)(ws + WS_W1GU), *W1D = (bf16*)(ws + WS_W1D), *WIN = (bf16*)(ws + WS_WIN), *WCO = (bf16*)(ws + WS_WCO), *WPG = (bf16*)(ws + WS_WPG), *WO = (bf16*)(ws + WS_WO),
         *W2GU = (bf16*)(ws + WS_W2GU), *W2D = (bf16*)(ws + WS_W2D);
    float* H = (float*)(ws + WS_H);
    bf16 *ACT = (bf16*)(ws + WS_R), *BG = (bf16*)(ws + WS_BG), *CV = (bf16*)(ws + WS_CV), *SGC = (bf16*)(ws + WS_SGC), *SGP = (bf16*)(ws + WS_SGP), *Z = (bf16*)(ws + WS_Z), *PL = (bf16*)(ws + WS_PL);
    bf16 *XN1 = (bf16*)(ws + WS_XN1), *XN = (bf16*)(ws + WS_W1GU);

    {
        LAS float* scr = (LAS float*)(lds + wave * 16640);
        constexpr int IT_GU = (DM / 64) * (DFF / 64), IT_D = (DFF / 64) * (DM / 64), IT_IN = (DM / 64) * (DIN / 64), IT_SQ = (DM / 64) * (DM / 64), IT_PG = (256 / 64) * (512 / 64);
        constexpr int NITEMS = 4 * IT_GU + 2 * IT_D + IT_IN + 2 * IT_SQ + 4 * IT_PG;
        for (int it = gw; it < NITEMS; it += NGW) {
            int r = it;
            if (p0_job(r, a.w1g, DM, DFF, W1GU, 1, 0, scr, lane)) continue;
            if (p0_job(r, a.w1u, DM, DFF, W1GU, 2, 0, scr, lane)) continue;
            if (p0_job(r, a.w1d, DFF, DM, W1D, 0, 0, scr, lane)) continue;
            if (p0_job(r, a.w_in, DM, DIN, WIN, 3, 0, scr, lane)) continue;
            if (p0_job(r, a.w_conv_out, DM, DM, WCO, 0, 0, scr, lane)) continue;
            if (p0_job(r, a.w_o, DM, DM, WO, 0, 0, scr, lane)) continue;
            if (p0_job(r, a.w2g, DM, DFF, W2GU, 1, 0, scr, lane)) continue;
            if (p0_job(r, a.w2u, DM, DFF, W2GU, 2, 0, scr, lane)) continue;
            if (p0_job(r, a.w2d, DFF, DM, W2D, 0, 0, scr, lane)) continue;
            if (p0_job(r, a.w_pool + 0 * 256 * 512, 256, 512, WPG, 0, 0, scr, lane)) continue;
            if (p0_job(r, a.w_pool + 1 * 256 * 512, 256, 512, WPG, 0, 512, scr, lane)) continue;
            if (p0_job(r, a.w_pool + 2 * 256 * 512, 256, 512, WPG, 0, 1024, scr, lane)) continue;
            p0_job(r, a.w_pool + 3 * 256 * 512, 256, 512, WPG, 0, 1536, scr, lane);
        }
        for (int m = gw; m < MPAD; m += NGW) rms_row_bf16(src_row(a, m), a.norm_ffn1, XN1 + (size_t)m * DM, H + (size_t)m * DM, lane);
    }
    grid.sync();

    {
        pg8::Gemm g{XN1, W1GU, MPAD, 2 * DFF, DM, DM, DM, 0}; pg8::StaticOrder S; S.init(MPAD, 2 * DFF, G, bx);
        pg8::EpiSwiglu E{ACT, DFF};
        pg8::gemm_phase<pg8::EpiSwiglu, pg8::StaticOrder, true, true>(lds, g, S, E);
    }
    grid.sync();
    {
        pg8::Gemm g{ACT, W1D, MPAD, DM, DFF, DFF, DFF, 0}; pg8::StaticOrder S; S.init(MPAD, DM, G, bx);
        pg8::EpiResid E{H, DM, 0.5f};
        pg8::gemm_phase<pg8::EpiResid, pg8::StaticOrder, true, true>(lds, g, S, E);
    }
    grid.sync();
    for (int m = gw; m < MPAD; m += NGW) rms_row_bf16(H + (size_t)m * DM, a.norm_mix, XN + (size_t)m * DM, nullptr, lane);
    grid.sync();
    {
        pg8::Gemm g{XN, WIN, MPAD, DIN, DM, DM, DM, 0}; pg8::StaticOrder S; S.init(MPAD, DIN, G, bx);
        pg8::EpiProj E{BG, CV, Z, SGC, SGP};
        pg8::gemm_phase<pg8::EpiProj, pg8::StaticOrder, true, true>(lds, g, S, E);
    }
    grid.sync();
    for (int m = gw; m < MREAL; m += NGW) {
        const bool smp = m >= MP_ROWS;
        int sq, t, L;
        if (smp) { sq = (m - MP_ROWS) >> 3; t = (m - MP_ROWS) & 7; L = DECS; } else { sq = m / LP; t = m - sq * LP; L = LP; }
        const float* sc = a.state_conv + (size_t)sq * 2 * DM;
        const float* sp = a.state_pool + (size_t)sq * 15 * DPOOL;
        float* ncv = (t >= L - 2) ? (smp ? a.out + O_NCS + ((size_t)sq * 2 + (t - (L - 2))) * DM : a.out + O_NCP + ((size_t)sq * 2 + (t - (L - 2))) * DM) : nullptr;
#pragma unroll 1
        for (int j = 0; j < 4; ++j) {
            const int col = 512 * j + 8 * lane;
            float c0[8], c1[8], c2[8], bg[8], w0[8], w1[8], w2[8], o[8];
            load8_bf16(CV + (size_t)m * DM + col, c2);
            if (t >= 1) load8_bf16(CV + (size_t)(m - 1) * DM + col, c1); else if (smp) load8_f32(sc + (size_t)1 * DM + col, c1); else {
#pragma unroll
                for (int e = 0; e < 8; ++e) c1[e] = 0.f; }
            if (t >= 2) load8_bf16(CV + (size_t)(m - 2) * DM + col, c0); else if (smp) load8_f32(sc + (size_t)t * DM + col, c0); else {
#pragma unroll
                for (int e = 0; e < 8; ++e) c0[e] = 0.f; }
            load8_bf16(BG + (size_t)m * DM + col, bg);
            load8_f32(a.conv_w + col, w0); load8_f32(a.conv_w + DM + col, w1); load8_f32(a.conv_w + 2 * DM + col, w2);
#pragma unroll
            for (int e = 0; e < 8; ++e) o[e] = bg[e] * (w0[e] * c0[e] + w1[e] * c1[e] + w2[e] * c2[e]);
            v4u w; w.x = pk2(o[0], o[1]); w.y = pk2(o[2], o[3]); w.z = pk2(o[4], o[5]); w.w = pk2(o[6], o[7]);
            *(v4u*)(BG + (size_t)m * DM + col) = w;
            if (ncv) store8_f32(ncv + col, c2);
        }
        float* npp = nullptr;
        if (smp) npp = a.out + O_NPS + ((size_t)sq * 15 + 7 + t) * DPOOL; else if (t >= L - 15) npp = a.out + O_NPP + ((size_t)sq * 15 + (t - (L - 15))) * DPOOL;
#pragma unroll 1
        for (int j = 0; j < 2; ++j) {
            const int col = 512 * j + 8 * lane, gq = col >> 8, k = 2 << gq, kmax = j ? 16 : 4;
            float z0[8], s[8], zi[8];
            load8_bf16(Z + (size_t)m * DPOOL + col, z0);
#pragma unroll
            for (int e = 0; e < 8; ++e) s[e] = z0[e];
#pragma unroll 1
            for (int i = 1; i < kmax; ++i) {
                if (t - i >= 0) load8_bf16(Z + (size_t)(m - i) * DPOOL + col, zi);
                else if (smp) load8_f32(sp + (size_t)(15 + t - i) * DPOOL + col, zi);
                else break;
                if (i < k) {
#pragma unroll
                    for (int e = 0; e < 8; ++e) s[e] += zi[e]; }
            }
            const int cnt = smp ? k : (k < t + 1 ? k : t + 1);
            const float inv = 1.0f / (float)cnt;
            float o[8];
#pragma unroll
            for (int e = 0; e < 8; ++e) o[e] = s[e] * inv - z0[e];
            v4u w; w.x = pk2(o[0], o[1]); w.y = pk2(o[2], o[3]); w.z = pk2(o[4], o[5]); w.w = pk2(o[6], o[7]);
            *(v4u*)(PL + (size_t)m * DPOOL + col) = w;
            if (npp) store8_f32(npp + col, z0);
            if (smp && t < 7) { float q[8]; load8_f32(sp + (size_t)(8 + t) * DPOOL + col, q); store8_f32(a.out + O_NPS + ((size_t)sq * 15 + t) * DPOOL + col, q); }
        }
    }
    grid.sync();
    {
        pg8::Gemm g{PL, WPG, MPAD, DM, 256, DPOOL, 256, 1}; pg8::StaticOrder S; S.init(MPAD, DM, G, bx);
        pg8::EpiPool E{SGP, a.pool_scale};
        pg8::gemm_phase<pg8::EpiPool, pg8::StaticOrder, true, true>(lds, g, S, E);
    }
    __syncthreads();
    {
        pg8::Gemm g{BG, WCO, MPAD, DM, DM, DM, DM, 0}; pg8::StaticOrder S; S.init(MPAD, DM, G, bx);
        pg8::EpiMerge E{SGC, SGP};
        pg8::gemm_phase<pg8::EpiMerge, pg8::StaticOrder, true, true>(lds, g, S, E);
    }
    grid.sync();
    {
        pg8::Gemm g{SGC, WO, MPAD, DM, DM, DM, DM, 0}; pg8::StaticOrder S; S.init(MPAD, DM, G, bx);
        pg8::EpiResid E{H, DM, 1.0f};
        pg8::gemm_phase<pg8::EpiResid, pg8::StaticOrder, true, true>(lds, g, S, E);
    }
    grid.sync();
    for (int m = gw; m < MPAD; m += NGW) rms_row_bf16(H + (size_t)m * DM, a.norm_ffn2, XN + (size_t)m * DM, nullptr, lane);
    grid.sync();
    {
        pg8::Gemm g{XN, W2GU, MPAD, 2 * DFF, DM, DM, DM, 0}; pg8::StaticOrder S; S.init(MPAD, 2 * DFF, G, bx);
        pg8::EpiSwiglu E{ACT, DFF};
        pg8::gemm_phase<pg8::EpiSwiglu, pg8::StaticOrder, true, true>(lds, g, S, E);
    }
    grid.sync();
    {
        pg8::Gemm g{ACT, W2D, MPAD, DM, DFF, DFF, DFF, 0}; pg8::StaticOrder S; S.init(MPAD, DM, G, bx);
        pg8::EpiResid E{H, DM, 0.5f};
        pg8::gemm_phase<pg8::EpiResid, pg8::StaticOrder, true, true>(lds, g, S, E);
    }
    grid.sync();
    for (int m = gw; m < MREAL; m += NGW) {
        float* dst;
        if (m < MP_ROWS) { const int b = m / LP, t = m - b * LP; if (t < NMETA) continue; dst = a.out + O_YP + ((size_t)b * SEQ + (t - NMETA)) * DM; }
        else dst = a.out + O_YS + (size_t)(m - MP_ROWS) * DM;
        const float* hr = H + (size_t)m * DM;
        f32x4 v[8]; float s = 0.f;
#pragma unroll
        for (int j = 0; j < 8; ++j) { v[j] = ((const f32x4*)hr)[lane + 64 * j]; s += (v[j].x * v[j].x + v[j].y * v[j].y) + (v[j].z * v[j].z + v[j].w * v[j].w); }
        const float r = 1.0f / sqrtf(wave_sum(s) * (1.0f / DM) + EPS);
#pragma unroll
        for (int j = 0; j < 8; ++j) { const f32x4 gg = ((const f32x4*)a.norm_final)[lane + 64 * j]; ((f32x4*)dst)[lane + 64 * j] = v[j] * r * gg; }
    }
}

extern "C" void kernel_launch(void* const* d_in, const int* in_sizes, int n_in, void* d_out, int out_size, void* d_ws, size_t ws_size, hipStream_t stream) {
    static int grid = 0;
    if (grid == 0) {
        if (n_in != 21 || (size_t)out_size != O_END || ws_size < WS_END) { fprintf(stderr, "kernel_launch: unexpected shapes: n_in %d out %d ws %zu (need %zu)\n", n_in, out_size, ws_size, (size_t)WS_END); grid = -1; return; }
        int dev = 0, cus = 0, per_cu = 0;
        hipGetDevice(&dev); hipDeviceGetAttribute(&cus, hipDeviceAttributeMultiprocessorCount, dev);
        if (hipFuncSetAttribute((const void*)fwd_megakernel, hipFuncAttributeMaxDynamicSharedMemorySize, LDS_BYTES) != hipSuccess) { fprintf(stderr, "kernel_launch: hipFuncSetAttribute failed\n"); grid = -1; return; }
        if (hipOccupancyMaxActiveBlocksPerMultiprocessor(&per_cu, (const void*)fwd_megakernel, NWAVES * 64, LDS_BYTES) != hipSuccess || per_cu < 1) { fprintf(stderr, "kernel_launch: occupancy query failed (%d)\n", per_cu); (void)hipGetLastError(); per_cu = 1; }
        grid = cus * 1;
        fprintf(stderr, "kernel_launch: grid %d (cus %d, per_cu %d)\n", grid, cus, per_cu);
    }
    if (grid < 0) return;
    Args a{};
    a.x_prompt = (const float*)d_in[0]; a.x_sample = (const float*)d_in[1]; a.state_conv = (const float*)d_in[2]; a.state_pool = (const float*)d_in[3]; a.meta = (const float*)d_in[4];
    a.norm_ffn1 = (const float*)d_in[5]; a.w1g = (const float*)d_in[6]; a.w1u = (const float*)d_in[7]; a.w1d = (const float*)d_in[8]; a.norm_mix = (const float*)d_in[9]; a.w_in = (const float*)d_in[10];
    a.conv_w = (const float*)d_in[11]; a.w_conv_out = (const float*)d_in[12]; a.w_pool = (const float*)d_in[13]; a.pool_scale = (const float*)d_in[14]; a.w_o = (const float*)d_in[15];
    a.norm_ffn2 = (const float*)d_in[16]; a.w2g = (const float*)d_in[17]; a.w2u = (const float*)d_in[18]; a.w2d = (const float*)d_in[19]; a.norm_final = (const float*)d_in[20];
    a.out = (float*)d_out; a.ws = (unsigned char*)d_ws;
    void* args[] = {&a};
    hipError_t e = hipLaunchCooperativeKernel((const void*)fwd_megakernel, dim3(grid), dim3(NWAVES * 64), args, LDS_BYTES, stream);
    if (e != hipSuccess) fprintf(stderr, "kernel_launch: cooperative launch failed: %s (grid %d)\n", hipGetErrorString(e), grid);
}
```

```cpp
#include <hip/hip_runtime.h>
#include <hip/hip_cooperative_groups.h>
#include <cstdio>
#include <cstdint>
namespace cg = cooperative_groups;

namespace pg8 {
#define PG8_LAS __attribute__((address_space(3)))
typedef unsigned short bf16_t;
typedef short bf16x8 __attribute__((ext_vector_type(8)));
typedef float f32x4 __attribute__((ext_vector_type(4)));
typedef unsigned u32x4 __attribute__((ext_vector_type(4)));
constexpr int BM = 256, BK = 64, HALF = 128, HTB = HALF * BK * 2  , STAGE_BYTES = 8 * HTB, NXCD = 8, WGM = 8;

__host__ __device__ __forceinline__ int lds_byte(int r, int c) { const int st = (r >> 4) * 2 + (c >> 5), rr = r & 15, cc = c & 31, ob = rr * 64 + cc * 2; return st * 1024 + (ob ^ (((ob >> 9) & 1) << 5)); }
__host__ __device__ __forceinline__ void stage_rc(int b, int& R, int& C) { const int st = b / 1024, sb = b % 1024, swz = sb ^ (((sb >> 9) & 1) << 5); R = (st >> 1) * 16 + swz / 64; C = (st & 1) * 32 + (swz % 64) / 2; }
__host__ __device__ __forceinline__ int perm32(int rho) { const int n = rho >> 4, i = rho & 15; return 8 * (i >> 2) + 4 * n + (i & 3); }

struct Unit { int pm, pn; };
struct Gemm { const bf16_t* A; const bf16_t* Bt; int M, N, K, lda, ldb, agrp; };
__device__ __forceinline__ size_t acolb(const Gemm& g, const Unit& u) { return g.agrp ? (size_t)((u.pn >> 1) * 256) * 2 : (size_t)0; }

struct StaticOrder {
    int nM, nN, nwg, G, c;
    __host__ __device__ void init(int M, int N, int G_, int c_) { nM = M / BM; nN = N / BM; nwg = nM * nN; G = G_; c = c_; }
    __host__ __device__ bool next(int i, Unit& u) const {
        const long L = (long)i * G + c; if (L >= nwg) return false;
        int wgid = (int)L; { const int q = nwg / NXCD, r = nwg % NXCD, xcd = wgid % NXCD, off = wgid / NXCD; wgid = (xcd < r ? xcd * (q + 1) : r * (q + 1) + (xcd - r) * q) + off; }
        const int nig = WGM * nN, gid = wgid / nig, fm = gid * WGM, gsz = (nM - fm) < WGM ? (nM - fm) : WGM;
        u.pm = fm + ((wgid % nig) % gsz); u.pn = (wgid % nig) / gsz; return true;
    }
    __device__ __forceinline__ void a_ready(const Unit&) const {}
    __device__ __forceinline__ void done(const Unit&) const {}
};

__device__ __forceinline__ unsigned cvt_pk_bf16(float lo, float hi) { unsigned r; asm volatile("v_cvt_pk_bf16_f32 %0, %1, %2" : "=v"(r) : "v"(lo), "v"(hi)); return r; }
__device__ __forceinline__ float bf_lo(unsigned w) { return __uint_as_float(w << 16); }
__device__ __forceinline__ float bf_hi(unsigned w) { return __uint_as_float(w & 0xffff0000u); }
__device__ __forceinline__ float sigmoidf_(float x) { return __builtin_amdgcn_rcpf(1.0f + __builtin_amdgcn_exp2f(-1.4426950408889634f * x)); }
__device__ __forceinline__ u32x4 pack8(const f32x4& a, const f32x4& b) { u32x4 w; w.x = cvt_pk_bf16(a[0], a[1]); w.y = cvt_pk_bf16(a[2], a[3]); w.z = cvt_pk_bf16(b[0], b[1]); w.w = cvt_pk_bf16(b[2], b[3]); return w; }
__device__ __forceinline__ void unpack8(const u32x4& w, f32x4& a, f32x4& b) { a = (f32x4){bf_lo(w.x), bf_hi(w.x), bf_lo(w.y), bf_hi(w.y)}; b = (f32x4){bf_lo(w.z), bf_hi(w.z), bf_lo(w.w), bf_hi(w.w)}; }

struct EpiSwiglu {
    static constexpr bool PERM = true, AFTER_DRAIN = false;
    bf16_t* O; int ldc;
    __device__ __forceinline__ void operator()(const f32x4 (&acc)[2][2][4][2], const Unit& u, int wr, int wc, int fr, int fq) const {
        const int row0 = u.pm * BM + wr * 64 + fr, col0 = u.pn * HALF + wc * 32 + 8 * fq;
#pragma unroll
        for (int ai = 0; ai < 2; ++ai)
#pragma unroll
            for (int m = 0; m < 4; ++m) {
                f32x4 v[2];
#pragma unroll
                for (int n = 0; n < 2; ++n) { const f32x4 gt = acc[ai][0][m][n], up = acc[ai][1][m][n];
#pragma unroll
                    for (int e = 0; e < 4; ++e) v[n][e] = gt[e] * sigmoidf_(gt[e]) * up[e]; }
                *(u32x4*)(O + (size_t)(row0 + ai * HALF + m * 16) * ldc + col0) = pack8(v[0], v[1]);
            }
    }
};
struct EpiResid {
    static constexpr bool PERM = false, AFTER_DRAIN = false;
    float* H; int ldc; float s;
    __device__ __forceinline__ void operator()(const f32x4 (&acc)[2][2][4][2], const Unit& u, int wr, int wc, int fr, int fq) const {
        const int row0 = u.pm * BM + wr * 64 + fr, col0 = u.pn * BM + wc * 32 + 4 * fq;
#pragma unroll
        for (int ai = 0; ai < 2; ++ai)
#pragma unroll
            for (int m = 0; m < 4; ++m) { float* rowp = H + (size_t)(row0 + ai * HALF + m * 16) * ldc + col0;
#pragma unroll
                for (int bj = 0; bj < 2; ++bj)
#pragma unroll
                    for (int n = 0; n < 2; ++n) { f32x4* p = (f32x4*)(rowp + bj * HALF + n * 16); const f32x4 h = *p; *p = h + acc[ai][bj][m][n] * s; }
                if (m & 1) asm volatile("" ::: "memory"); }
    }
};
struct EpiProj {
    static constexpr bool PERM = true, AFTER_DRAIN = false;
    bf16_t *BG, *CV, *Z, *SGC, *SGP;
    __device__ __forceinline__ void operator()(const f32x4 (&acc)[2][2][4][2], const Unit& u, int wr, int wc, int fr, int fq) const {
        const int row0 = u.pm * BM + wr * 64 + fr, pn = u.pn;
        if (pn >= 8 && pn < 24) {
            const int col0 = (pn - 8) * HALF + wc * 32 + 8 * fq;
#pragma unroll
            for (int ai = 0; ai < 2; ++ai)
#pragma unroll
                for (int m = 0; m < 4; ++m)
                    *(u32x4*)(CV + (size_t)(row0 + ai * HALF + m * 16) * 2048 + col0) = pack8(acc[ai][0][m][0] * acc[ai][1][m][0], acc[ai][0][m][1] * acc[ai][1][m][1]);
        } else {
            bf16_t* base; int ld, ct; bool sg;
            if (pn < 8) { base = BG; ld = 2048; ct = pn; sg = false; }
            else if (pn < 28) { base = Z; ld = 1024; ct = pn - 24; sg = false; }
            else if (pn < 36) { base = SGC; ld = 2048; ct = pn - 28; sg = true; }
            else { base = SGP; ld = 2048; ct = pn - 36; sg = true; }
            const int col0 = ct * BM + wc * 32 + 8 * fq;
#pragma unroll
            for (int ai = 0; ai < 2; ++ai)
#pragma unroll
                for (int m = 0; m < 4; ++m) { bf16_t* rowp = base + (size_t)(row0 + ai * HALF + m * 16) * ld + col0;
#pragma unroll
                    for (int bj = 0; bj < 2; ++bj) { f32x4 v0 = acc[ai][bj][m][0], v1 = acc[ai][bj][m][1];
                        if (sg) {
#pragma unroll
                            for (int e = 0; e < 4; ++e) { v0[e] = sigmoidf_(v0[e]); v1[e] = sigmoidf_(v1[e]); } }
                        *(u32x4*)(rowp + bj * HALF) = pack8(v0, v1); } }
        }
    }
};
struct EpiPool {
    static constexpr bool PERM = true, AFTER_DRAIN = false;
    bf16_t* SGP; const float* ps;
    __device__ __forceinline__ void operator()(const f32x4 (&acc)[2][2][4][2], const Unit& u, int wr, int wc, int fr, int fq) const {
        const int row0 = u.pm * BM + wr * 64 + fr, col0 = u.pn * BM + wc * 32 + 8 * fq;
#pragma unroll
        for (int ai = 0; ai < 2; ++ai)
#pragma unroll
            for (int m = 0; m < 4; ++m) { bf16_t* rowp = SGP + (size_t)(row0 + ai * HALF + m * 16) * 2048 + col0;
#pragma unroll
                for (int bj = 0; bj < 2; ++bj) { u32x4* p = (u32x4*)(rowp + bj * HALF); f32x4 g0, g1; unpack8(*p, g0, g1);
                    const f32x4 s0 = *(const f32x4*)(ps + col0 + bj * HALF), s1 = *(const f32x4*)(ps + col0 + bj * HALF + 4);
                    *p = pack8(g0 * s0 * acc[ai][bj][m][0], g1 * s1 * acc[ai][bj][m][1]); }
                asm volatile("" ::: "memory"); }
    }
};
struct EpiMerge {
    static constexpr bool PERM = true, AFTER_DRAIN = false;
    bf16_t* SGC; const bf16_t* MP;
    __device__ __forceinline__ void operator()(const f32x4 (&acc)[2][2][4][2], const Unit& u, int wr, int wc, int fr, int fq) const {
        const int row0 = u.pm * BM + wr * 64 + fr, col0 = u.pn * BM + wc * 32 + 8 * fq;
#pragma unroll
        for (int ai = 0; ai < 2; ++ai)
#pragma unroll
            for (int m = 0; m < 4; ++m) { const size_t off = (size_t)(row0 + ai * HALF + m * 16) * 2048 + col0;
#pragma unroll
                for (int bj = 0; bj < 2; ++bj) { u32x4* p = (u32x4*)(SGC + off + bj * HALF); f32x4 g0, g1, q0, q1; unpack8(*p, g0, g1); unpack8(*(const u32x4*)(MP + off + bj * HALF), q0, q1);
                    *p = pack8(g0 * acc[ai][bj][m][0] + q0, g1 * acc[ai][bj][m][1] + q1); }
                if (m & 1) asm volatile("" ::: "memory"); }
    }
};

template <class Epi, class Sched, bool ALIGN_EPI = false, bool SP2 = false>
__device__ __forceinline__ void gemm_phase(PG8_LAS unsigned char* lds, const Gemm g, const Sched& S, const Epi& E) {
    int tid_ = threadIdx.x; asm volatile("" : "+v"(tid_));
    const int tid = tid_, wid = __builtin_amdgcn_readfirstlane(tid >> 6), lane = tid & 63, wr = wid >> 2, wc = wid & 3, fr = lane & 15, fq = lane >> 4;
    const int K = g.K, nt = K / BK;
    unsigned voffA[2], voffB[2];
#pragma unroll
    for (int i = 0; i < 2; ++i) { int R, C; stage_rc(tid * 16 + i * 8192, R, C); const int Rb = Epi::PERM ? ((R & ~31) + perm32(R & 31)) : R;
        voffA[i] = (unsigned)(R * g.lda + C) * 2u; voffB[i] = (unsigned)(Rb * g.ldb + C) * 2u; }
    const size_t kstep = (size_t)(BK * 2);
    const size_t hstepA = (size_t)HALF * g.lda * 2, hstepB = (size_t)HALF * g.ldb * 2;
    const size_t tstepA = 2 * hstepA, tstepB = 2 * hstepB;
    const unsigned ldsw = (unsigned)wid * 1024u;
    const int aoff = lds_byte(wr * 64 + fr, fq * 8), boff = lds_byte(wc * 32 + fr, fq * 8);
#define PG8_SA(b, h) (((b) * 2 + (h)) * HTB)
#define PG8_SB(b, h) ((4 + (b) * 2 + (h)) * HTB)
#define PG8_STAGE(bufoff, gbase, voff) do { _Pragma("unroll") for (int _i = 0; _i < 2; ++_i) \
        __builtin_amdgcn_global_load_lds((const unsigned*)((const char*)(gbase) + (voff)[_i]), (PG8_LAS unsigned*)(lds + (bufoff) + ldsw + _i * 8192), 16, 0, 0); } while (0)
#define PG8_LDA(dst, b, h) do { _Pragma("unroll") for (int m = 0; m < 4; ++m) _Pragma("unroll") for (int k = 0; k < 2; ++k) dst[m][k] = *(const PG8_LAS bf16x8*)(lds + PG8_SA(b, h) + aoff + m * 2048 + k * 1024); } while (0)
#define PG8_LDB(dst, b, h) do { _Pragma("unroll") for (int n = 0; n < 2; ++n) _Pragma("unroll") for (int k = 0; k < 2; ++k) dst[n][k] = *(const PG8_LAS bf16x8*)(lds + PG8_SB(b, h) + boff + n * 2048 + k * 1024); } while (0)
#define PG8_MMA(ai, bj, At, Bt) do { __builtin_amdgcn_s_setprio(1); _Pragma("unroll") for (int m = 0; m < 4; ++m) _Pragma("unroll") for (int n = 0; n < 2; ++n) _Pragma("unroll") for (int k = 0; k < 2; ++k) \
        acc[ai][bj][m][n] = __builtin_amdgcn_mfma_f32_16x16x32_bf16(Bt[n][k], At[m][k], acc[ai][bj][m][n], 0, 0, 0); __builtin_amdgcn_s_setprio(0); } while (0)
#define PG8_WAIT_V(n) asm volatile("s_waitcnt vmcnt(" #n ")" ::: "memory")
#define PG8_WAIT_L(n) asm volatile("s_waitcnt lgkmcnt(" #n ")" ::: "memory")
#define PG8_BAR __builtin_amdgcn_s_barrier()
#define PG8_SCHED __builtin_amdgcn_sched_barrier(0)
    Unit cur, nxt; int ui = 0;
    if (!S.next(0, cur)) return;
    f32x4 acc[2][2][4][2];
#pragma unroll
    for (int a = 0; a < 2; ++a)
#pragma unroll
        for (int b = 0; b < 2; ++b)
#pragma unroll
            for (int m = 0; m < 4; ++m)
#pragma unroll
                for (int n = 0; n < 2; ++n) acc[a][b][m][n] = (f32x4){0.f, 0.f, 0.f, 0.f};
    bf16x8 At[4][2], B0[2][2], B1[2][2];
    const char* cA = (const char*)g.A + (size_t)cur.pm * tstepA + acolb(g, cur); const char* cB = (const char*)g.Bt + (size_t)cur.pn * tstepB;
    S.a_ready(cur);
    if constexpr (SP2) {
        PG8_STAGE(PG8_SB(0, 0), cB, voffB); PG8_STAGE(PG8_SB(0, 1), cB + hstepB, voffB); PG8_STAGE(PG8_SA(0, 0), cA, voffA); PG8_STAGE(PG8_SA(0, 1), cA + hstepA, voffA);
        if (wr == 1) PG8_BAR;
        PG8_WAIT_V(2); PG8_BAR;
        PG8_STAGE(PG8_SB(1, 0), cB + kstep, voffB); PG8_STAGE(PG8_SA(1, 0), cA + kstep, voffA); PG8_STAGE(PG8_SB(1, 1), cB + hstepB + kstep, voffB);
        PG8_WAIT_V(6); PG8_BAR;
    } else {
        PG8_STAGE(PG8_SB(0, 0), cB, voffB); PG8_STAGE(PG8_SA(0, 0), cA, voffA); PG8_STAGE(PG8_SB(0, 1), cB + hstepB, voffB); PG8_STAGE(PG8_SA(0, 1), cA + hstepA, voffA);
        if (wr == 1) PG8_BAR;
        PG8_WAIT_V(4); PG8_BAR;
        PG8_STAGE(PG8_SB(1, 0), cB + kstep, voffB); PG8_STAGE(PG8_SA(1, 0), cA + kstep, voffA); PG8_STAGE(PG8_SB(1, 1), cB + hstepB + kstep, voffB);
        PG8_WAIT_V(6); PG8_BAR;
    }
    for (;;) {
        const bool has_next = S.next(ui + 1, nxt);
        const char* nA = has_next ? (const char*)g.A + (size_t)nxt.pm * tstepA + acolb(g, nxt) : cA; const char* nB = has_next ? (const char*)g.Bt + (size_t)nxt.pn * tstepB : cB;
        for (int t = 0; t < nt; t += 2) {
            const bool last = (t == nt - 2);
            const char* a1 = cA + (size_t)(t + 1) * kstep;
            const char* a2 = last ? nA : cA + (size_t)(t + 2) * kstep; const char* b2 = last ? nB : cB + (size_t)(t + 2) * kstep;
            const char* a3 = a2 + kstep; const char* b3 = b2 + kstep;
            if (last && has_next) S.a_ready(nxt);
            if constexpr (SP2) {
            PG8_LDB(B0, 0, 0); PG8_LDB(B1, 0, 1); PG8_SCHED; PG8_LDA(At, 0, 0); PG8_STAGE(PG8_SA(1, 1), a1 + hstepA, voffA);
            PG8_WAIT_V(8); PG8_WAIT_L(0); PG8_BAR; PG8_MMA(0, 0, At, B0); PG8_MMA(0, 1, At, B1); PG8_BAR; PG8_SCHED;
            PG8_LDA(At, 0, 1); PG8_STAGE(PG8_SB(0, 0), b2, voffB); PG8_STAGE(PG8_SB(0, 1), b2 + hstepB, voffB); PG8_STAGE(PG8_SA(0, 0), a2, voffA);
            PG8_WAIT_V(8); PG8_WAIT_L(0); PG8_BAR; PG8_MMA(1, 0, At, B0); PG8_MMA(1, 1, At, B1); PG8_BAR; PG8_SCHED;
            PG8_LDB(B0, 1, 0); PG8_LDB(B1, 1, 1); PG8_SCHED; PG8_LDA(At, 1, 0); PG8_STAGE(PG8_SA(0, 1), a2 + hstepA, voffA);
            PG8_WAIT_V(8); PG8_WAIT_L(0); PG8_BAR; PG8_MMA(0, 0, At, B0); PG8_MMA(0, 1, At, B1); PG8_BAR; PG8_SCHED;
            PG8_LDA(At, 1, 1); PG8_STAGE(PG8_SB(1, 0), b3, voffB); PG8_STAGE(PG8_SB(1, 1), b3 + hstepB, voffB); PG8_STAGE(PG8_SA(1, 0), a3, voffA);
            PG8_WAIT_V(8); PG8_WAIT_L(0); PG8_BAR; PG8_MMA(1, 0, At, B0); PG8_MMA(1, 1, At, B1); PG8_BAR; PG8_SCHED;
            } else {
            PG8_LDB(B0, 0, 0); PG8_SCHED; PG8_LDA(At, 0, 0); PG8_STAGE(PG8_SA(1, 1), a1 + hstepA, voffA);
            PG8_WAIT_L(8); PG8_BAR; PG8_WAIT_L(0); PG8_MMA(0, 0, At, B0); PG8_BAR; PG8_SCHED;
            PG8_LDB(B1, 0, 1); PG8_STAGE(PG8_SB(0, 0), b2, voffB);
            PG8_BAR; PG8_WAIT_L(0); PG8_MMA(0, 1, At, B1); PG8_BAR;
            PG8_LDA(At, 0, 1); PG8_STAGE(PG8_SA(0, 0), a2, voffA);
            PG8_BAR; PG8_WAIT_L(0); PG8_MMA(1, 0, At, B0); PG8_BAR; PG8_SCHED;
            PG8_STAGE(PG8_SB(0, 1), b2 + hstepB, voffB);
            PG8_WAIT_V(6); PG8_BAR; PG8_MMA(1, 1, At, B1); PG8_BAR;
            PG8_LDB(B0, 1, 0); PG8_SCHED; PG8_LDA(At, 1, 0); PG8_STAGE(PG8_SA(0, 1), a2 + hstepA, voffA);
            PG8_WAIT_L(8); PG8_BAR; PG8_WAIT_L(0); PG8_MMA(0, 0, At, B0); PG8_BAR; PG8_SCHED;
            PG8_LDB(B1, 1, 1); PG8_STAGE(PG8_SB(1, 0), b3, voffB);
            PG8_BAR; PG8_WAIT_L(0); PG8_MMA(0, 1, At, B1); PG8_BAR;
            PG8_LDA(At, 1, 1); PG8_STAGE(PG8_SA(1, 0), a3, voffA);
            PG8_BAR; PG8_WAIT_L(0); PG8_MMA(1, 0, At, B0); PG8_BAR; PG8_SCHED;
            PG8_STAGE(PG8_SB(1, 1), b3 + hstepB, voffB);
            PG8_WAIT_V(6); PG8_BAR; PG8_MMA(1, 1, At, B1); PG8_BAR;
            }
        }
        if constexpr (ALIGN_EPI) { if (wr == 0) PG8_BAR; }
        if constexpr (!Epi::AFTER_DRAIN) { E(acc, cur, wr, wc, fr, fq); S.done(cur); }
        if (!has_next) break;
#pragma unroll
        for (int a = 0; a < 2; ++a)
#pragma unroll
            for (int b = 0; b < 2; ++b)
#pragma unroll
                for (int m = 0; m < 4; ++m)
#pragma unroll
                    for (int n = 0; n < 2; ++n) acc[a][b][m][n] = (f32x4){0.f, 0.f, 0.f, 0.f};
        cur = nxt; cA = nA; cB = nB; ++ui;
        if constexpr (ALIGN_EPI) { if (wr == 1) PG8_BAR; }
    }
    PG8_WAIT_V(0);
    if constexpr (!ALIGN_EPI) { if (wr == 0) PG8_BAR; }
    PG8_BAR;
    if constexpr (Epi::AFTER_DRAIN) { E.fused(acc, cur, wr, wc, fr, fq, lds, wid, lane); S.done(cur); }
#undef PG8_SA
#undef PG8_SB
#undef PG8_STAGE
#undef PG8_LDA
#undef PG8_LDB
#undef PG8_MMA
#undef PG8_WAIT_V
#undef PG8_WAIT_L
#undef PG8_BAR
#undef PG8_SCHED
}
}

constexpr int DM = 2048, NB = 4, SEQ = 2048, NMETA = 16, LP = SEQ + NMETA  , DECB = 128, DECS = 8;
constexpr int DFF = 5632, DPOOL = 1024, DIN = 11264;
constexpr int MP_ROWS = NB * LP;
constexpr int MS_ROWS = DECB * DECS;
constexpr int MREAL = MP_ROWS + MS_ROWS;
constexpr int MPAD = 9472;
constexpr float EPS = 1e-6f;
constexpr int NWAVES = 8;

constexpr size_t O_YP = 0, O_YS = O_YP + (size_t)NB * SEQ * DM, O_NCP = O_YS + (size_t)MS_ROWS * DM, O_NPP = O_NCP + (size_t)NB * 2 * DM,
                 O_NCS = O_NPP + (size_t)NB * 15 * DPOOL, O_NPS = O_NCS + (size_t)DECB * 2 * DM, O_END = O_NPS + (size_t)DECB * 15 * DPOOL;

constexpr size_t MiB = 1u << 20;
constexpr size_t WS_W1GU = 1 * MiB;
constexpr size_t WS_W1D = WS_W1GU + 44 * MiB;
constexpr size_t WS_WIN = WS_W1D + 22 * MiB;
constexpr size_t WS_WCO = WS_WIN + 44 * MiB;
constexpr size_t WS_WPG = WS_WCO + 8 * MiB;
constexpr size_t WS_WO = WS_WPG + 1 * MiB;
constexpr size_t WS_W2GU = WS_WO + 8 * MiB;
constexpr size_t WS_W2D = WS_W2GU + 44 * MiB;
constexpr size_t WS_H = WS_W2D + 22 * MiB;
constexpr size_t WS_R = WS_H + 74 * MiB;
constexpr size_t WS_BG = WS_R, WS_CV = WS_R + 37 * MiB, WS_SGC = WS_R + 74 * MiB, WS_SGP = WS_R + 111 * MiB, WS_Z = WS_R + 148 * MiB, WS_PL = WS_Z + 19 * MiB;
constexpr size_t WS_XN1 = WS_SGP;
constexpr size_t WS_END = WS_PL + 19 * MiB;
static_assert((size_t)MPAD * DFF * 2 <= 111 * MiB, "ACT fits below XN1");

#define GAS __attribute__((address_space(1)))
#define LAS __attribute__((address_space(3)))
typedef unsigned short bf16;
typedef unsigned v4u __attribute__((ext_vector_type(4)));
typedef float f32x4 __attribute__((ext_vector_type(4)));
#define LDS_WAIT() asm volatile("s_waitcnt lgkmcnt(0)" ::: "memory")
constexpr int LDS_BYTES = 147456;

struct Args {
    const float *x_prompt, *x_sample, *state_conv, *state_pool, *meta, *norm_ffn1, *w1g, *w1u, *w1d, *norm_mix, *w_in, *conv_w, *w_conv_out, *w_pool, *pool_scale, *w_o, *norm_ffn2, *w2g, *w2u, *w2d, *norm_final;
    float* out; unsigned char* ws;
};

__device__ __forceinline__ unsigned pk2(float lo, float hi) { return pg8::cvt_pk_bf16(lo, hi); }
__device__ __forceinline__ float wave_sum(float v) {
#pragma unroll
    for (int o = 1; o < 64; o <<= 1) v += __shfl_xor(v, o);
    return v;
}
__device__ __forceinline__ const float* src_row(const Args& a, int r) {
    if (r < MP_ROWS) { const int b = r / LP, t = r - b * LP; return t < NMETA ? a.meta + (size_t)t * DM : a.x_prompt + ((size_t)b * SEQ + (t - NMETA)) * DM; }
    if (r < MREAL) return a.x_sample + (size_t)(r - MP_ROWS) * DM;
    return nullptr;
}
__device__ __forceinline__ void p0_transpose_item(const float* W, int N, bf16* WT, int K, int k0, int n0, int drow0, LAS float* scr, int lane) {
    const int lr = lane >> 4, lc = (lane & 15) * 4;
    f32x4 v[16];
#pragma unroll
    for (int i = 0; i < 16; ++i) v[i] = *(const f32x4*)(W + (size_t)(k0 + 4 * i + lr) * N + n0 + lc);
#pragma unroll
    for (int i = 0; i < 16; ++i) { LAS float* s = scr + (4 * i + lr) * 65 + lc; s[0] = v[i].x; s[1] = v[i].y; s[2] = v[i].z; s[3] = v[i].w; }
    LDS_WAIT(); asm volatile("" ::: "memory");
    const int c = lane & 7;
#pragma unroll
    for (int j = 0; j < 8; ++j) { const int n = (lane >> 3) + 8 * j; const LAS float* s = scr + (8 * c) * 65 + n;
        v4u o; o.x = pk2(s[0 * 65], s[1 * 65]); o.y = pk2(s[2 * 65], s[3 * 65]); o.z = pk2(s[4 * 65], s[5 * 65]); o.w = pk2(s[6 * 65], s[7 * 65]);
        *(v4u*)(WT + (size_t)(drow0 + n) * K + k0 + 8 * c) = o; }
    LDS_WAIT(); asm volatile("" ::: "memory");
}
__device__ __forceinline__ bool p0_job(int& r, const float* W, int K, int N, bf16* WT, int kind, int roff, LAS float* scr, int lane) {
    const int nb = N / 64, items = (K / 64) * nb;
    if (r >= items) { r -= items; return false; }
    const int kb = r / nb, n0 = (r % nb) * 64;
    int d;
    if (kind == 0) d = roff + n0;
    else if (kind == 1) d = (n0 >> 7) * 256 + (n0 & 127);
    else if (kind == 2) d = (n0 >> 7) * 256 + 128 + (n0 & 127);
    else { if (n0 < 2048 || n0 >= 6144) d = n0; else if (n0 < 4096) { const int j = n0 - 2048; d = 2048 + (j >> 7) * 256 + (j & 127); } else { const int j = n0 - 4096; d = 2048 + (j >> 7) * 256 + 128 + (j & 127); } }
    p0_transpose_item(W, N, WT, K, kb * 64, n0, d, scr, lane);
    return true;
}
__device__ __forceinline__ void rms_row_bf16(const float* xrow, const float* g, bf16* orow, float* hcopy, int lane) {
    f32x4 v[8]; float s = 0.f;
    if (xrow) {
#pragma unroll
        for (int j = 0; j < 8; ++j) { v[j] = ((const f32x4*)xrow)[lane + 64 * j]; s += (v[j].x * v[j].x + v[j].y * v[j].y) + (v[j].z * v[j].z + v[j].w * v[j].w); }
    } else {
#pragma unroll
        for (int j = 0; j < 8; ++j) v[j] = (f32x4){0.f, 0.f, 0.f, 0.f};
    }
    const float r = 1.0f / sqrtf(wave_sum(s) * (1.0f / DM) + EPS);
#pragma unroll
    for (int j = 0; j < 8; ++j) {
        if (hcopy) ((f32x4*)hcopy)[lane + 64 * j] = v[j];
        const f32x4 gg = ((const f32x4*)g)[lane + 64 * j];
        const unsigned lo = pk2(v[j].x * r * gg.x, v[j].y * r * gg.y), hi = pk2(v[j].z * r * gg.z, v[j].w * r * gg.w);
        ((unsigned long long*)orow)[lane + 64 * j] = (unsigned long long)lo | ((unsigned long long)hi << 32);
    }
}
__device__ __forceinline__ void load8_bf16(const bf16* p, float (&o)[8]) { const v4u w = *(const v4u*)p; o[0] = pg8::bf_lo(w.x); o[1] = pg8::bf_hi(w.x); o[2] = pg8::bf_lo(w.y); o[3] = pg8::bf_hi(w.y); o[4] = pg8::bf_lo(w.z); o[5] = pg8::bf_hi(w.z); o[6] = pg8::bf_lo(w.w); o[7] = pg8::bf_hi(w.w); }
__device__ __forceinline__ void load8_f32(const float* p, float (&o)[8]) { const f32x4 a = ((const f32x4*)p)[0], b = ((const f32x4*)p)[1]; o[0] = a.x; o[1] = a.y; o[2] = a.z; o[3] = a.w; o[4] = b.x; o[5] = b.y; o[6] = b.z; o[7] = b.w; }
__device__ __forceinline__ void store8_f32(float* p, const float (&o)[8]) { ((f32x4*)p)[0] = (f32x4){o[0], o[1], o[2], o[3]}; ((f32x4*)p)[1] = (f32x4){o[4], o[5], o[6], o[7]}; }


#define XB_TMO      128
#define XB_XCNT(j)  (256  + 64 * (j))
#define XB_XSUB(j)  (1280 + 64 * (j))
#define XB_XGEN(j)  (2304 + 64 * (j))
#define XB_TOP      3328
#define XB_TOPGEN   3392
#define XCD_BAR_WORDS 3456
#define XB_SPIN_CAP (1u << 18)

__device__ __forceinline__ unsigned xb_ld(unsigned* p)              { return __hip_atomic_load(p, __ATOMIC_RELAXED, __HIP_MEMORY_SCOPE_AGENT); }
__device__ __forceinline__ unsigned xb_add(unsigned* p, unsigned v) { return __hip_atomic_fetch_add(p, v, __ATOMIC_RELAXED, __HIP_MEMORY_SCOPE_AGENT); }
__device__ __forceinline__ unsigned xb_xcc_id() { return (unsigned)__builtin_amdgcn_s_getreg((3 << 11) | 20) & 0xFu; }
#define XB_SPIN(cond, bar) do { unsigned _sp = 0; while (cond) { __builtin_amdgcn_s_sleep(1); \
    if ((++_sp & 255u) == 0u) { if (xb_ld(&(bar)[XB_TMO])) break; if (_sp > XB_SPIN_CAP) { atomicAdd(&(bar)[XB_TMO], 1u); break; } } } } while (0)

struct XcdBarrier {
    unsigned* bar; unsigned x;
    volatile LAS unsigned* st;
};

__device__ __forceinline__ XcdBarrier xcd_barrier_post(unsigned* bar, volatile LAS unsigned* st) {
    XcdBarrier b; b.bar = bar; b.x = xb_xcc_id(); b.st = st;
    if (threadIdx.x == 0) (void)xb_add(&bar[XB_XCNT(b.x)], 1u);
    return b;
}
__device__ __forceinline__ void xcd_barrier_complete(unsigned* bar, unsigned x, unsigned& nloc, unsigned& nx) {
    const unsigned G = gridDim.x * gridDim.y * gridDim.z;
    unsigned sum, cnt, mine, sp = 0u;
    for (;;) {
        sum = 0u; cnt = 0u; mine = 0u;
#pragma unroll
        for (unsigned j = 0; j < 16; ++j) { const unsigned c = xb_ld(&bar[XB_XCNT(j)]); sum += c; cnt += (c > 0u) ? 1u : 0u; mine = (j == x) ? c : mine; }
        if (sum == G) break;
        __builtin_amdgcn_s_sleep(1);
        if ((++sp & 255u) == 0u) { if (xb_ld(&bar[XB_TMO])) break; if (sp > XB_SPIN_CAP) { atomicAdd(&bar[XB_TMO], 1u); break; } }
    }
    nloc = mine > 0u ? mine : 1u; nx = cnt > 0u ? cnt : 1u;
}

__device__ __forceinline__ void xcd_barrier(const XcdBarrier& b) {
    asm volatile("s_waitcnt vmcnt(0)" ::: "memory");
    __syncthreads();
    if (threadIdx.x == 0) {
        unsigned* bar = b.bar;
        __builtin_amdgcn_s_waitcnt(0);
        unsigned nloc = b.st[0], nx = b.st[1];
        if (nloc == 0u) { xcd_barrier_complete(bar, b.x, nloc, nx); b.st[0] = nloc; b.st[1] = nx; }
        const unsigned old = xb_add(&bar[XB_XSUB(b.x)], 1u);
        const unsigned gen = old / nloc;
        if (old + 1u == (gen + 1u) * nloc) {
            __builtin_amdgcn_fence(__ATOMIC_RELEASE, "agent");
            asm volatile("s_waitcnt vmcnt(0)" ::: "memory");
            const unsigned og = xb_add(&bar[XB_TOP], 1u);
            const unsigned tg = og / nx;
            if (og + 1u == (tg + 1u) * nx) xb_add(&bar[XB_TOPGEN], 1u);
            else XB_SPIN(xb_ld(&bar[XB_TOPGEN]) == tg, bar);
            __builtin_amdgcn_fence(__ATOMIC_ACQUIRE, "agent");
            xb_add(&bar[XB_XGEN(b.x)], 1u);
            asm volatile("s_waitcnt vmcnt(0)" ::: "memory");
        } else {
            XB_SPIN(xb_ld(&bar[XB_XGEN(b.x)]) == gen, bar);
            __builtin_amdgcn_fence(__ATOMIC_ACQUIRE, "agent");
            asm volatile("s_waitcnt vmcnt(0)" ::: "memory");
        }
    }
    __syncthreads();
}

__global__ void __launch_bounds__(NWAVES * 64) fwd_megakernel(Args a) {
    extern __shared__ __attribute__((aligned(16))) unsigned char lds_raw[];
    cg::grid_group grid = cg::this_grid();
    LAS unsigned char* lds = (LAS unsigned char*)lds_raw;
    const int tid = threadIdx.x, lane = tid & 63, wave = __builtin_amdgcn_readfirstlane(tid >> 6);
    const int G = gridDim.x, bx = blockIdx.x;
    const int gw = bx * NWAVES + wave, NGW = G * NWAVES;
    unsigned char* ws = a.ws;
    bf16 *W1GU = (bf16*)(ws + WS_W1GU), *W1D = (bf16*)(ws + WS_W1D), *WIN = (bf16*)(ws + WS_WIN), *WCO = (bf16*)(ws + WS_WCO), *WPG = (bf16*)(ws + WS_WPG), *WO = (bf16*)(ws + WS_WO),
         *W2GU = (bf16*)(ws + WS_W2GU), *W2D = (bf16*)(ws + WS_W2D);
    float* H = (float*)(ws + WS_H);
    bf16 *ACT = (bf16*)(ws + WS_R), *BG = (bf16*)(ws + WS_BG), *CV = (bf16*)(ws + WS_CV), *SGC = (bf16*)(ws + WS_SGC), *SGP = (bf16*)(ws + WS_SGP), *Z = (bf16*)(ws + WS_Z), *PL = (bf16*)(ws + WS_PL);
    bf16 *XN1 = (bf16*)(ws + WS_XN1), *XN = (bf16*)(ws + WS_W1GU);
    volatile LAS unsigned* MISC = (volatile LAS unsigned*)(lds + LDS_BYTES - 128);
    if (tid < 32) MISC[tid] = 0u;
    unsigned* barw = (unsigned*)ws;
    if (bx == 0) for (int i = tid; i < XCD_BAR_WORDS; i += NWAVES * 64) __hip_atomic_store(barw + i, 0u, __ATOMIC_RELAXED, __HIP_MEMORY_SCOPE_AGENT);
    __syncthreads();

    {
        LAS float* scr = (LAS float*)(lds + wave * 16640);
        constexpr int IT_GU = (DM / 64) * (DFF / 64), IT_D = (DFF / 64) * (DM / 64), IT_IN = (DM / 64) * (DIN / 64), IT_SQ = (DM / 64) * (DM / 64), IT_PG = (256 / 64) * (512 / 64);
        constexpr int NITEMS = 4 * IT_GU + 2 * IT_D + IT_IN + 2 * IT_SQ + 4 * IT_PG;
        for (int it = gw; it < NITEMS; it += NGW) {
            int r = it;
            if (p0_job(r, a.w1g, DM, DFF, W1GU, 1, 0, scr, lane)) continue;
            if (p0_job(r, a.w1u, DM, DFF, W1GU, 2, 0, scr, lane)) continue;
            if (p0_job(r, a.w1d, DFF, DM, W1D, 0, 0, scr, lane)) continue;
            if (p0_job(r, a.w_in, DM, DIN, WIN, 3, 0, scr, lane)) continue;
            if (p0_job(r, a.w_conv_out, DM, DM, WCO, 0, 0, scr, lane)) continue;
            if (p0_job(r, a.w_o, DM, DM, WO, 0, 0, scr, lane)) continue;
            if (p0_job(r, a.w2g, DM, DFF, W2GU, 1, 0, scr, lane)) continue;
            if (p0_job(r, a.w2u, DM, DFF, W2GU, 2, 0, scr, lane)) continue;
            if (p0_job(r, a.w2d, DFF, DM, W2D, 0, 0, scr, lane)) continue;
            if (p0_job(r, a.w_pool + 0 * 256 * 512, 256, 512, WPG, 0, 0, scr, lane)) continue;
            if (p0_job(r, a.w_pool + 1 * 256 * 512, 256, 512, WPG, 0, 512, scr, lane)) continue;
            if (p0_job(r, a.w_pool + 2 * 256 * 512, 256, 512, WPG, 0, 1024, scr, lane)) continue;
            p0_job(r, a.w_pool + 3 * 256 * 512, 256, 512, WPG, 0, 1536, scr, lane);
        }
        for (int m = gw; m < MPAD; m += NGW) rms_row_bf16(src_row(a, m), a.norm_ffn1, XN1 + (size_t)m * DM, H + (size_t)m * DM, lane);
    }
    grid.sync();
    const XcdBarrier bar = xcd_barrier_post(barw, MISC + 8);

    {
        pg8::Gemm g{XN1, W1GU, MPAD, 2 * DFF, DM, DM, DM, 0}; pg8::StaticOrder S; S.init(MPAD, 2 * DFF, G, bx);
        pg8::EpiSwiglu E{ACT, DFF};
        pg8::gemm_phase<pg8::EpiSwiglu, pg8::StaticOrder, true, true>(lds, g, S, E);
    }
    xcd_barrier(bar);
    {
        pg8::Gemm g{ACT, W1D, MPAD, DM, DFF, DFF, DFF, 0}; pg8::StaticOrder S; S.init(MPAD, DM, G, bx);
        pg8::EpiResid E{H, DM, 0.5f};
        pg8::gemm_phase<pg8::EpiResid, pg8::StaticOrder, true, true>(lds, g, S, E);
    }
    xcd_barrier(bar);
    for (int m = gw; m < MPAD; m += NGW) rms_row_bf16(H + (size_t)m * DM, a.norm_mix, XN + (size_t)m * DM, nullptr, lane);
    xcd_barrier(bar);
    {
        pg8::Gemm g{XN, WIN, MPAD, DIN, DM, DM, DM, 0}; pg8::StaticOrder S; S.init(MPAD, DIN, G, bx);
        pg8::EpiProj E{BG, CV, Z, SGC, SGP};
        pg8::gemm_phase<pg8::EpiProj, pg8::StaticOrder, true, true>(lds, g, S, E);
    }
    xcd_barrier(bar);
    for (int m = gw; m < MREAL; m += NGW) {
        const bool smp = m >= MP_ROWS;
        int sq, t, L;
        if (smp) { sq = (m - MP_ROWS) >> 3; t = (m - MP_ROWS) & 7; L = DECS; } else { sq = m / LP; t = m - sq * LP; L = LP; }
        const float* sc = a.state_conv + (size_t)sq * 2 * DM;
        const float* sp = a.state_pool + (size_t)sq * 15 * DPOOL;
        float* ncv = (t >= L - 2) ? (smp ? a.out + O_NCS + ((size_t)sq * 2 + (t - (L - 2))) * DM : a.out + O_NCP + ((size_t)sq * 2 + (t - (L - 2))) * DM) : nullptr;
#pragma unroll 1
        for (int j = 0; j < 4; ++j) {
            const int col = 512 * j + 8 * lane;
            float c0[8], c1[8], c2[8], bg[8], w0[8], w1[8], w2[8], o[8];
            load8_bf16(CV + (size_t)m * DM + col, c2);
            if (t >= 1) load8_bf16(CV + (size_t)(m - 1) * DM + col, c1); else if (smp) load8_f32(sc + (size_t)1 * DM + col, c1); else {
#pragma unroll
                for (int e = 0; e < 8; ++e) c1[e] = 0.f; }
            if (t >= 2) load8_bf16(CV + (size_t)(m - 2) * DM + col, c0); else if (smp) load8_f32(sc + (size_t)t * DM + col, c0); else {
#pragma unroll
                for (int e = 0; e < 8; ++e) c0[e] = 0.f; }
            load8_bf16(BG + (size_t)m * DM + col, bg);
            load8_f32(a.conv_w + col, w0); load8_f32(a.conv_w + DM + col, w1); load8_f32(a.conv_w + 2 * DM + col, w2);
#pragma unroll
            for (int e = 0; e < 8; ++e) o[e] = bg[e] * (w0[e] * c0[e] + w1[e] * c1[e] + w2[e] * c2[e]);
            v4u w; w.x = pk2(o[0], o[1]); w.y = pk2(o[2], o[3]); w.z = pk2(o[4], o[5]); w.w = pk2(o[6], o[7]);
            *(v4u*)(BG + (size_t)m * DM + col) = w;
            if (ncv) store8_f32(ncv + col, c2);
        }
        float* npp = nullptr;
        if (smp) npp = a.out + O_NPS + ((size_t)sq * 15 + 7 + t) * DPOOL; else if (t >= L - 15) npp = a.out + O_NPP + ((size_t)sq * 15 + (t - (L - 15))) * DPOOL;
#pragma unroll 1
        for (int j = 0; j < 2; ++j) {
            const int col = 512 * j + 8 * lane, gq = col >> 8, k = 2 << gq, kmax = j ? 16 : 4;
            float z0[8], s[8], zi[8];
            load8_bf16(Z + (size_t)m * DPOOL + col, z0);
#pragma unroll
            for (int e = 0; e < 8; ++e) s[e] = z0[e];
#pragma unroll 1
            for (int i = 1; i < kmax; ++i) {
                if (t - i >= 0) load8_bf16(Z + (size_t)(m - i) * DPOOL + col, zi);
                else if (smp) load8_f32(sp + (size_t)(15 + t - i) * DPOOL + col, zi);
                else break;
                if (i < k) {
#pragma unroll
                    for (int e = 0; e < 8; ++e) s[e] += zi[e]; }
            }
            const int cnt = smp ? k : (k < t + 1 ? k : t + 1);
            const float inv = 1.0f / (float)cnt;
            float o[8];
#pragma unroll
            for (int e = 0; e < 8; ++e) o[e] = s[e] * inv - z0[e];
            v4u w; w.x = pk2(o[0], o[1]); w.y = pk2(o[2], o[3]); w.z = pk2(o[4], o[5]); w.w = pk2(o[6], o[7]);
            *(v4u*)(PL + (size_t)m * DPOOL + col) = w;
            if (npp) store8_f32(npp + col, z0);
            if (smp && t < 7) { float q[8]; load8_f32(sp + (size_t)(8 + t) * DPOOL + col, q); store8_f32(a.out + O_NPS + ((size_t)sq * 15 + t) * DPOOL + col, q); }
        }
    }
    xcd_barrier(bar);
    {
        pg8::Gemm g{PL, WPG, MPAD, DM, 256, DPOOL, 256, 1}; pg8::StaticOrder S; S.init(MPAD, DM, G, bx);
        pg8::EpiPool E{SGP, a.pool_scale};
        pg8::gemm_phase<pg8::EpiPool, pg8::StaticOrder, true, true>(lds, g, S, E);
    }
    __syncthreads();
    {
        pg8::Gemm g{BG, WCO, MPAD, DM, DM, DM, DM, 0}; pg8::StaticOrder S; S.init(MPAD, DM, G, bx);
        pg8::EpiMerge E{SGC, SGP};
        pg8::gemm_phase<pg8::EpiMerge, pg8::StaticOrder, true, true>(lds, g, S, E);
    }
    xcd_barrier(bar);
    {
        pg8::Gemm g{SGC, WO, MPAD, DM, DM, DM, DM, 0}; pg8::StaticOrder S; S.init(MPAD, DM, G, bx);
        pg8::EpiResid E{H, DM, 1.0f};
        pg8::gemm_phase<pg8::EpiResid, pg8::StaticOrder, true, true>(lds, g, S, E);
    }
    xcd_barrier(bar);
    for (int m = gw; m < MPAD; m += NGW) rms_row_bf16(H + (size_t)m * DM, a.norm_ffn2, XN + (size_t)m * DM, nullptr, lane);
    xcd_barrier(bar);
    {
        pg8::Gemm g{XN, W2GU, MPAD, 2 * DFF, DM, DM, DM, 0}; pg8::StaticOrder S; S.init(MPAD, 2 * DFF, G, bx);
        pg8::EpiSwiglu E{ACT, DFF};
        pg8::gemm_phase<pg8::EpiSwiglu, pg8::StaticOrder, true, true>(lds, g, S, E);
    }
    xcd_barrier(bar);
    {
        pg8::Gemm g{ACT, W2D, MPAD, DM, DFF, DFF, DFF, 0}; pg8::StaticOrder S; S.init(MPAD, DM, G, bx);
        pg8::EpiResid E{H, DM, 0.5f};
        pg8::gemm_phase<pg8::EpiResid, pg8::StaticOrder, true, true>(lds, g, S, E);
    }
    xcd_barrier(bar);
    for (int m = gw; m < MREAL; m += NGW) {
        float* dst;
        if (m < MP_ROWS) { const int b = m / LP, t = m - b * LP; if (t < NMETA) continue; dst = a.out + O_YP + ((size_t)b * SEQ + (t - NMETA)) * DM; }
        else dst = a.out + O_YS + (size_t)(m - MP_ROWS) * DM;
        const float* hr = H + (size_t)m * DM;
        f32x4 v[8]; float s = 0.f;
#pragma unroll
        for (int j = 0; j < 8; ++j) { v[j] = ((const f32x4*)hr)[lane + 64 * j]; s += (v[j].x * v[j].x + v[j].y * v[j].y) + (v[j].z * v[j].z + v[j].w * v[j].w); }
        const float r = 1.0f / sqrtf(wave_sum(s) * (1.0f / DM) + EPS);
#pragma unroll
        for (int j = 0; j < 8; ++j) { const f32x4 gg = ((const f32x4*)a.norm_final)[lane + 64 * j]; ((f32x4*)dst)[lane + 64 * j] = v[j] * r * gg; }
    }
}

extern "C" void kernel_launch(void* const* d_in, const int* in_sizes, int n_in, void* d_out, int out_size, void* d_ws, size_t ws_size, hipStream_t stream) {
    static int grid = 0;
    if (grid == 0) {
        if (n_in != 21 || (size_t)out_size != O_END || ws_size < WS_END) { fprintf(stderr, "kernel_launch: unexpected shapes: n_in %d out %d ws %zu (need %zu)\n", n_in, out_size, ws_size, (size_t)WS_END); grid = -1; return; }
        int dev = 0, cus = 0, per_cu = 0;
        hipGetDevice(&dev); hipDeviceGetAttribute(&cus, hipDeviceAttributeMultiprocessorCount, dev);
        if (hipFuncSetAttribute((const void*)fwd_megakernel, hipFuncAttributeMaxDynamicSharedMemorySize, LDS_BYTES) != hipSuccess) { fprintf(stderr, "kernel_launch: hipFuncSetAttribute failed\n"); grid = -1; return; }
        if (hipOccupancyMaxActiveBlocksPerMultiprocessor(&per_cu, (const void*)fwd_megakernel, NWAVES * 64, LDS_BYTES) != hipSuccess || per_cu < 1) { fprintf(stderr, "kernel_launch: occupancy query failed (%d)\n", per_cu); (void)hipGetLastError(); per_cu = 1; }
        grid = cus * 1;
        fprintf(stderr, "kernel_launch: grid %d (cus %d, per_cu %d)\n", grid, cus, per_cu);
    }
    if (grid < 0) return;
    Args a{};
    a.x_prompt = (const float*)d_in[0]; a.x_sample = (const float*)d_in[1]; a.state_conv = (const float*)d_in[2]; a.state_pool = (const float*)d_in[3]; a.meta = (const float*)d_in[4];
    a.norm_ffn1 = (const float*)d_in[5]; a.w1g = (const float*)d_in[6]; a.w1u = (const float*)d_in[7]; a.w1d = (const float*)d_in[8]; a.norm_mix = (const float*)d_in[9]; a.w_in = (const float*)d_in[10];
    a.conv_w = (const float*)d_in[11]; a.w_conv_out = (const float*)d_in[12]; a.w_pool = (const float*)d_in[13]; a.pool_scale = (const float*)d_in[14]; a.w_o = (const float*)d_in[15];
    a.norm_ffn2 = (const float*)d_in[16]; a.w2g = (const float*)d_in[17]; a.w2u = (const float*)d_in[18]; a.w2d = (const float*)d_in[19]; a.norm_final = (const float*)d_in[20];
    a.out = (float*)d_out; a.ws = (unsigned char*)d_ws;
    void* args[] = {&a};
    hipError_t e = hipLaunchCooperativeKernel((const void*)fwd_megakernel, dim3(grid), dim3(NWAVES * 64), args, LDS_BYTES, stream);
    if (e != hipSuccess) fprintf(stderr, "kernel_launch: cooperative launch failed: %s (grid %d)\n", hipGetErrorString(e), grid);
}
```

```cpp
#include <hip/hip_runtime.h>
#include <hip/hip_cooperative_groups.h>
#include <cstdio>
#include <cstdint>
namespace cg = cooperative_groups;

namespace pg8 {
#define PG8_LAS __attribute__((address_space(3)))
typedef unsigned short bf16_t;
typedef short bf16x8 __attribute__((ext_vector_type(8)));
typedef float f32x4 __attribute__((ext_vector_type(4)));
typedef unsigned u32x4 __attribute__((ext_vector_type(4)));
constexpr int BM = 256, BK = 64, HALF = 128, HTB = HALF * BK * 2  , STAGE_BYTES = 8 * HTB, NXCD = 8, WGM = 8;

__host__ __device__ __forceinline__ int lds_byte(int r, int c) { const int st = (r >> 4) * 2 + (c >> 5), rr = r & 15, cc = c & 31, ob = rr * 64 + cc * 2; return st * 1024 + (ob ^ (((ob >> 9) & 1) << 5)); }
__host__ __device__ __forceinline__ void stage_rc(int b, int& R, int& C) { const int st = b / 1024, sb = b % 1024, swz = sb ^ (((sb >> 9) & 1) << 5); R = (st >> 1) * 16 + swz / 64; C = (st & 1) * 32 + (swz % 64) / 2; }
__host__ __device__ __forceinline__ int perm32(int rho) { const int n = rho >> 4, i = rho & 15; return 8 * (i >> 2) + 4 * n + (i & 3); }

struct Unit { int pm, pn, kt0, nkt, slab; };
struct Gemm { const bf16_t* A; const bf16_t* Bt; int M, N, K, lda, ldb, agrp; };
__device__ __forceinline__ size_t acolb(const Gemm& g, const Unit& u) { return g.agrp ? (size_t)((u.pn >> 1) * 256) * 2 : (size_t)0; }

struct StaticOrder {
    int nM, nN, nwg, G, c, nt;
    __host__ __device__ void init(int M, int N, int K, int G_, int c_) { nM = M / BM; nN = N / BM; nwg = nM * nN; G = G_; c = c_; nt = K / BK; }
    __host__ __device__ bool next(int i, Unit& u) const {
        const long L = (long)i * G + c; if (L >= nwg) return false;
        int wgid = (int)L; { const int q = nwg / NXCD, r = nwg % NXCD, xcd = wgid % NXCD, off = wgid / NXCD; wgid = (xcd < r ? xcd * (q + 1) : r * (q + 1) + (xcd - r) * q) + off; }
        const int nig = WGM * nN, gid = wgid / nig, fm = gid * WGM, gsz = (nM - fm) < WGM ? (nM - fm) : WGM;
        u.pm = fm + ((wgid % nig) % gsz); u.pn = (wgid % nig) / gsz; u.kt0 = 0; u.nkt = nt; u.slab = -1; return true;
    }
    __device__ __forceinline__ void a_ready(const Unit&) const {}
    __device__ __forceinline__ void done(const Unit&) const {}
};
struct TailOrder {
    int c, nt;
    __host__ __device__ void init(int K, int c_) { c = c_; nt = K / BK; }
    __host__ __device__ bool next(int i, Unit& u) const {
        if (i == 0) { const int x = c & 7, idx = c >> 3; u.pm = 4 * x + (idx >> 3); u.pn = idx & 7; u.kt0 = 0; u.nkt = nt; u.slab = -1; return true; }
        if (i == 1 && c < 240) { const int j = c / 6, ch = c - 6 * j, np = nt >> 1, base = np / 6, rem = np % 6, p0 = ch * base + (ch < rem ? ch : rem), pc = base + (ch < rem ? 1 : 0);
            u.pm = 32 + (j >> 3); u.pn = j & 7; u.kt0 = 2 * p0; u.nkt = 2 * pc; u.slab = c; return true; }
        return false;
    }
    __device__ __forceinline__ void a_ready(const Unit&) const {}
    __device__ __forceinline__ void done(const Unit&) const {}
};

__device__ __forceinline__ unsigned cvt_pk_bf16(float lo, float hi) { unsigned r; asm volatile("v_cvt_pk_bf16_f32 %0, %1, %2" : "=v"(r) : "v"(lo), "v"(hi)); return r; }
__device__ __forceinline__ float bf_lo(unsigned w) { return __uint_as_float(w << 16); }
__device__ __forceinline__ float bf_hi(unsigned w) { return __uint_as_float(w & 0xffff0000u); }
__device__ __forceinline__ float sigmoidf_(float x) { return __builtin_amdgcn_rcpf(1.0f + __builtin_amdgcn_exp2f(-1.4426950408889634f * x)); }
__device__ __forceinline__ u32x4 pack8(const f32x4& a, const f32x4& b) { u32x4 w; w.x = cvt_pk_bf16(a[0], a[1]); w.y = cvt_pk_bf16(a[2], a[3]); w.z = cvt_pk_bf16(b[0], b[1]); w.w = cvt_pk_bf16(b[2], b[3]); return w; }
__device__ __forceinline__ void unpack8(const u32x4& w, f32x4& a, f32x4& b) { a = (f32x4){bf_lo(w.x), bf_hi(w.x), bf_lo(w.y), bf_hi(w.y)}; b = (f32x4){bf_lo(w.z), bf_hi(w.z), bf_lo(w.w), bf_hi(w.w)}; }

struct EpiSwiglu {
    static constexpr bool PERM = true, AFTER_DRAIN = false;
    bf16_t* O; int ldc;
    __device__ __forceinline__ void operator()(const f32x4 (&acc)[2][2][4][2], const Unit& u, int wr, int wc, int fr, int fq) const {
        const int row0 = u.pm * BM + wr * 64 + fr, col0 = u.pn * HALF + wc * 32 + 8 * fq;
#pragma unroll
        for (int ai = 0; ai < 2; ++ai)
#pragma unroll
            for (int m = 0; m < 4; ++m) {
                f32x4 v[2];
#pragma unroll
                for (int n = 0; n < 2; ++n) { const f32x4 gt = acc[ai][0][m][n], up = acc[ai][1][m][n];
#pragma unroll
                    for (int e = 0; e < 4; ++e) v[n][e] = gt[e] * sigmoidf_(gt[e]) * up[e]; }
                *(u32x4*)(O + (size_t)(row0 + ai * HALF + m * 16) * ldc + col0) = pack8(v[0], v[1]);
            }
    }
};
struct EpiResid {
    static constexpr bool PERM = false, AFTER_DRAIN = false;
    float* H; int ldc; float s; float* SL;
    __device__ __forceinline__ void operator()(const f32x4 (&acc)[2][2][4][2], const Unit& u, int wr, int wc, int fr, int fq) const {
        if (u.slab >= 0) {
            float* base = SL + (size_t)u.slab * (BM * BM) + (size_t)(wr * 64 + fr) * BM + wc * 32 + 4 * fq;
#pragma unroll
            for (int ai = 0; ai < 2; ++ai)
#pragma unroll
                for (int m = 0; m < 4; ++m)
#pragma unroll
                    for (int bj = 0; bj < 2; ++bj)
#pragma unroll
                        for (int n = 0; n < 2; ++n) *(f32x4*)(base + (size_t)(ai * HALF + m * 16) * BM + bj * HALF + n * 16) = acc[ai][bj][m][n];
            return;
        }
        const int row0 = u.pm * BM + wr * 64 + fr, col0 = u.pn * BM + wc * 32 + 4 * fq;
#pragma unroll
        for (int ai = 0; ai < 2; ++ai)
#pragma unroll
            for (int m = 0; m < 4; ++m) { float* rowp = H + (size_t)(row0 + ai * HALF + m * 16) * ldc + col0;
#pragma unroll
                for (int bj = 0; bj < 2; ++bj)
#pragma unroll
                    for (int n = 0; n < 2; ++n) { f32x4* p = (f32x4*)(rowp + bj * HALF + n * 16); const f32x4 h = *p; *p = h + acc[ai][bj][m][n] * s; }
                if (m & 1) asm volatile("" ::: "memory"); }
    }
};
struct EpiProj {
    static constexpr bool PERM = true, AFTER_DRAIN = false;
    bf16_t *BG, *CV, *Z, *SGC, *SGP;
    __device__ __forceinline__ void operator()(const f32x4 (&acc)[2][2][4][2], const Unit& u, int wr, int wc, int fr, int fq) const {
        const int row0 = u.pm * BM + wr * 64 + fr, pn = u.pn;
        if (pn >= 8 && pn < 24) {
            const int col0 = (pn - 8) * HALF + wc * 32 + 8 * fq;
#pragma unroll
            for (int ai = 0; ai < 2; ++ai)
#pragma unroll
                for (int m = 0; m < 4; ++m)
                    *(u32x4*)(CV + (size_t)(row0 + ai * HALF + m * 16) * 2048 + col0) = pack8(acc[ai][0][m][0] * acc[ai][1][m][0], acc[ai][0][m][1] * acc[ai][1][m][1]);
        } else {
            bf16_t* base; int ld, ct; bool sg;
            if (pn < 8) { base = BG; ld = 2048; ct = pn; sg = false; }
            else if (pn < 28) { base = Z; ld = 1024; ct = pn - 24; sg = false; }
            else if (pn < 36) { base = SGC; ld = 2048; ct = pn - 28; sg = true; }
            else { base = SGP; ld = 2048; ct = pn - 36; sg = true; }
            const int col0 = ct * BM + wc * 32 + 8 * fq;
#pragma unroll
            for (int ai = 0; ai < 2; ++ai)
#pragma unroll
                for (int m = 0; m < 4; ++m) { bf16_t* rowp = base + (size_t)(row0 + ai * HALF + m * 16) * ld + col0;
#pragma unroll
                    for (int bj = 0; bj < 2; ++bj) { f32x4 v0 = acc[ai][bj][m][0], v1 = acc[ai][bj][m][1];
                        if (sg) {
#pragma unroll
                            for (int e = 0; e < 4; ++e) { v0[e] = sigmoidf_(v0[e]); v1[e] = sigmoidf_(v1[e]); } }
                        *(u32x4*)(rowp + bj * HALF) = pack8(v0, v1); } }
        }
    }
};
struct EpiPool {
    static constexpr bool PERM = true, AFTER_DRAIN = false;
    bf16_t* SGP; const float* ps;
    __device__ __forceinline__ void operator()(const f32x4 (&acc)[2][2][4][2], const Unit& u, int wr, int wc, int fr, int fq) const {
        const int row0 = u.pm * BM + wr * 64 + fr, col0 = u.pn * BM + wc * 32 + 8 * fq;
#pragma unroll
        for (int ai = 0; ai < 2; ++ai)
#pragma unroll
            for (int m = 0; m < 4; ++m) { bf16_t* rowp = SGP + (size_t)(row0 + ai * HALF + m * 16) * 2048 + col0;
#pragma unroll
                for (int bj = 0; bj < 2; ++bj) { u32x4* p = (u32x4*)(rowp + bj * HALF); f32x4 g0, g1; unpack8(*p, g0, g1);
                    const f32x4 s0 = *(const f32x4*)(ps + col0 + bj * HALF), s1 = *(const f32x4*)(ps + col0 + bj * HALF + 4);
                    *p = pack8(g0 * s0 * acc[ai][bj][m][0], g1 * s1 * acc[ai][bj][m][1]); }
                asm volatile("" ::: "memory"); }
    }
};
struct EpiMerge {
    static constexpr bool PERM = true, AFTER_DRAIN = false;
    bf16_t* SGC; const bf16_t* MP;
    __device__ __forceinline__ void operator()(const f32x4 (&acc)[2][2][4][2], const Unit& u, int wr, int wc, int fr, int fq) const {
        const int row0 = u.pm * BM + wr * 64 + fr, col0 = u.pn * BM + wc * 32 + 8 * fq;
#pragma unroll
        for (int ai = 0; ai < 2; ++ai)
#pragma unroll
            for (int m = 0; m < 4; ++m) { const size_t off = (size_t)(row0 + ai * HALF + m * 16) * 2048 + col0;
#pragma unroll
                for (int bj = 0; bj < 2; ++bj) { u32x4* p = (u32x4*)(SGC + off + bj * HALF); f32x4 g0, g1, q0, q1; unpack8(*p, g0, g1); unpack8(*(const u32x4*)(MP + off + bj * HALF), q0, q1);
                    *p = pack8(g0 * acc[ai][bj][m][0] + q0, g1 * acc[ai][bj][m][1] + q1); }
                if (m & 1) asm volatile("" ::: "memory"); }
    }
};

template <class Epi, class Sched, bool ALIGN_EPI = false, bool SP2 = false>
__device__ __forceinline__ void gemm_phase(PG8_LAS unsigned char* lds, const Gemm g, const Sched& S, const Epi& E) {
    int tid_ = threadIdx.x; asm volatile("" : "+v"(tid_));
    const int tid = tid_, wid = __builtin_amdgcn_readfirstlane(tid >> 6), lane = tid & 63, wr = wid >> 2, wc = wid & 3, fr = lane & 15, fq = lane >> 4;

    unsigned voffA[2], voffB[2];
#pragma unroll
    for (int i = 0; i < 2; ++i) { int R, C; stage_rc(tid * 16 + i * 8192, R, C); const int Rb = Epi::PERM ? ((R & ~31) + perm32(R & 31)) : R;
        voffA[i] = (unsigned)(R * g.lda + C) * 2u; voffB[i] = (unsigned)(Rb * g.ldb + C) * 2u; }
    const size_t kstep = (size_t)(BK * 2);
    const size_t hstepA = (size_t)HALF * g.lda * 2, hstepB = (size_t)HALF * g.ldb * 2;
    const size_t tstepA = 2 * hstepA, tstepB = 2 * hstepB;
    const unsigned ldsw = (unsigned)wid * 1024u;
    const int aoff = lds_byte(wr * 64 + fr, fq * 8), boff = lds_byte(wc * 32 + fr, fq * 8);
#define PG8_SA(b, h) (((b) * 2 + (h)) * HTB)
#define PG8_SB(b, h) ((4 + (b) * 2 + (h)) * HTB)
#define PG8_STAGE(bufoff, gbase, voff) do { _Pragma("unroll") for (int _i = 0; _i < 2; ++_i) \
        __builtin_amdgcn_global_load_lds((const unsigned*)((const char*)(gbase) + (voff)[_i]), (PG8_LAS unsigned*)(lds + (bufoff) + ldsw + _i * 8192), 16, 0, 0); } while (0)
#define PG8_LDA(dst, b, h) do { _Pragma("unroll") for (int m = 0; m < 4; ++m) _Pragma("unroll") for (int k = 0; k < 2; ++k) dst[m][k] = *(const PG8_LAS bf16x8*)(lds + PG8_SA(b, h) + aoff + m * 2048 + k * 1024); } while (0)
#define PG8_LDB(dst, b, h) do { _Pragma("unroll") for (int n = 0; n < 2; ++n) _Pragma("unroll") for (int k = 0; k < 2; ++k) dst[n][k] = *(const PG8_LAS bf16x8*)(lds + PG8_SB(b, h) + boff + n * 2048 + k * 1024); } while (0)
#define PG8_MMA(ai, bj, At, Bt) do { __builtin_amdgcn_s_setprio(1); _Pragma("unroll") for (int m = 0; m < 4; ++m) _Pragma("unroll") for (int n = 0; n < 2; ++n) _Pragma("unroll") for (int k = 0; k < 2; ++k) \
        acc[ai][bj][m][n] = __builtin_amdgcn_mfma_f32_16x16x32_bf16(Bt[n][k], At[m][k], acc[ai][bj][m][n], 0, 0, 0); __builtin_amdgcn_s_setprio(0); } while (0)
#define PG8_WAIT_V(n) asm volatile("s_waitcnt vmcnt(" #n ")" ::: "memory")
#define PG8_WAIT_L(n) asm volatile("s_waitcnt lgkmcnt(" #n ")" ::: "memory")
#define PG8_BAR __builtin_amdgcn_s_barrier()
#define PG8_SCHED __builtin_amdgcn_sched_barrier(0)
    Unit cur, nxt; int ui = 0;
    if (!S.next(0, cur)) return;
    f32x4 acc[2][2][4][2];
#pragma unroll
    for (int a = 0; a < 2; ++a)
#pragma unroll
        for (int b = 0; b < 2; ++b)
#pragma unroll
            for (int m = 0; m < 4; ++m)
#pragma unroll
                for (int n = 0; n < 2; ++n) acc[a][b][m][n] = (f32x4){0.f, 0.f, 0.f, 0.f};
    bf16x8 At[4][2], B0[2][2], B1[2][2];
    const char* cA = (const char*)g.A + (size_t)cur.pm * tstepA + acolb(g, cur) + (size_t)cur.kt0 * kstep; const char* cB = (const char*)g.Bt + (size_t)cur.pn * tstepB + (size_t)cur.kt0 * kstep;
    S.a_ready(cur);
    if constexpr (SP2) {
        PG8_STAGE(PG8_SB(0, 0), cB, voffB); PG8_STAGE(PG8_SB(0, 1), cB + hstepB, voffB); PG8_STAGE(PG8_SA(0, 0), cA, voffA); PG8_STAGE(PG8_SA(0, 1), cA + hstepA, voffA);
        if (wr == 1) PG8_BAR;
        PG8_WAIT_V(2); PG8_BAR;
        PG8_STAGE(PG8_SB(1, 0), cB + kstep, voffB); PG8_STAGE(PG8_SA(1, 0), cA + kstep, voffA); PG8_STAGE(PG8_SB(1, 1), cB + hstepB + kstep, voffB);
        PG8_WAIT_V(6); PG8_BAR;
    } else {
        PG8_STAGE(PG8_SB(0, 0), cB, voffB); PG8_STAGE(PG8_SA(0, 0), cA, voffA); PG8_STAGE(PG8_SB(0, 1), cB + hstepB, voffB); PG8_STAGE(PG8_SA(0, 1), cA + hstepA, voffA);
        if (wr == 1) PG8_BAR;
        PG8_WAIT_V(4); PG8_BAR;
        PG8_STAGE(PG8_SB(1, 0), cB + kstep, voffB); PG8_STAGE(PG8_SA(1, 0), cA + kstep, voffA); PG8_STAGE(PG8_SB(1, 1), cB + hstepB + kstep, voffB);
        PG8_WAIT_V(6); PG8_BAR;
    }
    for (;;) {
        const bool has_next = S.next(ui + 1, nxt);
        const char* nA = has_next ? (const char*)g.A + (size_t)nxt.pm * tstepA + acolb(g, nxt) + (size_t)nxt.kt0 * kstep : cA; const char* nB = has_next ? (const char*)g.Bt + (size_t)nxt.pn * tstepB + (size_t)nxt.kt0 * kstep : cB;
        const int nt = cur.nkt;
        for (int t = 0; t < nt; t += 2) {
            const bool last = (t == nt - 2);
            const char* a1 = cA + (size_t)(t + 1) * kstep;
            const char* a2 = last ? nA : cA + (size_t)(t + 2) * kstep; const char* b2 = last ? nB : cB + (size_t)(t + 2) * kstep;
            const char* a3 = a2 + kstep; const char* b3 = b2 + kstep;
            if (last && has_next) S.a_ready(nxt);
            if constexpr (SP2) {
            PG8_LDB(B0, 0, 0); PG8_LDB(B1, 0, 1); PG8_SCHED; PG8_LDA(At, 0, 0); PG8_STAGE(PG8_SA(1, 1), a1 + hstepA, voffA);
            PG8_WAIT_V(8); PG8_WAIT_L(0); PG8_BAR; PG8_MMA(0, 0, At, B0); PG8_MMA(0, 1, At, B1); PG8_BAR; PG8_SCHED;
            PG8_LDA(At, 0, 1); PG8_STAGE(PG8_SB(0, 0), b2, voffB); PG8_STAGE(PG8_SB(0, 1), b2 + hstepB, voffB); PG8_STAGE(PG8_SA(0, 0), a2, voffA);
            PG8_WAIT_V(8); PG8_WAIT_L(0); PG8_BAR; PG8_MMA(1, 0, At, B0); PG8_MMA(1, 1, At, B1); PG8_BAR; PG8_SCHED;
            PG8_LDB(B0, 1, 0); PG8_LDB(B1, 1, 1); PG8_SCHED; PG8_LDA(At, 1, 0); PG8_STAGE(PG8_SA(0, 1), a2 + hstepA, voffA);
            PG8_WAIT_V(8); PG8_WAIT_L(0); PG8_BAR; PG8_MMA(0, 0, At, B0); PG8_MMA(0, 1, At, B1); PG8_BAR; PG8_SCHED;
            PG8_LDA(At, 1, 1); PG8_STAGE(PG8_SB(1, 0), b3, voffB); PG8_STAGE(PG8_SB(1, 1), b3 + hstepB, voffB); PG8_STAGE(PG8_SA(1, 0), a3, voffA);
            PG8_WAIT_V(8); PG8_WAIT_L(0); PG8_BAR; PG8_MMA(1, 0, At, B0); PG8_MMA(1, 1, At, B1); PG8_BAR; PG8_SCHED;
            } else {
            PG8_LDB(B0, 0, 0); PG8_SCHED; PG8_LDA(At, 0, 0); PG8_STAGE(PG8_SA(1, 1), a1 + hstepA, voffA);
            PG8_WAIT_L(8); PG8_BAR; PG8_WAIT_L(0); PG8_MMA(0, 0, At, B0); PG8_BAR; PG8_SCHED;
            PG8_LDB(B1, 0, 1); PG8_STAGE(PG8_SB(0, 0), b2, voffB);
            PG8_BAR; PG8_WAIT_L(0); PG8_MMA(0, 1, At, B1); PG8_BAR;
            PG8_LDA(At, 0, 1); PG8_STAGE(PG8_SA(0, 0), a2, voffA);
            PG8_BAR; PG8_WAIT_L(0); PG8_MMA(1, 0, At, B0); PG8_BAR; PG8_SCHED;
            PG8_STAGE(PG8_SB(0, 1), b2 + hstepB, voffB);
            PG8_WAIT_V(6); PG8_BAR; PG8_MMA(1, 1, At, B1); PG8_BAR;
            PG8_LDB(B0, 1, 0); PG8_SCHED; PG8_LDA(At, 1, 0); PG8_STAGE(PG8_SA(0, 1), a2 + hstepA, voffA);
            PG8_WAIT_L(8); PG8_BAR; PG8_WAIT_L(0); PG8_MMA(0, 0, At, B0); PG8_BAR; PG8_SCHED;
            PG8_LDB(B1, 1, 1); PG8_STAGE(PG8_SB(1, 0), b3, voffB);
            PG8_BAR; PG8_WAIT_L(0); PG8_MMA(0, 1, At, B1); PG8_BAR;
            PG8_LDA(At, 1, 1); PG8_STAGE(PG8_SA(1, 0), a3, voffA);
            PG8_BAR; PG8_WAIT_L(0); PG8_MMA(1, 0, At, B0); PG8_BAR; PG8_SCHED;
            PG8_STAGE(PG8_SB(1, 1), b3 + hstepB, voffB);
            PG8_WAIT_V(6); PG8_BAR; PG8_MMA(1, 1, At, B1); PG8_BAR;
            }
        }
        if constexpr (ALIGN_EPI) { if (wr == 0) PG8_BAR; }
        if constexpr (!Epi::AFTER_DRAIN) { E(acc, cur, wr, wc, fr, fq); S.done(cur); }
        if (!has_next) break;
#pragma unroll
        for (int a = 0; a < 2; ++a)
#pragma unroll
            for (int b = 0; b < 2; ++b)
#pragma unroll
                for (int m = 0; m < 4; ++m)
#pragma unroll
                    for (int n = 0; n < 2; ++n) acc[a][b][m][n] = (f32x4){0.f, 0.f, 0.f, 0.f};
        cur = nxt; cA = nA; cB = nB; ++ui;
        if constexpr (ALIGN_EPI) { if (wr == 1) PG8_BAR; }
    }
    PG8_WAIT_V(0);
    if constexpr (!ALIGN_EPI) { if (wr == 0) PG8_BAR; }
    PG8_BAR;
    if constexpr (Epi::AFTER_DRAIN) { E.fused(acc, cur, wr, wc, fr, fq, lds, wid, lane); S.done(cur); }
#undef PG8_SA
#undef PG8_SB
#undef PG8_STAGE
#undef PG8_LDA
#undef PG8_LDB
#undef PG8_MMA
#undef PG8_WAIT_V
#undef PG8_WAIT_L
#undef PG8_BAR
#undef PG8_SCHED
}
}

constexpr int DM = 2048, NB = 4, SEQ = 2048, NMETA = 16, LP = SEQ + NMETA  , DECB = 128, DECS = 8;
constexpr int DFF = 5632, DPOOL = 1024, DIN = 11264;
constexpr int MP_ROWS = NB * LP;
constexpr int MS_ROWS = DECB * DECS;
constexpr int MREAL = MP_ROWS + MS_ROWS;
constexpr int MPAD = 9472;
constexpr float EPS = 1e-6f;
constexpr int NWAVES = 8;

constexpr size_t O_YP = 0, O_YS = O_YP + (size_t)NB * SEQ * DM, O_NCP = O_YS + (size_t)MS_ROWS * DM, O_NPP = O_NCP + (size_t)NB * 2 * DM,
                 O_NCS = O_NPP + (size_t)NB * 15 * DPOOL, O_NPS = O_NCS + (size_t)DECB * 2 * DM, O_END = O_NPS + (size_t)DECB * 15 * DPOOL;

constexpr size_t MiB = 1u << 20;
constexpr size_t WS_W1GU = 1 * MiB;
constexpr size_t WS_W1D = WS_W1GU + 44 * MiB;
constexpr size_t WS_WIN = WS_W1D + 22 * MiB;
constexpr size_t WS_WCO = WS_WIN + 44 * MiB;
constexpr size_t WS_WPG = WS_WCO + 8 * MiB;
constexpr size_t WS_WO = WS_WPG + 1 * MiB;
constexpr size_t WS_W2GU = WS_WO + 8 * MiB;
constexpr size_t WS_W2D = WS_W2GU + 44 * MiB;
constexpr size_t WS_H = WS_W2D + 22 * MiB;
constexpr size_t WS_R = WS_H + 74 * MiB;
constexpr size_t WS_BG = WS_R, WS_CV = WS_R + 37 * MiB, WS_SGC = WS_R + 74 * MiB, WS_SGP = WS_R + 111 * MiB, WS_Z = WS_R + 148 * MiB, WS_PL = WS_Z + 19 * MiB;
constexpr size_t WS_XN1 = WS_SGP;
constexpr size_t WS_END = WS_PL + 19 * MiB;
static_assert((size_t)MPAD * DFF * 2 <= 111 * MiB, "ACT fits below XN1");

#define GAS __attribute__((address_space(1)))
#define LAS __attribute__((address_space(3)))
typedef unsigned short bf16;
typedef unsigned v4u __attribute__((ext_vector_type(4)));
typedef float f32x4 __attribute__((ext_vector_type(4)));
#define LDS_WAIT() asm volatile("s_waitcnt lgkmcnt(0)" ::: "memory")
constexpr int LDS_BYTES = 147456;

struct Args {
    const float *x_prompt, *x_sample, *state_conv, *state_pool, *meta, *norm_ffn1, *w1g, *w1u, *w1d, *norm_mix, *w_in, *conv_w, *w_conv_out, *w_pool, *pool_scale, *w_o, *norm_ffn2, *w2g, *w2u, *w2d, *norm_final;
    float* out; unsigned char* ws;
};

__device__ __forceinline__ unsigned pk2(float lo, float hi) { return pg8::cvt_pk_bf16(lo, hi); }
__device__ __forceinline__ float wave_sum(float v) {
#pragma unroll
    for (int o = 1; o < 64; o <<= 1) v += __shfl_xor(v, o);
    return v;
}
__device__ __forceinline__ const float* src_row(const Args& a, int r) {
    if (r < MP_ROWS) { const int b = r / LP, t = r - b * LP; return t < NMETA ? a.meta + (size_t)t * DM : a.x_prompt + ((size_t)b * SEQ + (t - NMETA)) * DM; }
    if (r < MREAL) return a.x_sample + (size_t)(r - MP_ROWS) * DM;
    return nullptr;
}
__device__ __forceinline__ void p0_transpose_item(const float* W, int N, bf16* WT, int K, int k0, int n0, int drow0, LAS float* scr, int lane) {
    const int lr = lane >> 4, lc = (lane & 15) * 4;
    f32x4 v[16];
#pragma unroll
    for (int i = 0; i < 16; ++i) v[i] = *(const f32x4*)(W + (size_t)(k0 + 4 * i + lr) * N + n0 + lc);
#pragma unroll
    for (int i = 0; i < 16; ++i) { LAS float* s = scr + (4 * i + lr) * 65 + lc; s[0] = v[i].x; s[1] = v[i].y; s[2] = v[i].z; s[3] = v[i].w; }
    LDS_WAIT(); asm volatile("" ::: "memory");
    const int c = lane & 7;
#pragma unroll
    for (int j = 0; j < 8; ++j) { const int n = (lane >> 3) + 8 * j; const LAS float* s = scr + (8 * c) * 65 + n;
        v4u o; o.x = pk2(s[0 * 65], s[1 * 65]); o.y = pk2(s[2 * 65], s[3 * 65]); o.z = pk2(s[4 * 65], s[5 * 65]); o.w = pk2(s[6 * 65], s[7 * 65]);
        *(v4u*)(WT + (size_t)(drow0 + n) * K + k0 + 8 * c) = o; }
    LDS_WAIT(); asm volatile("" ::: "memory");
}
__device__ __forceinline__ bool p0_job(int& r, const float* W, int K, int N, bf16* WT, int kind, int roff, LAS float* scr, int lane) {
    const int nb = N / 64, items = (K / 64) * nb;
    if (r >= items) { r -= items; return false; }
    const int kb = r / nb, n0 = (r % nb) * 64;
    int d;
    if (kind == 0) d = roff + n0;
    else if (kind == 1) d = (n0 >> 7) * 256 + (n0 & 127);
    else if (kind == 2) d = (n0 >> 7) * 256 + 128 + (n0 & 127);
    else { if (n0 < 2048 || n0 >= 6144) d = n0; else if (n0 < 4096) { const int j = n0 - 2048; d = 2048 + (j >> 7) * 256 + (j & 127); } else { const int j = n0 - 4096; d = 2048 + (j >> 7) * 256 + 128 + (j & 127); } }
    p0_transpose_item(W, N, WT, K, kb * 64, n0, d, scr, lane);
    return true;
}
__device__ __forceinline__ f32x4 slab_sum(const float* SL, int m, int j, int lane) {
    const float* p = SL + (size_t)(((m >> 8) - 32) * 8 + j) * 6 * 65536 + (size_t)(m & 255) * 256 + 4 * lane;
    f32x4 a = *(const f32x4*)p;
#pragma unroll
    for (int ch = 1; ch < 6; ++ch) a += *(const f32x4*)(p + (size_t)ch * 65536);
    return a;
}
__device__ __forceinline__ void rms_row_bf16(const float* xrow, const float* g, bf16* orow, float* hcopy, int lane, const float* SL = nullptr, float sc = 0.f, int m = 0) {
    f32x4 v[8]; float s = 0.f;
    if (xrow) {
        if (SL && m >= 8192) {
            hcopy = (float*)xrow;
#pragma unroll
            for (int j = 0; j < 8; ++j) { v[j] = ((const f32x4*)xrow)[lane + 64 * j] + slab_sum(SL, m, j, lane) * sc; s += (v[j].x * v[j].x + v[j].y * v[j].y) + (v[j].z * v[j].z + v[j].w * v[j].w); }
        } else {
#pragma unroll
        for (int j = 0; j < 8; ++j) { v[j] = ((const f32x4*)xrow)[lane + 64 * j]; s += (v[j].x * v[j].x + v[j].y * v[j].y) + (v[j].z * v[j].z + v[j].w * v[j].w); }
        }
    } else {
#pragma unroll
        for (int j = 0; j < 8; ++j) v[j] = (f32x4){0.f, 0.f, 0.f, 0.f};
    }
    const float r = 1.0f / sqrtf(wave_sum(s) * (1.0f / DM) + EPS);
#pragma unroll
    for (int j = 0; j < 8; ++j) {
        if (hcopy) ((f32x4*)hcopy)[lane + 64 * j] = v[j];
        const f32x4 gg = ((const f32x4*)g)[lane + 64 * j];
        const unsigned lo = pk2(v[j].x * r * gg.x, v[j].y * r * gg.y), hi = pk2(v[j].z * r * gg.z, v[j].w * r * gg.w);
        ((unsigned long long*)orow)[lane + 64 * j] = (unsigned long long)lo | ((unsigned long long)hi << 32);
    }
}
__device__ __forceinline__ void load8_bf16(const bf16* p, float (&o)[8]) { const v4u w = *(const v4u*)p; o[0] = pg8::bf_lo(w.x); o[1] = pg8::bf_hi(w.x); o[2] = pg8::bf_lo(w.y); o[3] = pg8::bf_hi(w.y); o[4] = pg8::bf_lo(w.z); o[5] = pg8::bf_hi(w.z); o[6] = pg8::bf_lo(w.w); o[7] = pg8::bf_hi(w.w); }
__device__ __forceinline__ void load8_f32(const float* p, float (&o)[8]) { const f32x4 a = ((const f32x4*)p)[0], b = ((const f32x4*)p)[1]; o[0] = a.x; o[1] = a.y; o[2] = a.z; o[3] = a.w; o[4] = b.x; o[5] = b.y; o[6] = b.z; o[7] = b.w; }
__device__ __forceinline__ void store8_f32(float* p, const float (&o)[8]) { ((f32x4*)p)[0] = (f32x4){o[0], o[1], o[2], o[3]}; ((f32x4*)p)[1] = (f32x4){o[4], o[5], o[6], o[7]}; }


#define XB_TMO      128
#define XB_XCNT(j)  (256  + 64 * (j))
#define XB_XSUB(j)  (1280 + 64 * (j))
#define XB_XGEN(j)  (2304 + 64 * (j))
#define XB_TOP      3328
#define XB_TOPGEN   3392
#define XCD_BAR_WORDS 3456
#define XB_SPIN_CAP (1u << 18)

__device__ __forceinline__ unsigned xb_ld(unsigned* p)              { return __hip_atomic_load(p, __ATOMIC_RELAXED, __HIP_MEMORY_SCOPE_AGENT); }
__device__ __forceinline__ unsigned xb_add(unsigned* p, unsigned v) { return __hip_atomic_fetch_add(p, v, __ATOMIC_RELAXED, __HIP_MEMORY_SCOPE_AGENT); }
__device__ __forceinline__ unsigned xb_xcc_id() { return (unsigned)__builtin_amdgcn_s_getreg((3 << 11) | 20) & 0xFu; }
#define XB_SPIN(cond, bar) do { unsigned _sp = 0; while (cond) { __builtin_amdgcn_s_sleep(1); \
    if ((++_sp & 255u) == 0u) { if (xb_ld(&(bar)[XB_TMO])) break; if (_sp > XB_SPIN_CAP) { atomicAdd(&(bar)[XB_TMO], 1u); break; } } } } while (0)

struct XcdBarrier {
    unsigned* bar; unsigned x;
    volatile LAS unsigned* st;
};

__device__ __forceinline__ XcdBarrier xcd_barrier_post(unsigned* bar, volatile LAS unsigned* st) {
    XcdBarrier b; b.bar = bar; b.x = xb_xcc_id(); b.st = st;
    if (threadIdx.x == 0) (void)xb_add(&bar[XB_XCNT(b.x)], 1u);
    return b;
}
__device__ __forceinline__ void xcd_barrier_complete(unsigned* bar, unsigned x, unsigned& nloc, unsigned& nx) {
    const unsigned G = gridDim.x * gridDim.y * gridDim.z;
    unsigned sum, cnt, mine, sp = 0u;
    for (;;) {
        sum = 0u; cnt = 0u; mine = 0u;
#pragma unroll
        for (unsigned j = 0; j < 16; ++j) { const unsigned c = xb_ld(&bar[XB_XCNT(j)]); sum += c; cnt += (c > 0u) ? 1u : 0u; mine = (j == x) ? c : mine; }
        if (sum == G) break;
        __builtin_amdgcn_s_sleep(1);
        if ((++sp & 255u) == 0u) { if (xb_ld(&bar[XB_TMO])) break; if (sp > XB_SPIN_CAP) { atomicAdd(&bar[XB_TMO], 1u); break; } }
    }
    nloc = mine > 0u ? mine : 1u; nx = cnt > 0u ? cnt : 1u;
}

__device__ __forceinline__ void xcd_barrier(const XcdBarrier& b) {
    asm volatile("s_waitcnt vmcnt(0)" ::: "memory");
    __syncthreads();
    if (threadIdx.x == 0) {
        unsigned* bar = b.bar;
        __builtin_amdgcn_s_waitcnt(0);
        unsigned nloc = b.st[0], nx = b.st[1];
        if (nloc == 0u) { xcd_barrier_complete(bar, b.x, nloc, nx); b.st[0] = nloc; b.st[1] = nx; }
        const unsigned old = xb_add(&bar[XB_XSUB(b.x)], 1u);
        const unsigned gen = old / nloc;
        if (old + 1u == (gen + 1u) * nloc) {
            __builtin_amdgcn_fence(__ATOMIC_RELEASE, "agent");
            asm volatile("s_waitcnt vmcnt(0)" ::: "memory");
            const unsigned og = xb_add(&bar[XB_TOP], 1u);
            const unsigned tg = og / nx;
            if (og + 1u == (tg + 1u) * nx) xb_add(&bar[XB_TOPGEN], 1u);
            else XB_SPIN(xb_ld(&bar[XB_TOPGEN]) == tg, bar);
            __builtin_amdgcn_fence(__ATOMIC_ACQUIRE, "agent");
            xb_add(&bar[XB_XGEN(b.x)], 1u);
            asm volatile("s_waitcnt vmcnt(0)" ::: "memory");
        } else {
            XB_SPIN(xb_ld(&bar[XB_XGEN(b.x)]) == gen, bar);
            __builtin_amdgcn_fence(__ATOMIC_ACQUIRE, "agent");
            asm volatile("s_waitcnt vmcnt(0)" ::: "memory");
        }
    }
    __syncthreads();
}

__global__ void __launch_bounds__(NWAVES * 64) fwd_megakernel(Args a) {
    extern __shared__ __attribute__((aligned(16))) unsigned char lds_raw[];
    cg::grid_group grid = cg::this_grid();
    LAS unsigned char* lds = (LAS unsigned char*)lds_raw;
    const int tid = threadIdx.x, lane = tid & 63, wave = __builtin_amdgcn_readfirstlane(tid >> 6);
    const int G = gridDim.x, bx = blockIdx.x;
    const int gw = bx * NWAVES + wave, NGW = G * NWAVES;
    unsigned char* ws = a.ws;
    bf16 *W1GU = (bf16*)(ws + WS_W1GU), *W1D = (bf16*)(ws + WS_W1D), *WIN = (bf16*)(ws + WS_WIN), *WCO = (bf16*)(ws + WS_WCO), *WPG = (bf16*)(ws + WS_WPG), *WO = (bf16*)(ws + WS_WO),
         *W2GU = (bf16*)(ws + WS_W2GU), *W2D = (bf16*)(ws + WS_W2D);
    float* H = (float*)(ws + WS_H);
    bf16 *ACT = (bf16*)(ws + WS_R), *BG = (bf16*)(ws + WS_BG), *CV = (bf16*)(ws + WS_CV), *SGC = (bf16*)(ws + WS_SGC), *SGP = (bf16*)(ws + WS_SGP), *Z = (bf16*)(ws + WS_Z), *PL = (bf16*)(ws + WS_PL);
    bf16 *XN1 = (bf16*)(ws + WS_XN1), *XN = (bf16*)(ws + WS_W1GU);
    float* SLAB = (float*)(ws + WS_SGP);
    volatile LAS unsigned* MISC = (volatile LAS unsigned*)(lds + LDS_BYTES - 128);
    if (tid < 32) MISC[tid] = 0u;
    unsigned* barw = (unsigned*)ws;
    if (bx == 0) for (int i = tid; i < XCD_BAR_WORDS; i += NWAVES * 64) __hip_atomic_store(barw + i, 0u, __ATOMIC_RELAXED, __HIP_MEMORY_SCOPE_AGENT);
    __syncthreads();

    {
        LAS float* scr = (LAS float*)(lds + wave * 16640);
        constexpr int IT_GU = (DM / 64) * (DFF / 64), IT_D = (DFF / 64) * (DM / 64), IT_IN = (DM / 64) * (DIN / 64), IT_SQ = (DM / 64) * (DM / 64), IT_PG = (256 / 64) * (512 / 64);
        constexpr int NITEMS = 4 * IT_GU + 2 * IT_D + IT_IN + 2 * IT_SQ + 4 * IT_PG;
        for (int it = gw; it < NITEMS; it += NGW) {
            int r = it;
            if (p0_job(r, a.w1g, DM, DFF, W1GU, 1, 0, scr, lane)) continue;
            if (p0_job(r, a.w1u, DM, DFF, W1GU, 2, 0, scr, lane)) continue;
            if (p0_job(r, a.w1d, DFF, DM, W1D, 0, 0, scr, lane)) continue;
            if (p0_job(r, a.w_in, DM, DIN, WIN, 3, 0, scr, lane)) continue;
            if (p0_job(r, a.w_conv_out, DM, DM, WCO, 0, 0, scr, lane)) continue;
            if (p0_job(r, a.w_o, DM, DM, WO, 0, 0, scr, lane)) continue;
            if (p0_job(r, a.w2g, DM, DFF, W2GU, 1, 0, scr, lane)) continue;
            if (p0_job(r, a.w2u, DM, DFF, W2GU, 2, 0, scr, lane)) continue;
            if (p0_job(r, a.w2d, DFF, DM, W2D, 0, 0, scr, lane)) continue;
            if (p0_job(r, a.w_pool + 0 * 256 * 512, 256, 512, WPG, 0, 0, scr, lane)) continue;
            if (p0_job(r, a.w_pool + 1 * 256 * 512, 256, 512, WPG, 0, 512, scr, lane)) continue;
            if (p0_job(r, a.w_pool + 2 * 256 * 512, 256, 512, WPG, 0, 1024, scr, lane)) continue;
            p0_job(r, a.w_pool + 3 * 256 * 512, 256, 512, WPG, 0, 1536, scr, lane);
        }
        for (int m = gw; m < MPAD; m += NGW) rms_row_bf16(src_row(a, m), a.norm_ffn1, XN1 + (size_t)m * DM, H + (size_t)m * DM, lane);
    }
    grid.sync();
    const XcdBarrier bar = xcd_barrier_post(barw, MISC + 8);

    {
        pg8::Gemm g{XN1, W1GU, MPAD, 2 * DFF, DM, DM, DM, 0}; pg8::StaticOrder S; S.init(MPAD, 2 * DFF, DM, G, bx);
        pg8::EpiSwiglu E{ACT, DFF};
        pg8::gemm_phase<pg8::EpiSwiglu, pg8::StaticOrder, true, true>(lds, g, S, E);
    }
    xcd_barrier(bar);
    {
        pg8::Gemm g{ACT, W1D, MPAD, DM, DFF, DFF, DFF, 0}; pg8::TailOrder S; S.init(DFF, bx);
        pg8::EpiResid E{H, DM, 0.5f, SLAB};
        pg8::gemm_phase<pg8::EpiResid, pg8::TailOrder, true, true>(lds, g, S, E);
    }
    xcd_barrier(bar);
    for (int m = gw; m < MPAD; m += NGW) rms_row_bf16(H + (size_t)m * DM, a.norm_mix, XN + (size_t)m * DM, nullptr, lane, SLAB, 0.5f, m);
    xcd_barrier(bar);
    {
        pg8::Gemm g{XN, WIN, MPAD, DIN, DM, DM, DM, 0}; pg8::StaticOrder S; S.init(MPAD, DIN, DM, G, bx);
        pg8::EpiProj E{BG, CV, Z, SGC, SGP};
        pg8::gemm_phase<pg8::EpiProj, pg8::StaticOrder, true, true>(lds, g, S, E);
    }
    xcd_barrier(bar);
    for (int m = gw; m < MREAL; m += NGW) {
        const bool smp = m >= MP_ROWS;
        int sq, t, L;
        if (smp) { sq = (m - MP_ROWS) >> 3; t = (m - MP_ROWS) & 7; L = DECS; } else { sq = m / LP; t = m - sq * LP; L = LP; }
        const float* sc = a.state_conv + (size_t)sq * 2 * DM;
        const float* sp = a.state_pool + (size_t)sq * 15 * DPOOL;
        float* ncv = (t >= L - 2) ? (smp ? a.out + O_NCS + ((size_t)sq * 2 + (t - (L - 2))) * DM : a.out + O_NCP + ((size_t)sq * 2 + (t - (L - 2))) * DM) : nullptr;
#pragma unroll 1
        for (int j = 0; j < 4; ++j) {
            const int col = 512 * j + 8 * lane;
            float c0[8], c1[8], c2[8], bg[8], w0[8], w1[8], w2[8], o[8];
            load8_bf16(CV + (size_t)m * DM + col, c2);
            if (t >= 1) load8_bf16(CV + (size_t)(m - 1) * DM + col, c1); else if (smp) load8_f32(sc + (size_t)1 * DM + col, c1); else {
#pragma unroll
                for (int e = 0; e < 8; ++e) c1[e] = 0.f; }
            if (t >= 2) load8_bf16(CV + (size_t)(m - 2) * DM + col, c0); else if (smp) load8_f32(sc + (size_t)t * DM + col, c0); else {
#pragma unroll
                for (int e = 0; e < 8; ++e) c0[e] = 0.f; }
            load8_bf16(BG + (size_t)m * DM + col, bg);
            load8_f32(a.conv_w + col, w0); load8_f32(a.conv_w + DM + col, w1); load8_f32(a.conv_w + 2 * DM + col, w2);
#pragma unroll
            for (int e = 0; e < 8; ++e) o[e] = bg[e] * (w0[e] * c0[e] + w1[e] * c1[e] + w2[e] * c2[e]);
            v4u w; w.x = pk2(o[0], o[1]); w.y = pk2(o[2], o[3]); w.z = pk2(o[4], o[5]); w.w = pk2(o[6], o[7]);
            *(v4u*)(BG + (size_t)m * DM + col) = w;
            if (ncv) store8_f32(ncv + col, c2);
        }
        float* npp = nullptr;
        if (smp) npp = a.out + O_NPS + ((size_t)sq * 15 + 7 + t) * DPOOL; else if (t >= L - 15) npp = a.out + O_NPP + ((size_t)sq * 15 + (t - (L - 15))) * DPOOL;
#pragma unroll 1
        for (int j = 0; j < 2; ++j) {
            const int col = 512 * j + 8 * lane, gq = col >> 8, k = 2 << gq, kmax = j ? 16 : 4;
            float z0[8], s[8], zi[8];
            load8_bf16(Z + (size_t)m * DPOOL + col, z0);
#pragma unroll
            for (int e = 0; e < 8; ++e) s[e] = z0[e];
#pragma unroll 1
            for (int i = 1; i < kmax; ++i) {
                if (t - i >= 0) load8_bf16(Z + (size_t)(m - i) * DPOOL + col, zi);
                else if (smp) load8_f32(sp + (size_t)(15 + t - i) * DPOOL + col, zi);
                else break;
                if (i < k) {
#pragma unroll
                    for (int e = 0; e < 8; ++e) s[e] += zi[e]; }
            }
            const int cnt = smp ? k : (k < t + 1 ? k : t + 1);
            const float inv = 1.0f / (float)cnt;
            float o[8];
#pragma unroll
            for (int e = 0; e < 8; ++e) o[e] = s[e] * inv - z0[e];
            v4u w; w.x = pk2(o[0], o[1]); w.y = pk2(o[2], o[3]); w.z = pk2(o[4], o[5]); w.w = pk2(o[6], o[7]);
            *(v4u*)(PL + (size_t)m * DPOOL + col) = w;
            if (npp) store8_f32(npp + col, z0);
            if (smp && t < 7) { float q[8]; load8_f32(sp + (size_t)(8 + t) * DPOOL + col, q); store8_f32(a.out + O_NPS + ((size_t)sq * 15 + t) * DPOOL + col, q); }
        }
    }
    xcd_barrier(bar);
    {
        pg8::Gemm g{PL, WPG, MPAD, DM, 256, DPOOL, 256, 1}; pg8::StaticOrder S; S.init(MPAD, DM, 256, G, bx);
        pg8::EpiPool E{SGP, a.pool_scale};
        pg8::gemm_phase<pg8::EpiPool, pg8::StaticOrder, true, true>(lds, g, S, E);
    }
    __syncthreads();
    {
        pg8::Gemm g{BG, WCO, MPAD, DM, DM, DM, DM, 0}; pg8::StaticOrder S; S.init(MPAD, DM, DM, G, bx);
        pg8::EpiMerge E{SGC, SGP};
        pg8::gemm_phase<pg8::EpiMerge, pg8::StaticOrder, true, true>(lds, g, S, E);
    }
    xcd_barrier(bar);
    {
        pg8::Gemm g{SGC, WO, MPAD, DM, DM, DM, DM, 0}; pg8::TailOrder S; S.init(DM, bx);
        pg8::EpiResid E{H, DM, 1.0f, SLAB};
        pg8::gemm_phase<pg8::EpiResid, pg8::TailOrder, true, true>(lds, g, S, E);
    }
    xcd_barrier(bar);
    for (int m = gw; m < MPAD; m += NGW) rms_row_bf16(H + (size_t)m * DM, a.norm_ffn2, XN + (size_t)m * DM, nullptr, lane, SLAB, 1.0f, m);
    xcd_barrier(bar);
    {
        pg8::Gemm g{XN, W2GU, MPAD, 2 * DFF, DM, DM, DM, 0}; pg8::StaticOrder S; S.init(MPAD, 2 * DFF, DM, G, bx);
        pg8::EpiSwiglu E{ACT, DFF};
        pg8::gemm_phase<pg8::EpiSwiglu, pg8::StaticOrder, true, true>(lds, g, S, E);
    }
    xcd_barrier(bar);
    {
        pg8::Gemm g{ACT, W2D, MPAD, DM, DFF, DFF, DFF, 0}; pg8::TailOrder S; S.init(DFF, bx);
        pg8::EpiResid E{H, DM, 0.5f, SLAB};
        pg8::gemm_phase<pg8::EpiResid, pg8::TailOrder, true, true>(lds, g, S, E);
    }
    xcd_barrier(bar);
    for (int m = gw; m < MREAL; m += NGW) {
        float* dst;
        if (m < MP_ROWS) { const int b = m / LP, t = m - b * LP; if (t < NMETA) continue; dst = a.out + O_YP + ((size_t)b * SEQ + (t - NMETA)) * DM; }
        else dst = a.out + O_YS + (size_t)(m - MP_ROWS) * DM;
        const float* hr = H + (size_t)m * DM;
        f32x4 v[8]; float s = 0.f;
#pragma unroll
        for (int j = 0; j < 8; ++j) { v[j] = ((const f32x4*)hr)[lane + 64 * j]; if (m >= 8192) v[j] += slab_sum(SLAB, m, j, lane) * 0.5f; s += (v[j].x * v[j].x + v[j].y * v[j].y) + (v[j].z * v[j].z + v[j].w * v[j].w); }
        const float r = 1.0f / sqrtf(wave_sum(s) * (1.0f / DM) + EPS);
#pragma unroll
        for (int j = 0; j < 8; ++j) { const f32x4 gg = ((const f32x4*)a.norm_final)[lane + 64 * j]; ((f32x4*)dst)[lane + 64 * j] = v[j] * r * gg; }
    }
}

extern "C" void kernel_launch(void* const* d_in, const int* in_sizes, int n_in, void* d_out, int out_size, void* d_ws, size_t ws_size, hipStream_t stream) {
    static int grid = 0;
    if (grid == 0) {
        if (n_in != 21 || (size_t)out_size != O_END || ws_size < WS_END) { fprintf(stderr, "kernel_launch: unexpected shapes: n_in %d out %d ws %zu (need %zu)\n", n_in, out_size, ws_size, (size_t)WS_END); grid = -1; return; }
        int dev = 0, cus = 0, per_cu = 0;
        hipGetDevice(&dev); hipDeviceGetAttribute(&cus, hipDeviceAttributeMultiprocessorCount, dev);
        if (hipFuncSetAttribute((const void*)fwd_megakernel, hipFuncAttributeMaxDynamicSharedMemorySize, LDS_BYTES) != hipSuccess) { fprintf(stderr, "kernel_launch: hipFuncSetAttribute failed\n"); grid = -1; return; }
        if (hipOccupancyMaxActiveBlocksPerMultiprocessor(&per_cu, (const void*)fwd_megakernel, NWAVES * 64, LDS_BYTES) != hipSuccess || per_cu < 1) { fprintf(stderr, "kernel_launch: occupancy query failed (%d)\n", per_cu); (void)hipGetLastError(); per_cu = 1; }
        grid = cus * 1;
        fprintf(stderr, "kernel_launch: grid %d (cus %d, per_cu %d)\n", grid, cus, per_cu);
    }
    if (grid < 0) return;
    Args a{};
    a.x_prompt = (const float*)d_in[0]; a.x_sample = (const float*)d_in[1]; a.state_conv = (const float*)d_in[2]; a.state_pool = (const float*)d_in[3]; a.meta = (const float*)d_in[4];
    a.norm_ffn1 = (const float*)d_in[5]; a.w1g = (const float*)d_in[6]; a.w1u = (const float*)d_in[7]; a.w1d = (const float*)d_in[8]; a.norm_mix = (const float*)d_in[9]; a.w_in = (const float*)d_in[10];
    a.conv_w = (const float*)d_in[11]; a.w_conv_out = (const float*)d_in[12]; a.w_pool = (const float*)d_in[13]; a.pool_scale = (const float*)d_in[14]; a.w_o = (const float*)d_in[15];
    a.norm_ffn2 = (const float*)d_in[16]; a.w2g = (const float*)d_in[17]; a.w2u = (const float*)d_in[18]; a.w2d = (const float*)d_in[19]; a.norm_final = (const float*)d_in[20];
    a.out = (float*)d_out; a.ws = (unsigned char*)d_ws;
    void* args[] = {&a};
    hipError_t e = hipLaunchCooperativeKernel((const void*)fwd_megakernel, dim3(grid), dim3(NWAVES * 64), args, LDS_BYTES, stream);
    if (e != hipSuccess) fprintf(stderr, "kernel_launch: cooperative launch failed: %s (grid %d)\n", hipGetErrorString(e), grid);
}
```

```cpp
#include <hip/hip_runtime.h>
#include <hip/hip_cooperative_groups.h>
#include <cstdio>
#include <cstdint>
namespace cg = cooperative_groups;

namespace pg8 {
#define PG8_LAS __attribute__((address_space(3)))
typedef unsigned short bf16_t;
typedef short bf16x8 __attribute__((ext_vector_type(8)));
typedef float f32x4 __attribute__((ext_vector_type(4)));
typedef unsigned u32x4 __attribute__((ext_vector_type(4)));
constexpr int BM = 256, BK = 64, HALF = 128, HTB = HALF * BK * 2  , STAGE_BYTES = 8 * HTB, NXCD = 8, WGM = 8;

__host__ __device__ __forceinline__ int lds_byte(int r, int c) { const int st = (r >> 4) * 2 + (c >> 5), rr = r & 15, cc = c & 31, ob = rr * 64 + cc * 2; return st * 1024 + (ob ^ (((ob >> 9) & 1) << 5)); }
__host__ __device__ __forceinline__ void stage_rc(int b, int& R, int& C) { const int st = b / 1024, sb = b % 1024, swz = sb ^ (((sb >> 9) & 1) << 5); R = (st >> 1) * 16 + swz / 64; C = (st & 1) * 32 + (swz % 64) / 2; }
__host__ __device__ __forceinline__ int perm32(int rho) { const int n = rho >> 4, i = rho & 15; return 8 * (i >> 2) + 4 * n + (i & 3); }

struct Unit { int pm, pn, kt0, nkt, slab; };
struct Gemm { const bf16_t* A; const bf16_t* Bt; int M, N, K, lda, ldb, agrp; };
__device__ __forceinline__ size_t acolb(const Gemm& g, const Unit& u) { return g.agrp ? (size_t)((u.pn >> 1) * 256) * 2 : (size_t)0; }

struct StaticOrder {
    int nM, nN, nwg, G, c, nt;
    __host__ __device__ void init(int M, int N, int K, int G_, int c_) { nM = M / BM; nN = N / BM; nwg = nM * nN; G = G_; c = c_; nt = K / BK; }
    __host__ __device__ bool next(int i, Unit& u) const {
        const long L = (long)i * G + c; if (L >= nwg) return false;
        int wgid = (int)L; { const int q = nwg / NXCD, r = nwg % NXCD, xcd = wgid % NXCD, off = wgid / NXCD; wgid = (xcd < r ? xcd * (q + 1) : r * (q + 1) + (xcd - r) * q) + off; }
        const int nig = WGM * nN, gid = wgid / nig, fm = gid * WGM, gsz = (nM - fm) < WGM ? (nM - fm) : WGM;
        u.pm = fm + ((wgid % nig) % gsz); u.pn = (wgid % nig) / gsz; u.kt0 = 0; u.nkt = nt; u.slab = -1; return true;
    }
    __device__ __forceinline__ void a_ready(const Unit&) const {}
    __device__ __forceinline__ void done(const Unit&) const {}
};
struct TailOrder {
    int c, nt;
    __host__ __device__ void init(int K, int c_) { c = c_; nt = K / BK; }
    __host__ __device__ bool next(int i, Unit& u) const {
        if (i == 0) { const int x = c & 7, idx = c >> 3; u.pm = 4 * x + (idx >> 3); u.pn = idx & 7; u.kt0 = 0; u.nkt = nt; u.slab = -1; return true; }
        if (i == 1 && c < 240) { const int j = c / 6, ch = c - 6 * j, np = nt >> 1, base = np / 6, rem = np % 6, p0 = ch * base + (ch < rem ? ch : rem), pc = base + (ch < rem ? 1 : 0);
            u.pm = 32 + (j >> 3); u.pn = j & 7; u.kt0 = 2 * p0; u.nkt = 2 * pc; u.slab = c; return true; }
        return false;
    }
    __device__ __forceinline__ void a_ready(const Unit&) const {}
    __device__ __forceinline__ void done(const Unit&) const {}
};

__device__ __forceinline__ unsigned cvt_pk_bf16(float lo, float hi) { unsigned r; asm volatile("v_cvt_pk_bf16_f32 %0, %1, %2" : "=v"(r) : "v"(lo), "v"(hi)); return r; }
__device__ __forceinline__ float bf_lo(unsigned w) { return __uint_as_float(w << 16); }
__device__ __forceinline__ float bf_hi(unsigned w) { return __uint_as_float(w & 0xffff0000u); }
__device__ __forceinline__ float sigmoidf_(float x) { return __builtin_amdgcn_rcpf(1.0f + __builtin_amdgcn_exp2f(-1.4426950408889634f * x)); }
__device__ __forceinline__ u32x4 pack8(const f32x4& a, const f32x4& b) { u32x4 w; w.x = cvt_pk_bf16(a[0], a[1]); w.y = cvt_pk_bf16(a[2], a[3]); w.z = cvt_pk_bf16(b[0], b[1]); w.w = cvt_pk_bf16(b[2], b[3]); return w; }
__device__ __forceinline__ void unpack8(const u32x4& w, f32x4& a, f32x4& b) { a = (f32x4){bf_lo(w.x), bf_hi(w.x), bf_lo(w.y), bf_hi(w.y)}; b = (f32x4){bf_lo(w.z), bf_hi(w.z), bf_lo(w.w), bf_hi(w.w)}; }

struct EpiSwiglu {
    static constexpr bool PERM = true, AFTER_DRAIN = false;
    bf16_t* O; int ldc;
    __device__ __forceinline__ void operator()(const f32x4 (&acc)[2][2][4][2], const Unit& u, int wr, int wc, int fr, int fq) const {
        const int row0 = u.pm * BM + wr * 64 + fr, col0 = u.pn * HALF + wc * 32 + 8 * fq;
#pragma unroll
        for (int ai = 0; ai < 2; ++ai)
#pragma unroll
            for (int m = 0; m < 4; ++m) {
                f32x4 v[2];
#pragma unroll
                for (int n = 0; n < 2; ++n) { const f32x4 gt = acc[ai][0][m][n], up = acc[ai][1][m][n];
#pragma unroll
                    for (int e = 0; e < 4; ++e) v[n][e] = gt[e] * sigmoidf_(gt[e]) * up[e]; }
                *(u32x4*)(O + (size_t)(row0 + ai * HALF + m * 16) * ldc + col0) = pack8(v[0], v[1]);
            }
    }
};
template <bool FROMX> struct EpiResid {
    static constexpr bool PERM = false, AFTER_DRAIN = false;
    float* H; int ldc; float s; float* SL;
    const float *xp, *xs, *meta;
    __device__ __forceinline__ void operator()(const f32x4 (&acc)[2][2][4][2], const Unit& u, int wr, int wc, int fr, int fq) const {
        if (u.slab >= 0) {
            float* base = SL + (size_t)u.slab * (BM * BM) + (size_t)(wr * 64 + fr) * BM + wc * 32 + 4 * fq;
#pragma unroll
            for (int ai = 0; ai < 2; ++ai)
#pragma unroll
                for (int m = 0; m < 4; ++m)
#pragma unroll
                    for (int bj = 0; bj < 2; ++bj)
#pragma unroll
                        for (int n = 0; n < 2; ++n) *(f32x4*)(base + (size_t)(ai * HALF + m * 16) * BM + bj * HALF + n * 16) = acc[ai][bj][m][n];
            return;
        }
        const int row0 = u.pm * BM + wr * 64 + fr, col0 = u.pn * BM + wc * 32 + 4 * fq;
#pragma unroll
        for (int ai = 0; ai < 2; ++ai)
#pragma unroll
            for (int m = 0; m < 4; ++m) { const int r = row0 + ai * HALF + m * 16; float* rowp = H + (size_t)r * ldc + col0;
                const float* srcp = rowp;
                if (FROMX) {
                    const int b = r / 2064, t = r - b * 2064;
                    srcp = (t < 16 ? meta + (size_t)t * 2048 : xp + ((size_t)b * 2048 + (t - 16)) * 2048) + col0;
                }
#pragma unroll
                for (int bj = 0; bj < 2; ++bj)
#pragma unroll
                    for (int n = 0; n < 2; ++n) { const f32x4 h = *(const f32x4*)(srcp + bj * HALF + n * 16); *(f32x4*)(rowp + bj * HALF + n * 16) = h + acc[ai][bj][m][n] * s; }
                if (m & 1) asm volatile("" ::: "memory"); }
    }
};
struct EpiProj {
    static constexpr bool PERM = true, AFTER_DRAIN = false;
    bf16_t *BG, *CV, *Z, *SGC, *SGP;
    __device__ __forceinline__ void operator()(const f32x4 (&acc)[2][2][4][2], const Unit& u, int wr, int wc, int fr, int fq) const {
        const int row0 = u.pm * BM + wr * 64 + fr, pn = u.pn;
        if (pn >= 8 && pn < 24) {
            const int col0 = (pn - 8) * HALF + wc * 32 + 8 * fq;
#pragma unroll
            for (int ai = 0; ai < 2; ++ai)
#pragma unroll
                for (int m = 0; m < 4; ++m)
                    *(u32x4*)(CV + (size_t)(row0 + ai * HALF + m * 16) * 2048 + col0) = pack8(acc[ai][0][m][0] * acc[ai][1][m][0], acc[ai][0][m][1] * acc[ai][1][m][1]);
        } else {
            bf16_t* base; int ld, ct; bool sg;
            if (pn < 8) { base = BG; ld = 2048; ct = pn; sg = false; }
            else if (pn < 28) { base = Z; ld = 1024; ct = pn - 24; sg = false; }
            else if (pn < 36) { base = SGC; ld = 2048; ct = pn - 28; sg = true; }
            else { base = SGP; ld = 2048; ct = pn - 36; sg = true; }
            const int col0 = ct * BM + wc * 32 + 8 * fq;
#pragma unroll
            for (int ai = 0; ai < 2; ++ai)
#pragma unroll
                for (int m = 0; m < 4; ++m) { bf16_t* rowp = base + (size_t)(row0 + ai * HALF + m * 16) * ld + col0;
#pragma unroll
                    for (int bj = 0; bj < 2; ++bj) { f32x4 v0 = acc[ai][bj][m][0], v1 = acc[ai][bj][m][1];
                        if (sg) {
#pragma unroll
                            for (int e = 0; e < 4; ++e) { v0[e] = sigmoidf_(v0[e]); v1[e] = sigmoidf_(v1[e]); } }
                        *(u32x4*)(rowp + bj * HALF) = pack8(v0, v1); } }
        }
    }
};
struct EpiPool {
    static constexpr bool PERM = true, AFTER_DRAIN = false;
    bf16_t* SGP; const float* ps;
    __device__ __forceinline__ void operator()(const f32x4 (&acc)[2][2][4][2], const Unit& u, int wr, int wc, int fr, int fq) const {
        const int row0 = u.pm * BM + wr * 64 + fr, col0 = u.pn * BM + wc * 32 + 8 * fq;
#pragma unroll
        for (int ai = 0; ai < 2; ++ai)
#pragma unroll
            for (int m = 0; m < 4; ++m) { bf16_t* rowp = SGP + (size_t)(row0 + ai * HALF + m * 16) * 2048 + col0;
#pragma unroll
                for (int bj = 0; bj < 2; ++bj) { u32x4* p = (u32x4*)(rowp + bj * HALF); f32x4 g0, g1; unpack8(*p, g0, g1);
                    const f32x4 s0 = *(const f32x4*)(ps + col0 + bj * HALF), s1 = *(const f32x4*)(ps + col0 + bj * HALF + 4);
                    *p = pack8(g0 * s0 * acc[ai][bj][m][0], g1 * s1 * acc[ai][bj][m][1]); }
                asm volatile("" ::: "memory"); }
    }
};
struct EpiMerge {
    static constexpr bool PERM = true, AFTER_DRAIN = false;
    bf16_t* SGC; const bf16_t* MP;
    __device__ __forceinline__ void operator()(const f32x4 (&acc)[2][2][4][2], const Unit& u, int wr, int wc, int fr, int fq) const {
        const int row0 = u.pm * BM + wr * 64 + fr, col0 = u.pn * BM + wc * 32 + 8 * fq;
#pragma unroll
        for (int ai = 0; ai < 2; ++ai)
#pragma unroll
            for (int m = 0; m < 4; ++m) { const size_t off = (size_t)(row0 + ai * HALF + m * 16) * 2048 + col0;
#pragma unroll
                for (int bj = 0; bj < 2; ++bj) { u32x4* p = (u32x4*)(SGC + off + bj * HALF); f32x4 g0, g1, q0, q1; unpack8(*p, g0, g1); unpack8(*(const u32x4*)(MP + off + bj * HALF), q0, q1);
                    *p = pack8(g0 * acc[ai][bj][m][0] + q0, g1 * acc[ai][bj][m][1] + q1); }
                if (m & 1) asm volatile("" ::: "memory"); }
    }
};

template <class Epi, class Sched, bool ALIGN_EPI = false, bool SP2 = false>
__device__ __forceinline__ void gemm_phase(PG8_LAS unsigned char* lds, const Gemm g, const Sched& S, const Epi& E) {
    int tid_ = threadIdx.x; asm volatile("" : "+v"(tid_));
    const int tid = tid_, wid = __builtin_amdgcn_readfirstlane(tid >> 6), lane = tid & 63, wr = wid >> 2, wc = wid & 3, fr = lane & 15, fq = lane >> 4;

    unsigned voffA[2], voffB[2];
#pragma unroll
    for (int i = 0; i < 2; ++i) { int R, C; stage_rc(tid * 16 + i * 8192, R, C); const int Rb = Epi::PERM ? ((R & ~31) + perm32(R & 31)) : R;
        voffA[i] = (unsigned)(R * g.lda + C) * 2u; voffB[i] = (unsigned)(Rb * g.ldb + C) * 2u; }
    const size_t kstep = (size_t)(BK * 2);
    const size_t hstepA = (size_t)HALF * g.lda * 2, hstepB = (size_t)HALF * g.ldb * 2;
    const size_t tstepA = 2 * hstepA, tstepB = 2 * hstepB;
    const unsigned ldsw = (unsigned)wid * 1024u;
    const int aoff = lds_byte(wr * 64 + fr, fq * 8), boff = lds_byte(wc * 32 + fr, fq * 8);
#define PG8_SA(b, h) (((b) * 2 + (h)) * HTB)
#define PG8_SB(b, h) ((4 + (b) * 2 + (h)) * HTB)
#define PG8_STAGE(bufoff, gbase, voff) do { _Pragma("unroll") for (int _i = 0; _i < 2; ++_i) \
        __builtin_amdgcn_global_load_lds((const unsigned*)((const char*)(gbase) + (voff)[_i]), (PG8_LAS unsigned*)(lds + (bufoff) + ldsw + _i * 8192), 16, 0, 0); } while (0)
#define PG8_LDA(dst, b, h) do { _Pragma("unroll") for (int m = 0; m < 4; ++m) _Pragma("unroll") for (int k = 0; k < 2; ++k) dst[m][k] = *(const PG8_LAS bf16x8*)(lds + PG8_SA(b, h) + aoff + m * 2048 + k * 1024); } while (0)
#define PG8_LDB(dst, b, h) do { _Pragma("unroll") for (int n = 0; n < 2; ++n) _Pragma("unroll") for (int k = 0; k < 2; ++k) dst[n][k] = *(const PG8_LAS bf16x8*)(lds + PG8_SB(b, h) + boff + n * 2048 + k * 1024); } while (0)
#define PG8_MMA(ai, bj, At, Bt) do { __builtin_amdgcn_s_setprio(1); _Pragma("unroll") for (int m = 0; m < 4; ++m) _Pragma("unroll") for (int n = 0; n < 2; ++n) _Pragma("unroll") for (int k = 0; k < 2; ++k) \
        acc[ai][bj][m][n] = __builtin_amdgcn_mfma_f32_16x16x32_bf16(Bt[n][k], At[m][k], acc[ai][bj][m][n], 0, 0, 0); __builtin_amdgcn_s_setprio(0); } while (0)
#define PG8_WAIT_V(n) asm volatile("s_waitcnt vmcnt(" #n ")" ::: "memory")
#define PG8_WAIT_L(n) asm volatile("s_waitcnt lgkmcnt(" #n ")" ::: "memory")
#define PG8_BAR __builtin_amdgcn_s_barrier()
#define PG8_SCHED __builtin_amdgcn_sched_barrier(0)
    Unit cur, nxt; int ui = 0;
    if (!S.next(0, cur)) return;
    f32x4 acc[2][2][4][2];
#pragma unroll
    for (int a = 0; a < 2; ++a)
#pragma unroll
        for (int b = 0; b < 2; ++b)
#pragma unroll
            for (int m = 0; m < 4; ++m)
#pragma unroll
                for (int n = 0; n < 2; ++n) acc[a][b][m][n] = (f32x4){0.f, 0.f, 0.f, 0.f};
    bf16x8 At[4][2], B0[2][2], B1[2][2];
    const char* cA = (const char*)g.A + (size_t)cur.pm * tstepA + acolb(g, cur) + (size_t)cur.kt0 * kstep; const char* cB = (const char*)g.Bt + (size_t)cur.pn * tstepB + (size_t)cur.kt0 * kstep;
    S.a_ready(cur);
    if constexpr (SP2) {
        PG8_STAGE(PG8_SB(0, 0), cB, voffB); PG8_STAGE(PG8_SB(0, 1), cB + hstepB, voffB); PG8_STAGE(PG8_SA(0, 0), cA, voffA); PG8_STAGE(PG8_SA(0, 1), cA + hstepA, voffA);
        if (wr == 1) PG8_BAR;
        PG8_WAIT_V(2); PG8_BAR;
        PG8_STAGE(PG8_SB(1, 0), cB + kstep, voffB); PG8_STAGE(PG8_SA(1, 0), cA + kstep, voffA); PG8_STAGE(PG8_SB(1, 1), cB + hstepB + kstep, voffB);
        PG8_WAIT_V(6); PG8_BAR;
    } else {
        PG8_STAGE(PG8_SB(0, 0), cB, voffB); PG8_STAGE(PG8_SA(0, 0), cA, voffA); PG8_STAGE(PG8_SB(0, 1), cB + hstepB, voffB); PG8_STAGE(PG8_SA(0, 1), cA + hstepA, voffA);
        if (wr == 1) PG8_BAR;
        PG8_WAIT_V(4); PG8_BAR;
        PG8_STAGE(PG8_SB(1, 0), cB + kstep, voffB); PG8_STAGE(PG8_SA(1, 0), cA + kstep, voffA); PG8_STAGE(PG8_SB(1, 1), cB + hstepB + kstep, voffB);
        PG8_WAIT_V(6); PG8_BAR;
    }
    for (;;) {
        const bool has_next = S.next(ui + 1, nxt);
        const char* nA = has_next ? (const char*)g.A + (size_t)nxt.pm * tstepA + acolb(g, nxt) + (size_t)nxt.kt0 * kstep : cA; const char* nB = has_next ? (const char*)g.Bt + (size_t)nxt.pn * tstepB + (size_t)nxt.kt0 * kstep : cB;
        const int nt = cur.nkt;
        for (int t = 0; t < nt; t += 2) {
            const bool last = (t == nt - 2);
            const char* a1 = cA + (size_t)(t + 1) * kstep;
            const char* a2 = last ? nA : cA + (size_t)(t + 2) * kstep; const char* b2 = last ? nB : cB + (size_t)(t + 2) * kstep;
            const char* a3 = a2 + kstep; const char* b3 = b2 + kstep;
            if (last && has_next) S.a_ready(nxt);
            if constexpr (SP2) {
            PG8_LDB(B0, 0, 0); PG8_LDB(B1, 0, 1); PG8_SCHED; PG8_LDA(At, 0, 0); PG8_STAGE(PG8_SA(1, 1), a1 + hstepA, voffA);
            PG8_WAIT_V(8); PG8_WAIT_L(0); PG8_BAR; PG8_MMA(0, 0, At, B0); PG8_MMA(0, 1, At, B1); PG8_BAR; PG8_SCHED;
            PG8_LDA(At, 0, 1); PG8_STAGE(PG8_SB(0, 0), b2, voffB); PG8_STAGE(PG8_SB(0, 1), b2 + hstepB, voffB); PG8_STAGE(PG8_SA(0, 0), a2, voffA);
            PG8_WAIT_V(8); PG8_WAIT_L(0); PG8_BAR; PG8_MMA(1, 0, At, B0); PG8_MMA(1, 1, At, B1); PG8_BAR; PG8_SCHED;
            PG8_LDB(B0, 1, 0); PG8_LDB(B1, 1, 1); PG8_SCHED; PG8_LDA(At, 1, 0); PG8_STAGE(PG8_SA(0, 1), a2 + hstepA, voffA);
            PG8_WAIT_V(8); PG8_WAIT_L(0); PG8_BAR; PG8_MMA(0, 0, At, B0); PG8_MMA(0, 1, At, B1); PG8_BAR; PG8_SCHED;
            PG8_LDA(At, 1, 1); PG8_STAGE(PG8_SB(1, 0), b3, voffB); PG8_STAGE(PG8_SB(1, 1), b3 + hstepB, voffB); PG8_STAGE(PG8_SA(1, 0), a3, voffA);
            PG8_WAIT_V(8); PG8_WAIT_L(0); PG8_BAR; PG8_MMA(1, 0, At, B0); PG8_MMA(1, 1, At, B1); PG8_BAR; PG8_SCHED;
            } else {
            PG8_LDB(B0, 0, 0); PG8_SCHED; PG8_LDA(At, 0, 0); PG8_STAGE(PG8_SA(1, 1), a1 + hstepA, voffA);
            PG8_WAIT_L(8); PG8_BAR; PG8_WAIT_L(0); PG8_MMA(0, 0, At, B0); PG8_BAR; PG8_SCHED;
            PG8_LDB(B1, 0, 1); PG8_STAGE(PG8_SB(0, 0), b2, voffB);
            PG8_BAR; PG8_WAIT_L(0); PG8_MMA(0, 1, At, B1); PG8_BAR;
            PG8_LDA(At, 0, 1); PG8_STAGE(PG8_SA(0, 0), a2, voffA);
            PG8_BAR; PG8_WAIT_L(0); PG8_MMA(1, 0, At, B0); PG8_BAR; PG8_SCHED;
            PG8_STAGE(PG8_SB(0, 1), b2 + hstepB, voffB);
            PG8_WAIT_V(6); PG8_BAR; PG8_MMA(1, 1, At, B1); PG8_BAR;
            PG8_LDB(B0, 1, 0); PG8_SCHED; PG8_LDA(At, 1, 0); PG8_STAGE(PG8_SA(0, 1), a2 + hstepA, voffA);
            PG8_WAIT_L(8); PG8_BAR; PG8_WAIT_L(0); PG8_MMA(0, 0, At, B0); PG8_BAR; PG8_SCHED;
            PG8_LDB(B1, 1, 1); PG8_STAGE(PG8_SB(1, 0), b3, voffB);
            PG8_BAR; PG8_WAIT_L(0); PG8_MMA(0, 1, At, B1); PG8_BAR;
            PG8_LDA(At, 1, 1); PG8_STAGE(PG8_SA(1, 0), a3, voffA);
            PG8_BAR; PG8_WAIT_L(0); PG8_MMA(1, 0, At, B0); PG8_BAR; PG8_SCHED;
            PG8_STAGE(PG8_SB(1, 1), b3 + hstepB, voffB);
            PG8_WAIT_V(6); PG8_BAR; PG8_MMA(1, 1, At, B1); PG8_BAR;
            }
        }
        if constexpr (ALIGN_EPI) { if (wr == 0) PG8_BAR; }
        if constexpr (!Epi::AFTER_DRAIN) { E(acc, cur, wr, wc, fr, fq); S.done(cur); }
        if (!has_next) break;
#pragma unroll
        for (int a = 0; a < 2; ++a)
#pragma unroll
            for (int b = 0; b < 2; ++b)
#pragma unroll
                for (int m = 0; m < 4; ++m)
#pragma unroll
                    for (int n = 0; n < 2; ++n) acc[a][b][m][n] = (f32x4){0.f, 0.f, 0.f, 0.f};
        cur = nxt; cA = nA; cB = nB; ++ui;
        if constexpr (ALIGN_EPI) { if (wr == 1) PG8_BAR; }
    }
    PG8_WAIT_V(0);
    if constexpr (!ALIGN_EPI) { if (wr == 0) PG8_BAR; }
    PG8_BAR;
    if constexpr (Epi::AFTER_DRAIN) { E.fused(acc, cur, wr, wc, fr, fq, lds, wid, lane); S.done(cur); }
#undef PG8_SA
#undef PG8_SB
#undef PG8_STAGE
#undef PG8_LDA
#undef PG8_LDB
#undef PG8_MMA
#undef PG8_WAIT_V
#undef PG8_WAIT_L
#undef PG8_BAR
#undef PG8_SCHED
}
}

constexpr int DM = 2048, NB = 4, SEQ = 2048, NMETA = 16, LP = SEQ + NMETA  , DECB = 128, DECS = 8;
constexpr int DFF = 5632, DPOOL = 1024, DIN = 11264;
constexpr int MP_ROWS = NB * LP;
constexpr int MS_ROWS = DECB * DECS;
constexpr int MREAL = MP_ROWS + MS_ROWS;
constexpr int MPAD = 9472;
constexpr float EPS = 1e-6f;
constexpr int NWAVES = 8;

constexpr size_t O_YP = 0, O_YS = O_YP + (size_t)NB * SEQ * DM, O_NCP = O_YS + (size_t)MS_ROWS * DM, O_NPP = O_NCP + (size_t)NB * 2 * DM,
                 O_NCS = O_NPP + (size_t)NB * 15 * DPOOL, O_NPS = O_NCS + (size_t)DECB * 2 * DM, O_END = O_NPS + (size_t)DECB * 15 * DPOOL;

constexpr size_t MiB = 1u << 20;
constexpr size_t WS_W1GU = 1 * MiB;
constexpr size_t WS_W1D = WS_W1GU + 44 * MiB;
constexpr size_t WS_WIN = WS_W1D + 22 * MiB;
constexpr size_t WS_WCO = WS_WIN + 44 * MiB;
constexpr size_t WS_WPG = WS_WCO + 8 * MiB;
constexpr size_t WS_WO = WS_WPG + 1 * MiB;
constexpr size_t WS_W2GU = WS_WO + 8 * MiB;
constexpr size_t WS_W2D = WS_W2GU + 44 * MiB;
constexpr size_t WS_H = WS_W2D + 22 * MiB;
constexpr size_t WS_R = WS_H + 74 * MiB;
constexpr size_t WS_BG = WS_R, WS_CV = WS_R + 37 * MiB, WS_SGC = WS_R + 74 * MiB, WS_SGP = WS_R + 111 * MiB, WS_Z = WS_R + 148 * MiB, WS_PL = WS_Z + 19 * MiB;
constexpr size_t WS_XN1 = WS_SGP;
constexpr size_t WS_END = WS_PL + 19 * MiB;
static_assert((size_t)MPAD * DFF * 2 <= 111 * MiB, "ACT fits below XN1");

#define GAS __attribute__((address_space(1)))
#define LAS __attribute__((address_space(3)))
typedef unsigned short bf16;
typedef unsigned v4u __attribute__((ext_vector_type(4)));
typedef float f32x4 __attribute__((ext_vector_type(4)));
#define LDS_WAIT() asm volatile("s_waitcnt lgkmcnt(0)" ::: "memory")
constexpr int LDS_BYTES = 147456;

struct Args {
    const float *x_prompt, *x_sample, *state_conv, *state_pool, *meta, *norm_ffn1, *w1g, *w1u, *w1d, *norm_mix, *w_in, *conv_w, *w_conv_out, *w_pool, *pool_scale, *w_o, *norm_ffn2, *w2g, *w2u, *w2d, *norm_final;
    float* out; unsigned char* ws;
};

__device__ __forceinline__ unsigned pk2(float lo, float hi) { return pg8::cvt_pk_bf16(lo, hi); }
__device__ __forceinline__ float wave_sum(float v) {
#pragma unroll
    for (int o = 1; o < 64; o <<= 1) v += __shfl_xor(v, o);
    return v;
}
__device__ __forceinline__ const float* src_row(const Args& a, int r) {
    if (r < MP_ROWS) { const int b = r / LP, t = r - b * LP; return t < NMETA ? a.meta + (size_t)t * DM : a.x_prompt + ((size_t)b * SEQ + (t - NMETA)) * DM; }
    if (r < MREAL) return a.x_sample + (size_t)(r - MP_ROWS) * DM;
    return nullptr;
}
__device__ __forceinline__ void p0_transpose_item(const float* W, int N, bf16* WT, int K, int k0, int n0, int drow0, LAS float* scr, int lane) {
    const int lr = lane >> 4, lc = (lane & 15) * 4;
    f32x4 v[16];
#pragma unroll
    for (int i = 0; i < 16; ++i) v[i] = *(const f32x4*)(W + (size_t)(k0 + 4 * i + lr) * N + n0 + lc);
#pragma unroll
    for (int i = 0; i < 16; ++i) { LAS float* s = scr + (4 * i + lr) * 65 + lc; s[0] = v[i].x; s[1] = v[i].y; s[2] = v[i].z; s[3] = v[i].w; }
    LDS_WAIT(); asm volatile("" ::: "memory");
    const int c = lane & 7;
#pragma unroll
    for (int j = 0; j < 8; ++j) { const int n = (lane >> 3) + 8 * j; const LAS float* s = scr + (8 * c) * 65 + n;
        v4u o; o.x = pk2(s[0 * 65], s[1 * 65]); o.y = pk2(s[2 * 65], s[3 * 65]); o.z = pk2(s[4 * 65], s[5 * 65]); o.w = pk2(s[6 * 65], s[7 * 65]);
        *(v4u*)(WT + (size_t)(drow0 + n) * K + k0 + 8 * c) = o; }
    LDS_WAIT(); asm volatile("" ::: "memory");
}
__device__ __forceinline__ bool p0_job(int& r, const float* W, int K, int N, bf16* WT, int kind, int roff, LAS float* scr, int lane) {
    const int nb = N / 64, items = (K / 64) * nb;
    if (r >= items) { r -= items; return false; }
    const int kb = r / nb, n0 = (r % nb) * 64;
    int d;
    if (kind == 0) d = roff + n0;
    else if (kind == 1) d = (n0 >> 7) * 256 + (n0 & 127);
    else if (kind == 2) d = (n0 >> 7) * 256 + 128 + (n0 & 127);
    else { if (n0 < 2048 || n0 >= 6144) d = n0; else if (n0 < 4096) { const int j = n0 - 2048; d = 2048 + (j >> 7) * 256 + (j & 127); } else { const int j = n0 - 4096; d = 2048 + (j >> 7) * 256 + 128 + (j & 127); } }
    p0_transpose_item(W, N, WT, K, kb * 64, n0, d, scr, lane);
    return true;
}
__device__ __forceinline__ f32x4 slab_sum(const float* SL, int m, int j, int lane) {
    const float* p = SL + (size_t)(((m >> 8) - 32) * 8 + j) * 6 * 65536 + (size_t)(m & 255) * 256 + 4 * lane;
    f32x4 a = *(const f32x4*)p;
#pragma unroll
    for (int ch = 1; ch < 6; ++ch) a += *(const f32x4*)(p + (size_t)ch * 65536);
    return a;
}
__device__ __forceinline__ void rms_row_bf16(const float* xrow, const float* g, bf16* orow, float* hout, int lane, const float* SL = nullptr, float sc = 0.f, int m = 0) {
    f32x4 v[8]; float s = 0.f;
    const bool red = SL && m >= 8192;
#pragma unroll
    for (int j = 0; j < 8; ++j) {
        v[j] = xrow ? ((const f32x4*)xrow)[lane + 64 * j] : (f32x4){0.f, 0.f, 0.f, 0.f};
        if (red) v[j] += slab_sum(SL, m, j, lane) * sc;
        s += (v[j].x * v[j].x + v[j].y * v[j].y) + (v[j].z * v[j].z + v[j].w * v[j].w);
    }
    const float r = 1.0f / sqrtf(wave_sum(s) * (1.0f / DM) + EPS);
#pragma unroll
    for (int j = 0; j < 8; ++j) {
        if (hout) ((f32x4*)hout)[lane + 64 * j] = v[j];
        const f32x4 gg = ((const f32x4*)g)[lane + 64 * j];
        const unsigned lo = pk2(v[j].x * r * gg.x, v[j].y * r * gg.y), hi = pk2(v[j].z * r * gg.z, v[j].w * r * gg.w);
        ((unsigned long long*)orow)[lane + 64 * j] = (unsigned long long)lo | ((unsigned long long)hi << 32);
    }
}
__device__ __forceinline__ void load8_bf16(const bf16* p, float (&o)[8]) { const v4u w = *(const v4u*)p; o[0] = pg8::bf_lo(w.x); o[1] = pg8::bf_hi(w.x); o[2] = pg8::bf_lo(w.y); o[3] = pg8::bf_hi(w.y); o[4] = pg8::bf_lo(w.z); o[5] = pg8::bf_hi(w.z); o[6] = pg8::bf_lo(w.w); o[7] = pg8::bf_hi(w.w); }
__device__ __forceinline__ void load8_f32(const float* p, float (&o)[8]) { const f32x4 a = ((const f32x4*)p)[0], b = ((const f32x4*)p)[1]; o[0] = a.x; o[1] = a.y; o[2] = a.z; o[3] = a.w; o[4] = b.x; o[5] = b.y; o[6] = b.z; o[7] = b.w; }
__device__ __forceinline__ void store8_f32(float* p, const float (&o)[8]) { ((f32x4*)p)[0] = (f32x4){o[0], o[1], o[2], o[3]}; ((f32x4*)p)[1] = (f32x4){o[4], o[5], o[6], o[7]}; }


__device__ __forceinline__ void acc8_bf16(const v4u& w, float msk, float (&s)[8]) {
    s[0] += msk * pg8::bf_lo(w.x); s[1] += msk * pg8::bf_hi(w.x); s[2] += msk * pg8::bf_lo(w.y); s[3] += msk * pg8::bf_hi(w.y);
    s[4] += msk * pg8::bf_lo(w.z); s[5] += msk * pg8::bf_hi(w.z); s[6] += msk * pg8::bf_lo(w.w); s[7] += msk * pg8::bf_hi(w.w);
}
template <bool SMP>
__device__ __forceinline__ void p3b_row(const Args& a, int m, int lane, bf16* BG, const bf16* CV, const bf16* Z, bf16* PL) {
    int sq, t;
    if (SMP) { sq = (m - MP_ROWS) >> 3; t = (m - MP_ROWS) & 7; } else { sq = m / LP; t = m - sq * LP; }
    constexpr int L = SMP ? DECS : LP;
    const float* sc = a.state_conv + (size_t)sq * 2 * DM;
    const float* sp = a.state_pool + (size_t)sq * 15 * DPOOL;
    float* ncv = (t >= L - 2) ? a.out + (SMP ? O_NCS : O_NCP) + ((size_t)sq * 2 + (t - (L - 2))) * DM : nullptr;
    const float m1 = t >= 1 ? 1.f : 0.f, m2 = t >= 2 ? 1.f : 0.f;
    const int r1 = t >= 1 ? m - 1 : m, r2 = t >= 2 ? m - 2 : m;
#pragma unroll 2
    for (int j = 0; j < 4; ++j) {
        const int col = 512 * j + 8 * lane;
        float c0[8], c1[8], c2[8], bg[8], w0[8], w1[8], w2[8], o[8];
        load8_bf16(CV + (size_t)m * DM + col, c2); load8_bf16(CV + (size_t)r1 * DM + col, c1); load8_bf16(CV + (size_t)r2 * DM + col, c0);
        load8_bf16(BG + (size_t)m * DM + col, bg);
        load8_f32(a.conv_w + col, w0); load8_f32(a.conv_w + DM + col, w1); load8_f32(a.conv_w + 2 * DM + col, w2);
#pragma unroll
        for (int e = 0; e < 8; ++e) { c1[e] *= m1; c0[e] *= m2; }
        if (SMP) {
            float s1[8], s0[8];
            load8_f32(sc + (size_t)DM + col, s1); load8_f32(sc + (size_t)(t == 1 ? DM : 0) + col, s0);
#pragma unroll
            for (int e = 0; e < 8; ++e) { c1[e] += (1.f - m1) * s1[e]; c0[e] += (1.f - m2) * s0[e]; }
        }
#pragma unroll
        for (int e = 0; e < 8; ++e) o[e] = bg[e] * (w0[e] * c0[e] + w1[e] * c1[e] + w2[e] * c2[e]);
        v4u w; w.x = pk2(o[0], o[1]); w.y = pk2(o[2], o[3]); w.z = pk2(o[4], o[5]); w.w = pk2(o[6], o[7]);
        *(v4u*)(BG + (size_t)m * DM + col) = w;
        if (ncv) store8_f32(ncv + col, c2);
    }
    float* npp = nullptr;
    if (SMP) npp = a.out + O_NPS + ((size_t)sq * 15 + 7 + t) * DPOOL; else if (t >= L - 15) npp = a.out + O_NPP + ((size_t)sq * 15 + (t - (L - 15))) * DPOOL;
#pragma unroll
    for (int j = 0; j < 2; ++j) {
        const int col = 512 * j + 8 * lane, gq = col >> 8, k = 2 << gq;
        float z0[8], s[8];
        load8_bf16(Z + (size_t)m * DPOOL + col, z0);
#pragma unroll
        for (int e = 0; e < 8; ++e) s[e] = z0[e];
        if (j == 0) {
#pragma unroll
            for (int i = 1; i < 4; ++i) { const bool in = t - i >= 0; const v4u w = *(const v4u*)(Z + (size_t)(in ? m - i : m) * DPOOL + col); acc8_bf16(w, (in && i < k) ? 1.f : 0.f, s); }
            if (SMP) {
#pragma unroll
                for (int i = 1; i < 4; ++i) { const bool st = t - i < 0; float q[8]; load8_f32(sp + (size_t)(st ? 15 + t - i : 0) * DPOOL + col, q); const float mk = (st && i < k) ? 1.f : 0.f;
#pragma unroll
                    for (int e = 0; e < 8; ++e) s[e] += mk * q[e]; }
            }
        } else {
#pragma unroll
            for (int i = 1; i < 16; ++i) { const bool in = t - i >= 0; const v4u w = *(const v4u*)(Z + (size_t)(in ? m - i : m) * DPOOL + col); acc8_bf16(w, (in && i < k) ? 1.f : 0.f, s); }
            if (SMP) {
#pragma unroll
                for (int i = 1; i < 16; ++i) { const bool st = t - i < 0; float q[8]; load8_f32(sp + (size_t)(st ? 15 + t - i : 0) * DPOOL + col, q); const float mk = (st && i < k) ? 1.f : 0.f;
#pragma unroll
                    for (int e = 0; e < 8; ++e) s[e] += mk * q[e]; }
            }
        }
        const int cnt = SMP ? k : (k < t + 1 ? k : t + 1);
        const float inv = 1.0f / (float)cnt;
        float o[8];
#pragma unroll
        for (int e = 0; e < 8; ++e) o[e] = s[e] * inv - z0[e];
        v4u w; w.x = pk2(o[0], o[1]); w.y = pk2(o[2], o[3]); w.z = pk2(o[4], o[5]); w.w = pk2(o[6], o[7]);
        *(v4u*)(PL + (size_t)m * DPOOL + col) = w;
        if (npp) store8_f32(npp + col, z0);
        if (SMP && t < 7) { float q[8]; load8_f32(sp + (size_t)(8 + t) * DPOOL + col, q); store8_f32(a.out + O_NPS + ((size_t)sq * 15 + t) * DPOOL + col, q); }
    }
}

#define XB_TMO      128
#define XB_XCNT(j)  (256  + 64 * (j))
#define XB_XSUB(j)  (1280 + 64 * (j))
#define XB_XGEN(j)  (2304 + 64 * (j))
#define XB_TOP      3328
#define XB_TOPGEN   3392
#define XCD_BAR_WORDS 3456
#define XB_SPIN_CAP (1u << 18)

__device__ __forceinline__ unsigned xb_ld(unsigned* p)              { return __hip_atomic_load(p, __ATOMIC_RELAXED, __HIP_MEMORY_SCOPE_AGENT); }
__device__ __forceinline__ unsigned xb_add(unsigned* p, unsigned v) { return __hip_atomic_fetch_add(p, v, __ATOMIC_RELAXED, __HIP_MEMORY_SCOPE_AGENT); }
__device__ __forceinline__ unsigned xb_xcc_id() { return (unsigned)__builtin_amdgcn_s_getreg((3 << 11) | 20) & 0xFu; }
#define XB_SPIN(cond, bar) do { unsigned _sp = 0; while (cond) { __builtin_amdgcn_s_sleep(1); \
    if ((++_sp & 255u) == 0u) { if (xb_ld(&(bar)[XB_TMO])) break; if (_sp > XB_SPIN_CAP) { atomicAdd(&(bar)[XB_TMO], 1u); break; } } } } while (0)

struct XcdBarrier {
    unsigned* bar; unsigned x;
    volatile LAS unsigned* st;
};

__device__ __forceinline__ XcdBarrier xcd_barrier_post(unsigned* bar, volatile LAS unsigned* st) {
    XcdBarrier b; b.bar = bar; b.x = xb_xcc_id(); b.st = st;
    if (threadIdx.x == 0) (void)xb_add(&bar[XB_XCNT(b.x)], 1u);
    return b;
}
__device__ __forceinline__ void xcd_barrier_complete(unsigned* bar, unsigned x, unsigned& nloc, unsigned& nx) {
    const unsigned G = gridDim.x * gridDim.y * gridDim.z;
    unsigned sum, cnt, mine, sp = 0u;
    for (;;) {
        sum = 0u; cnt = 0u; mine = 0u;
#pragma unroll
        for (unsigned j = 0; j < 16; ++j) { const unsigned c = xb_ld(&bar[XB_XCNT(j)]); sum += c; cnt += (c > 0u) ? 1u : 0u; mine = (j == x) ? c : mine; }
        if (sum == G) break;
        __builtin_amdgcn_s_sleep(1);
        if ((++sp & 255u) == 0u) { if (xb_ld(&bar[XB_TMO])) break; if (sp > XB_SPIN_CAP) { atomicAdd(&bar[XB_TMO], 1u); break; } }
    }
    nloc = mine > 0u ? mine : 1u; nx = cnt > 0u ? cnt : 1u;
}

__device__ __forceinline__ void xcd_barrier(const XcdBarrier& b) {
    asm volatile("s_waitcnt vmcnt(0)" ::: "memory");
    __syncthreads();
    if (threadIdx.x == 0) {
        unsigned* bar = b.bar;
        __builtin_amdgcn_s_waitcnt(0);
        unsigned nloc = b.st[0], nx = b.st[1];
        if (nloc == 0u) { xcd_barrier_complete(bar, b.x, nloc, nx); b.st[0] = nloc; b.st[1] = nx; }
        const unsigned old = xb_add(&bar[XB_XSUB(b.x)], 1u);
        const unsigned gen = old / nloc;
        if (old + 1u == (gen + 1u) * nloc) {
            __builtin_amdgcn_fence(__ATOMIC_RELEASE, "agent");
            asm volatile("s_waitcnt vmcnt(0)" ::: "memory");
            const unsigned og = xb_add(&bar[XB_TOP], 1u);
            const unsigned tg = og / nx;
            if (og + 1u == (tg + 1u) * nx) xb_add(&bar[XB_TOPGEN], 1u);
            else XB_SPIN(xb_ld(&bar[XB_TOPGEN]) == tg, bar);
            __builtin_amdgcn_fence(__ATOMIC_ACQUIRE, "agent");
            xb_add(&bar[XB_XGEN(b.x)], 1u);
            asm volatile("s_waitcnt vmcnt(0)" ::: "memory");
        } else {
            XB_SPIN(xb_ld(&bar[XB_XGEN(b.x)]) == gen, bar);
            __builtin_amdgcn_fence(__ATOMIC_ACQUIRE, "agent");
            asm volatile("s_waitcnt vmcnt(0)" ::: "memory");
        }
    }
    __syncthreads();
}

__global__ void __launch_bounds__(NWAVES * 64) fwd_megakernel(Args a) {
    extern __shared__ __attribute__((aligned(16))) unsigned char lds_raw[];
    cg::grid_group grid = cg::this_grid();
    LAS unsigned char* lds = (LAS unsigned char*)lds_raw;
    const int tid = threadIdx.x, lane = tid & 63, wave = __builtin_amdgcn_readfirstlane(tid >> 6);
    const int G = gridDim.x, bx = blockIdx.x;
    const int gw = bx * NWAVES + wave, NGW = G * NWAVES;
    unsigned char* ws = a.ws;
    bf16 *W1GU = (bf16*)(ws + WS_W1GU), *W1D = (bf16*)(ws + WS_W1D), *WIN = (bf16*)(ws + WS_WIN), *WCO = (bf16*)(ws + WS_WCO), *WPG = (bf16*)(ws + WS_WPG), *WO = (bf16*)(ws + WS_WO),
         *W2GU = (bf16*)(ws + WS_W2GU), *W2D = (bf16*)(ws + WS_W2D);
    float* H = (float*)(ws + WS_H);
    bf16 *ACT = (bf16*)(ws + WS_R), *BG = (bf16*)(ws + WS_BG), *CV = (bf16*)(ws + WS_CV), *SGC = (bf16*)(ws + WS_SGC), *SGP = (bf16*)(ws + WS_SGP), *Z = (bf16*)(ws + WS_Z), *PL = (bf16*)(ws + WS_PL);
    bf16 *XN1 = (bf16*)(ws + WS_XN1), *XN = (bf16*)(ws + WS_W1GU);
    float* SLAB = (float*)(ws + WS_SGP);
    volatile LAS unsigned* MISC = (volatile LAS unsigned*)(lds + LDS_BYTES - 128);
    if (tid < 32) MISC[tid] = 0u;
    unsigned* barw = (unsigned*)ws;
    if (bx == 0) for (int i = tid; i < XCD_BAR_WORDS; i += NWAVES * 64) __hip_atomic_store(barw + i, 0u, __ATOMIC_RELAXED, __HIP_MEMORY_SCOPE_AGENT);
    __syncthreads();

    {
        LAS float* scr = (LAS float*)(lds + wave * 16640);
        constexpr int IT_GU = (DM / 64) * (DFF / 64), IT_D = (DFF / 64) * (DM / 64), IT_IN = (DM / 64) * (DIN / 64), IT_SQ = (DM / 64) * (DM / 64), IT_PG = (256 / 64) * (512 / 64);
        constexpr int NITEMS = 4 * IT_GU + 2 * IT_D + IT_IN + 2 * IT_SQ + 4 * IT_PG;
        for (int it = gw; it < NITEMS; it += NGW) {
            int r = it;
            if (p0_job(r, a.w1g, DM, DFF, W1GU, 1, 0, scr, lane)) continue;
            if (p0_job(r, a.w1u, DM, DFF, W1GU, 2, 0, scr, lane)) continue;
            if (p0_job(r, a.w1d, DFF, DM, W1D, 0, 0, scr, lane)) continue;
            if (p0_job(r, a.w_in, DM, DIN, WIN, 3, 0, scr, lane)) continue;
            if (p0_job(r, a.w_conv_out, DM, DM, WCO, 0, 0, scr, lane)) continue;
            if (p0_job(r, a.w_o, DM, DM, WO, 0, 0, scr, lane)) continue;
            if (p0_job(r, a.w2g, DM, DFF, W2GU, 1, 0, scr, lane)) continue;
            if (p0_job(r, a.w2u, DM, DFF, W2GU, 2, 0, scr, lane)) continue;
            if (p0_job(r, a.w2d, DFF, DM, W2D, 0, 0, scr, lane)) continue;
            if (p0_job(r, a.w_pool + 0 * 256 * 512, 256, 512, WPG, 0, 0, scr, lane)) continue;
            if (p0_job(r, a.w_pool + 1 * 256 * 512, 256, 512, WPG, 0, 512, scr, lane)) continue;
            if (p0_job(r, a.w_pool + 2 * 256 * 512, 256, 512, WPG, 0, 1024, scr, lane)) continue;
            p0_job(r, a.w_pool + 3 * 256 * 512, 256, 512, WPG, 0, 1536, scr, lane);
        }
        for (int m = gw; m < MPAD; m += NGW) rms_row_bf16(src_row(a, m), a.norm_ffn1, XN1 + (size_t)m * DM, nullptr, lane);
    }
    grid.sync();
    const XcdBarrier bar = xcd_barrier_post(barw, MISC + 8);

    {
        pg8::Gemm g{XN1, W1GU, MPAD, 2 * DFF, DM, DM, DM, 0}; pg8::StaticOrder S; S.init(MPAD, 2 * DFF, DM, G, bx);
        pg8::EpiSwiglu E{ACT, DFF};
        pg8::gemm_phase<pg8::EpiSwiglu, pg8::StaticOrder, true, true>(lds, g, S, E);
    }
    xcd_barrier(bar);
    {
        pg8::Gemm g{ACT, W1D, MPAD, DM, DFF, DFF, DFF, 0}; pg8::TailOrder S; S.init(DFF, bx);
        pg8::EpiResid<true> E{H, DM, 0.5f, SLAB, a.x_prompt, a.x_sample, a.meta};
        pg8::gemm_phase<pg8::EpiResid<true>, pg8::TailOrder, true, true>(lds, g, S, E);
    }
    xcd_barrier(bar);
    for (int m = gw; m < MPAD; m += NGW) { float* hr = H + (size_t)m * DM; if (m < 8192) rms_row_bf16(hr, a.norm_mix, XN + (size_t)m * DM, nullptr, lane); else rms_row_bf16(src_row(a, m), a.norm_mix, XN + (size_t)m * DM, hr, lane, SLAB, 0.5f, m); }
    xcd_barrier(bar);
    {
        pg8::Gemm g{XN, WIN, MPAD, DIN, DM, DM, DM, 0}; pg8::StaticOrder S; S.init(MPAD, DIN, DM, G, bx);
        pg8::EpiProj E{BG, CV, Z, SGC, SGP};
        pg8::gemm_phase<pg8::EpiProj, pg8::StaticOrder, true, true>(lds, g, S, E);
    }
    xcd_barrier(bar);
    for (int m = gw; m < MREAL; m += NGW) {
        if (m >= MP_ROWS) p3b_row<true>(a, m, lane, BG, CV, Z, PL); else p3b_row<false>(a, m, lane, BG, CV, Z, PL);
    }
    xcd_barrier(bar);
    {
        pg8::Gemm g{PL, WPG, MPAD, DM, 256, DPOOL, 256, 1}; pg8::StaticOrder S; S.init(MPAD, DM, 256, G, bx);
        pg8::EpiPool E{SGP, a.pool_scale};
        pg8::gemm_phase<pg8::EpiPool, pg8::StaticOrder, true, true>(lds, g, S, E);
    }
    __syncthreads();
    {
        pg8::Gemm g{BG, WCO, MPAD, DM, DM, DM, DM, 0}; pg8::StaticOrder S; S.init(MPAD, DM, DM, G, bx);
        pg8::EpiMerge E{SGC, SGP};
        pg8::gemm_phase<pg8::EpiMerge, pg8::StaticOrder, true, true>(lds, g, S, E);
    }
    xcd_barrier(bar);
    {
        pg8::Gemm g{SGC, WO, MPAD, DM, DM, DM, DM, 0}; pg8::TailOrder S; S.init(DM, bx);
        pg8::EpiResid<false> E{H, DM, 1.0f, SLAB, nullptr, nullptr, nullptr};
        pg8::gemm_phase<pg8::EpiResid<false>, pg8::TailOrder, true, true>(lds, g, S, E);
    }
    xcd_barrier(bar);
    for (int m = gw; m < MPAD; m += NGW) { float* hr = H + (size_t)m * DM; if (m < 8192) rms_row_bf16(hr, a.norm_ffn2, XN + (size_t)m * DM, nullptr, lane); else rms_row_bf16(hr, a.norm_ffn2, XN + (size_t)m * DM, hr, lane, SLAB, 1.0f, m); }
    xcd_barrier(bar);
    {
        pg8::Gemm g{XN, W2GU, MPAD, 2 * DFF, DM, DM, DM, 0}; pg8::StaticOrder S; S.init(MPAD, 2 * DFF, DM, G, bx);
        pg8::EpiSwiglu E{ACT, DFF};
        pg8::gemm_phase<pg8::EpiSwiglu, pg8::StaticOrder, true, true>(lds, g, S, E);
    }
    xcd_barrier(bar);
    {
        pg8::Gemm g{ACT, W2D, MPAD, DM, DFF, DFF, DFF, 0}; pg8::TailOrder S; S.init(DFF, bx);
        pg8::EpiResid<false> E{H, DM, 0.5f, SLAB, nullptr, nullptr, nullptr};
        pg8::gemm_phase<pg8::EpiResid<false>, pg8::TailOrder, true, true>(lds, g, S, E);
    }
    xcd_barrier(bar);
    for (int m = gw; m < MREAL; m += NGW) {
        float* dst;
        if (m < MP_ROWS) { const int b = m / LP, t = m - b * LP; if (t < NMETA) continue; dst = a.out + O_YP + ((size_t)b * SEQ + (t - NMETA)) * DM; }
        else dst = a.out + O_YS + (size_t)(m - MP_ROWS) * DM;
        const float* hr = H + (size_t)m * DM;
        f32x4 v[8]; float s = 0.f;
#pragma unroll
        for (int j = 0; j < 8; ++j) { v[j] = ((const f32x4*)hr)[lane + 64 * j]; if (m >= 8192) v[j] += slab_sum(SLAB, m, j, lane) * 0.5f; s += (v[j].x * v[j].x + v[j].y * v[j].y) + (v[j].z * v[j].z + v[j].w * v[j].w); }
        const float r = 1.0f / sqrtf(wave_sum(s) * (1.0f / DM) + EPS);
#pragma unroll
        for (int j = 0; j < 8; ++j) { const f32x4 gg = ((const f32x4*)a.norm_final)[lane + 64 * j]; ((f32x4*)dst)[lane + 64 * j] = v[j] * r * gg; }
    }
}

extern "C" void kernel_launch(void* const* d_in, const int* in_sizes, int n_in, void* d_out, int out_size, void* d_ws, size_t ws_size, hipStream_t stream) {
    static int grid = 0;
    if (grid == 0) {
        if (n_in != 21 || (size_t)out_size != O_END || ws_size < WS_END) { fprintf(stderr, "kernel_launch: unexpected shapes: n_in %d out %d ws %zu (need %zu)\n", n_in, out_size, ws_size, (size_t)WS_END); grid = -1; return; }
        int dev = 0, cus = 0, per_cu = 0;
        hipGetDevice(&dev); hipDeviceGetAttribute(&cus, hipDeviceAttributeMultiprocessorCount, dev);
        if (hipFuncSetAttribute((const void*)fwd_megakernel, hipFuncAttributeMaxDynamicSharedMemorySize, LDS_BYTES) != hipSuccess) { fprintf(stderr, "kernel_launch: hipFuncSetAttribute failed\n"); grid = -1; return; }
        if (hipOccupancyMaxActiveBlocksPerMultiprocessor(&per_cu, (const void*)fwd_megakernel, NWAVES * 64, LDS_BYTES) != hipSuccess || per_cu < 1) { fprintf(stderr, "kernel_launch: occupancy query failed (%d)\n", per_cu); (void)hipGetLastError(); per_cu = 1; }
        grid = cus * 1;
        fprintf(stderr, "kernel_launch: grid %d (cus %d, per_cu %d)\n", grid, cus, per_cu);
    }
    if (grid < 0) return;
    Args a{};
    a.x_prompt = (const float*)d_in[0]; a.x_sample = (const float*)d_in[1]; a.state_conv = (const float*)d_in[2]; a.state_pool = (const float*)d_in[3]; a.meta = (const float*)d_in[4];
    a.norm_ffn1 = (const float*)d_in[5]; a.w1g = (const float*)d_in[6]; a.w1u = (const float*)d_in[7]; a.w1d = (const float*)d_in[8]; a.norm_mix = (const float*)d_in[9]; a.w_in = (const float*)d_in[10];
    a.conv_w = (const float*)d_in[11]; a.w_conv_out = (const float*)d_in[12]; a.w_pool = (const float*)d_in[13]; a.pool_scale = (const float*)d_in[14]; a.w_o = (const float*)d_in[15];
    a.norm_ffn2 = (const float*)d_in[16]; a.w2g = (const float*)d_in[17]; a.w2u = (const float*)d_in[18]; a.w2d = (const float*)d_in[19]; a.norm_final = (const float*)d_in[20];
    a.out = (float*)d_out; a.ws = (unsigned char*)d_ws;
    void* args[] = {&a};
    hipError_t e = hipLaunchCooperativeKernel((const void*)fwd_megakernel, dim3(grid), dim3(NWAVES * 64), args, LDS_BYTES, stream);
    if (e != hipSuccess) fprintf(stderr, "kernel_launch: cooperative launch failed: %s (grid %d)\n", hipGetErrorString(e), grid);
}
```

```cpp
#include <hip/hip_runtime.h>
#include <hip/hip_cooperative_groups.h>
#include <cstdio>
#include <cstdint>
namespace cg = cooperative_groups;

namespace pg8 {
#define PG8_LAS __attribute__((address_space(3)))
typedef unsigned short bf16_t;
typedef short bf16x8 __attribute__((ext_vector_type(8)));
typedef float f32x4 __attribute__((ext_vector_type(4)));
typedef unsigned u32x4 __attribute__((ext_vector_type(4)));
constexpr int BM = 256, BK = 64, HALF = 128, HTB = HALF * BK * 2  , STAGE_BYTES = 8 * HTB, NXCD = 8, WGM = 8;

__host__ __device__ __forceinline__ int lds_byte(int r, int c) { const int st = (r >> 4) * 2 + (c >> 5), rr = r & 15, cc = c & 31, ob = rr * 64 + cc * 2; return st * 1024 + (ob ^ (((ob >> 9) & 1) << 5)); }
__host__ __device__ __forceinline__ void stage_rc(int b, int& R, int& C) { const int st = b / 1024, sb = b % 1024, swz = sb ^ (((sb >> 9) & 1) << 5); R = (st >> 1) * 16 + swz / 64; C = (st & 1) * 32 + (swz % 64) / 2; }
__host__ __device__ __forceinline__ int perm32(int rho) { const int n = rho >> 4, i = rho & 15; return 8 * (i >> 2) + 4 * n + (i & 3); }

struct Unit { int pm, pn, kt0, nkt, slab; };
struct Gemm { const bf16_t* A; const bf16_t* Bt; int M, N, K, lda, ldb, agrp; };
__device__ __forceinline__ size_t acolb(const Gemm& g, const Unit& u) { return g.agrp ? (size_t)((u.pn >> 1) * 256) * 2 : (size_t)0; }

struct StaticOrder {
    int nM, nN, nwg, G, c, nt;
    __host__ __device__ void init(int M, int N, int K, int G_, int c_) { nM = M / BM; nN = N / BM; nwg = nM * nN; G = G_; c = c_; nt = K / BK; }
    __host__ __device__ bool next(int i, Unit& u) const {
        const long L = (long)i * G + c; if (L >= nwg) return false;
        int wgid = (int)L; { const int q = nwg / NXCD, r = nwg % NXCD, xcd = wgid % NXCD, off = wgid / NXCD; wgid = (xcd < r ? xcd * (q + 1) : r * (q + 1) + (xcd - r) * q) + off; }
        const int nig = WGM * nN, gid = wgid / nig, fm = gid * WGM, gsz = (nM - fm) < WGM ? (nM - fm) : WGM;
        u.pm = fm + ((wgid % nig) % gsz); u.pn = (wgid % nig) / gsz; u.kt0 = 0; u.nkt = nt; u.slab = -1; return true;
    }
    __device__ __forceinline__ void a_ready(const Unit&) const {}
    __device__ __forceinline__ void done(const Unit&) const {}
};
struct TailOrder {
    int c, nt;
    __host__ __device__ void init(int K, int c_) { c = c_; nt = K / BK; }
    __host__ __device__ bool next(int i, Unit& u) const {
        if (i == 0) { const int x = c & 7, idx = c >> 3; u.pm = 4 * x + (idx >> 3); u.pn = idx & 7; u.kt0 = 0; u.nkt = nt; u.slab = -1; return true; }
        if (i == 1 && c < 240) { const int j = c / 6, ch = c - 6 * j, np = nt >> 1, base = np / 6, rem = np % 6, p0 = ch * base + (ch < rem ? ch : rem), pc = base + (ch < rem ? 1 : 0);
            u.pm = 32 + (j >> 3); u.pn = j & 7; u.kt0 = 2 * p0; u.nkt = 2 * pc; u.slab = c; return true; }
        return false;
    }
    __device__ __forceinline__ void a_ready(const Unit&) const {}
    __device__ __forceinline__ void done(const Unit&) const {}
};

__device__ __forceinline__ unsigned cvt_pk_bf16(float lo, float hi) { unsigned r; asm volatile("v_cvt_pk_bf16_f32 %0, %1, %2" : "=v"(r) : "v"(lo), "v"(hi)); return r; }
__device__ __forceinline__ float bf_lo(unsigned w) { return __uint_as_float(w << 16); }
__device__ __forceinline__ float bf_hi(unsigned w) { return __uint_as_float(w & 0xffff0000u); }
__device__ __forceinline__ float sigmoidf_(float x) { return __builtin_amdgcn_rcpf(1.0f + __builtin_amdgcn_exp2f(-1.4426950408889634f * x)); }
__device__ __forceinline__ u32x4 pack8(const f32x4& a, const f32x4& b) { u32x4 w; w.x = cvt_pk_bf16(a[0], a[1]); w.y = cvt_pk_bf16(a[2], a[3]); w.z = cvt_pk_bf16(b[0], b[1]); w.w = cvt_pk_bf16(b[2], b[3]); return w; }
__device__ __forceinline__ void unpack8(const u32x4& w, f32x4& a, f32x4& b) { a = (f32x4){bf_lo(w.x), bf_hi(w.x), bf_lo(w.y), bf_hi(w.y)}; b = (f32x4){bf_lo(w.z), bf_hi(w.z), bf_lo(w.w), bf_hi(w.w)}; }

struct EpiSwiglu {
    static constexpr bool PERM = true, AFTER_DRAIN = false;
    bf16_t* O; int ldc;
    __device__ __forceinline__ void operator()(const f32x4 (&acc)[2][2][4][2], const Unit& u, int wr, int wc, int fr, int fq) const {
        const int row0 = u.pm * BM + wr * 64 + fr, col0 = u.pn * HALF + wc * 32 + 8 * fq;
#pragma unroll
        for (int ai = 0; ai < 2; ++ai)
#pragma unroll
            for (int m = 0; m < 4; ++m) {
                f32x4 v[2];
#pragma unroll
                for (int n = 0; n < 2; ++n) { const f32x4 gt = acc[ai][0][m][n], up = acc[ai][1][m][n];
#pragma unroll
                    for (int e = 0; e < 4; ++e) v[n][e] = gt[e] * sigmoidf_(gt[e]) * up[e]; }
                *(u32x4*)(O + (size_t)(row0 + ai * HALF + m * 16) * ldc + col0) = pack8(v[0], v[1]);
            }
    }
};
template <bool FROMX> struct EpiResid {
    static constexpr bool PERM = false, AFTER_DRAIN = false;
    float* H; int ldc; float s; float* SL;
    const float *xp, *xs, *meta;
    __device__ __forceinline__ void operator()(const f32x4 (&acc)[2][2][4][2], const Unit& u, int wr, int wc, int fr, int fq) const {
        if (u.slab >= 0) {
            float* base = SL + (size_t)u.slab * (BM * BM) + (size_t)(wr * 64 + fr) * BM + wc * 32 + 4 * fq;
#pragma unroll
            for (int ai = 0; ai < 2; ++ai)
#pragma unroll
                for (int m = 0; m < 4; ++m)
#pragma unroll
                    for (int bj = 0; bj < 2; ++bj)
#pragma unroll
                        for (int n = 0; n < 2; ++n) *(f32x4*)(base + (size_t)(ai * HALF + m * 16) * BM + bj * HALF + n * 16) = acc[ai][bj][m][n];
            return;
        }
        const int row0 = u.pm * BM + wr * 64 + fr, col0 = u.pn * BM + wc * 32 + 4 * fq;
#pragma unroll
        for (int ai = 0; ai < 2; ++ai)
#pragma unroll
            for (int m = 0; m < 4; ++m) { const int r = row0 + ai * HALF + m * 16; float* rowp = H + (size_t)r * ldc + col0;
                const float* srcp = rowp;
                if (FROMX) {
                    const int b = r / 2064, t = r - b * 2064;
                    srcp = (t < 16 ? meta + (size_t)t * 2048 : xp + ((size_t)b * 2048 + (t - 16)) * 2048) + col0;
                }
#pragma unroll
                for (int bj = 0; bj < 2; ++bj)
#pragma unroll
                    for (int n = 0; n < 2; ++n) { const f32x4 h = *(const f32x4*)(srcp + bj * HALF + n * 16); *(f32x4*)(rowp + bj * HALF + n * 16) = h + acc[ai][bj][m][n] * s; }
                if (m & 1) asm volatile("" ::: "memory"); }
    }
};
struct EpiProj {
    static constexpr bool PERM = true, AFTER_DRAIN = false;
    bf16_t *BG, *CV, *Z, *SGC, *SGP;
    __device__ __forceinline__ void operator()(const f32x4 (&acc)[2][2][4][2], const Unit& u, int wr, int wc, int fr, int fq) const {
        const int row0 = u.pm * BM + wr * 64 + fr, pn = u.pn;
        if (pn >= 8 && pn < 24) {
            const int col0 = (pn - 8) * HALF + wc * 32 + 8 * fq;
#pragma unroll
            for (int ai = 0; ai < 2; ++ai)
#pragma unroll
                for (int m = 0; m < 4; ++m)
                    *(u32x4*)(CV + (size_t)(row0 + ai * HALF + m * 16) * 2048 + col0) = pack8(acc[ai][0][m][0] * acc[ai][1][m][0], acc[ai][0][m][1] * acc[ai][1][m][1]);
        } else {
            bf16_t* base; int ld, ct; bool sg;
            if (pn < 8) { base = BG; ld = 2048; ct = pn; sg = false; }
            else if (pn < 28) { base = Z; ld = 1024; ct = pn - 24; sg = false; }
            else if (pn < 36) { base = SGC; ld = 2048; ct = pn - 28; sg = true; }
            else { base = SGP; ld = 2048; ct = pn - 36; sg = true; }
            const int col0 = ct * BM + wc * 32 + 8 * fq;
#pragma unroll
            for (int ai = 0; ai < 2; ++ai)
#pragma unroll
                for (int m = 0; m < 4; ++m) { bf16_t* rowp = base + (size_t)(row0 + ai * HALF + m * 16) * ld + col0;
#pragma unroll
                    for (int bj = 0; bj < 2; ++bj) { f32x4 v0 = acc[ai][bj][m][0], v1 = acc[ai][bj][m][1];
                        if (sg) {
#pragma unroll
                            for (int e = 0; e < 4; ++e) { v0[e] = sigmoidf_(v0[e]); v1[e] = sigmoidf_(v1[e]); } }
                        *(u32x4*)(rowp + bj * HALF) = pack8(v0, v1); } }
        }
    }
};
struct EpiPool {
    static constexpr bool PERM = true, AFTER_DRAIN = false;
    bf16_t* SGP; const float* ps;
    __device__ __forceinline__ void operator()(const f32x4 (&acc)[2][2][4][2], const Unit& u, int wr, int wc, int fr, int fq) const {
        const int row0 = u.pm * BM + wr * 64 + fr, col0 = u.pn * BM + wc * 32 + 8 * fq;
#pragma unroll
        for (int ai = 0; ai < 2; ++ai)
#pragma unroll
            for (int m = 0; m < 4; ++m) { bf16_t* rowp = SGP + (size_t)(row0 + ai * HALF + m * 16) * 2048 + col0;
#pragma unroll
                for (int bj = 0; bj < 2; ++bj) { u32x4* p = (u32x4*)(rowp + bj * HALF); f32x4 g0, g1; unpack8(*p, g0, g1);
                    const f32x4 s0 = *(const f32x4*)(ps + col0 + bj * HALF), s1 = *(const f32x4*)(ps + col0 + bj * HALF + 4);
                    *p = pack8(g0 * s0 * acc[ai][bj][m][0], g1 * s1 * acc[ai][bj][m][1]); }
                asm volatile("" ::: "memory"); }
    }
};
struct EpiMerge {
    static constexpr bool PERM = true, AFTER_DRAIN = false;
    bf16_t* SGC; const bf16_t* MP;
    __device__ __forceinline__ void operator()(const f32x4 (&acc)[2][2][4][2], const Unit& u, int wr, int wc, int fr, int fq) const {
        const int row0 = u.pm * BM + wr * 64 + fr, col0 = u.pn * BM + wc * 32 + 8 * fq;
#pragma unroll
        for (int ai = 0; ai < 2; ++ai)
#pragma unroll
            for (int m = 0; m < 4; ++m) { const size_t off = (size_t)(row0 + ai * HALF + m * 16) * 2048 + col0;
#pragma unroll
                for (int bj = 0; bj < 2; ++bj) { u32x4* p = (u32x4*)(SGC + off + bj * HALF); f32x4 g0, g1, q0, q1; unpack8(*p, g0, g1); unpack8(*(const u32x4*)(MP + off + bj * HALF), q0, q1);
                    *p = pack8(g0 * acc[ai][bj][m][0] + q0, g1 * acc[ai][bj][m][1] + q1); }
                if (m & 1) asm volatile("" ::: "memory"); }
    }
};

template <class Epi, class Sched, bool ALIGN_EPI = false, bool SP2 = false>
__device__ __forceinline__ void gemm_phase(PG8_LAS unsigned char* lds, const Gemm g, const Sched& S, const Epi& E) {
    int tid_ = threadIdx.x; asm volatile("" : "+v"(tid_));
    const int tid = tid_, wid = __builtin_amdgcn_readfirstlane(tid >> 6), lane = tid & 63, wr = wid >> 2, wc = wid & 3, fr = lane & 15, fq = lane >> 4;

    unsigned voffA[2], voffB[2];
#pragma unroll
    for (int i = 0; i < 2; ++i) { int R, C; stage_rc(tid * 16 + i * 8192, R, C); const int Rb = Epi::PERM ? ((R & ~31) + perm32(R & 31)) : R;
        voffA[i] = (unsigned)(R * g.lda + C) * 2u; voffB[i] = (unsigned)(Rb * g.ldb + C) * 2u; }
    const size_t kstep = (size_t)(BK * 2);
    const size_t hstepA = (size_t)HALF * g.lda * 2, hstepB = (size_t)HALF * g.ldb * 2;
    const size_t tstepA = 2 * hstepA, tstepB = 2 * hstepB;
    const unsigned ldsw = (unsigned)wid * 1024u;
    const int aoff = lds_byte(wr * 64 + fr, fq * 8), boff = lds_byte(wc * 32 + fr, fq * 8);
#define PG8_SA(b, h) (((b) * 2 + (h)) * HTB)
#define PG8_SB(b, h) ((4 + (b) * 2 + (h)) * HTB)
#define PG8_STAGE(bufoff, gbase, voff) do { _Pragma("unroll") for (int _i = 0; _i < 2; ++_i) \
        __builtin_amdgcn_global_load_lds((const unsigned*)((const char*)(gbase) + (voff)[_i]), (PG8_LAS unsigned*)(lds + (bufoff) + ldsw + _i * 8192), 16, 0, 0); } while (0)
#define PG8_LDA(dst, b, h) do { _Pragma("unroll") for (int m = 0; m < 4; ++m) _Pragma("unroll") for (int k = 0; k < 2; ++k) dst[m][k] = *(const PG8_LAS bf16x8*)(lds + PG8_SA(b, h) + aoff + m * 2048 + k * 1024); } while (0)
#define PG8_LDB(dst, b, h) do { _Pragma("unroll") for (int n = 0; n < 2; ++n) _Pragma("unroll") for (int k = 0; k < 2; ++k) dst[n][k] = *(const PG8_LAS bf16x8*)(lds + PG8_SB(b, h) + boff + n * 2048 + k * 1024); } while (0)
#define PG8_MMA(ai, bj, At, Bt) do { __builtin_amdgcn_s_setprio(1); _Pragma("unroll") for (int m = 0; m < 4; ++m) _Pragma("unroll") for (int n = 0; n < 2; ++n) _Pragma("unroll") for (int k = 0; k < 2; ++k) \
        acc[ai][bj][m][n] = __builtin_amdgcn_mfma_f32_16x16x32_bf16(Bt[n][k], At[m][k], acc[ai][bj][m][n], 0, 0, 0); __builtin_amdgcn_s_setprio(0); } while (0)
#define PG8_WAIT_V(n) asm volatile("s_waitcnt vmcnt(" #n ")" ::: "memory")
#define PG8_WAIT_L(n) asm volatile("s_waitcnt lgkmcnt(" #n ")" ::: "memory")
#define PG8_BAR __builtin_amdgcn_s_barrier()
#define PG8_SCHED __builtin_amdgcn_sched_barrier(0)
    Unit cur, nxt; int ui = 0;
    if (!S.next(0, cur)) return;
    f32x4 acc[2][2][4][2];
#pragma unroll
    for (int a = 0; a < 2; ++a)
#pragma unroll
        for (int b = 0; b < 2; ++b)
#pragma unroll
            for (int m = 0; m < 4; ++m)
#pragma unroll
                for (int n = 0; n < 2; ++n) acc[a][b][m][n] = (f32x4){0.f, 0.f, 0.f, 0.f};
    bf16x8 At[4][2], B0[2][2], B1[2][2];
    const char* cA = (const char*)g.A + (size_t)cur.pm * tstepA + acolb(g, cur) + (size_t)cur.kt0 * kstep; const char* cB = (const char*)g.Bt + (size_t)cur.pn * tstepB + (size_t)cur.kt0 * kstep;
    S.a_ready(cur);
    if constexpr (SP2) {
        PG8_STAGE(PG8_SB(0, 0), cB, voffB); PG8_STAGE(PG8_SB(0, 1), cB + hstepB, voffB); PG8_STAGE(PG8_SA(0, 0), cA, voffA); PG8_STAGE(PG8_SA(0, 1), cA + hstepA, voffA);
        if (wr == 1) PG8_BAR;
        PG8_WAIT_V(2); PG8_BAR;
        PG8_STAGE(PG8_SB(1, 0), cB + kstep, voffB); PG8_STAGE(PG8_SA(1, 0), cA + kstep, voffA); PG8_STAGE(PG8_SB(1, 1), cB + hstepB + kstep, voffB);
        PG8_WAIT_V(6); PG8_BAR;
    } else {
        PG8_STAGE(PG8_SB(0, 0), cB, voffB); PG8_STAGE(PG8_SA(0, 0), cA, voffA); PG8_STAGE(PG8_SB(0, 1), cB + hstepB, voffB); PG8_STAGE(PG8_SA(0, 1), cA + hstepA, voffA);
        if (wr == 1) PG8_BAR;
        PG8_WAIT_V(4); PG8_BAR;
        PG8_STAGE(PG8_SB(1, 0), cB + kstep, voffB); PG8_STAGE(PG8_SA(1, 0), cA + kstep, voffA); PG8_STAGE(PG8_SB(1, 1), cB + hstepB + kstep, voffB);
        PG8_WAIT_V(6); PG8_BAR;
    }
    for (;;) {
        const bool has_next = S.next(ui + 1, nxt);
        const char* nA = has_next ? (const char*)g.A + (size_t)nxt.pm * tstepA + acolb(g, nxt) + (size_t)nxt.kt0 * kstep : cA; const char* nB = has_next ? (const char*)g.Bt + (size_t)nxt.pn * tstepB + (size_t)nxt.kt0 * kstep : cB;
        const int nt = cur.nkt;
        for (int t = 0; t < nt; t += 2) {
            const bool last = (t == nt - 2);
            const char* a1 = cA + (size_t)(t + 1) * kstep;
            const char* a2 = last ? nA : cA + (size_t)(t + 2) * kstep; const char* b2 = last ? nB : cB + (size_t)(t + 2) * kstep;
            const char* a3 = a2 + kstep; const char* b3 = b2 + kstep;
            if (last && has_next) S.a_ready(nxt);
            if constexpr (SP2) {
            PG8_LDB(B0, 0, 0); PG8_LDB(B1, 0, 1); PG8_SCHED; PG8_LDA(At, 0, 0); PG8_STAGE(PG8_SA(1, 1), a1 + hstepA, voffA);
            PG8_WAIT_V(8); PG8_WAIT_L(0); PG8_BAR; PG8_MMA(0, 0, At, B0); PG8_MMA(0, 1, At, B1); PG8_BAR; PG8_SCHED;
            PG8_LDA(At, 0, 1); PG8_STAGE(PG8_SB(0, 0), b2, voffB); PG8_STAGE(PG8_SB(0, 1), b2 + hstepB, voffB); PG8_STAGE(PG8_SA(0, 0), a2, voffA);
            PG8_WAIT_V(8); PG8_WAIT_L(0); PG8_BAR; PG8_MMA(1, 0, At, B0); PG8_MMA(1, 1, At, B1); PG8_BAR; PG8_SCHED;
            PG8_LDB(B0, 1, 0); PG8_LDB(B1, 1, 1); PG8_SCHED; PG8_LDA(At, 1, 0); PG8_STAGE(PG8_SA(0, 1), a2 + hstepA, voffA);
            PG8_WAIT_V(8); PG8_WAIT_L(0); PG8_BAR; PG8_MMA(0, 0, At, B0); PG8_MMA(0, 1, At, B1); PG8_BAR; PG8_SCHED;
            PG8_LDA(At, 1, 1); PG8_STAGE(PG8_SB(1, 0), b3, voffB); PG8_STAGE(PG8_SB(1, 1), b3 + hstepB, voffB); PG8_STAGE(PG8_SA(1, 0), a3, voffA);
            PG8_WAIT_V(8); PG8_WAIT_L(0); PG8_BAR; PG8_MMA(1, 0, At, B0); PG8_MMA(1, 1, At, B1); PG8_BAR; PG8_SCHED;
            } else {
            PG8_LDB(B0, 0, 0); PG8_SCHED; PG8_LDA(At, 0, 0); PG8_STAGE(PG8_SA(1, 1), a1 + hstepA, voffA);
            PG8_WAIT_L(8); PG8_BAR; PG8_WAIT_L(0); PG8_MMA(0, 0, At, B0); PG8_BAR; PG8_SCHED;
            PG8_LDB(B1, 0, 1); PG8_STAGE(PG8_SB(0, 0), b2, voffB);
            PG8_BAR; PG8_WAIT_L(0); PG8_MMA(0, 1, At, B1); PG8_BAR;
            PG8_LDA(At, 0, 1); PG8_STAGE(PG8_SA(0, 0), a2, voffA);
            PG8_BAR; PG8_WAIT_L(0); PG8_MMA(1, 0, At, B0); PG8_BAR; PG8_SCHED;
            PG8_STAGE(PG8_SB(0, 1), b2 + hstepB, voffB);
            PG8_WAIT_V(6); PG8_BAR; PG8_MMA(1, 1, At, B1); PG8_BAR;
            PG8_LDB(B0, 1, 0); PG8_SCHED; PG8_LDA(At, 1, 0); PG8_STAGE(PG8_SA(0, 1), a2 + hstepA, voffA);
            PG8_WAIT_L(8); PG8_BAR; PG8_WAIT_L(0); PG8_MMA(0, 0, At, B0); PG8_BAR; PG8_SCHED;
            PG8_LDB(B1, 1, 1); PG8_STAGE(PG8_SB(1, 0), b3, voffB);
            PG8_BAR; PG8_WAIT_L(0); PG8_MMA(0, 1, At, B1); PG8_BAR;
            PG8_LDA(At, 1, 1); PG8_STAGE(PG8_SA(1, 0), a3, voffA);
            PG8_BAR; PG8_WAIT_L(0); PG8_MMA(1, 0, At, B0); PG8_BAR; PG8_SCHED;
            PG8_STAGE(PG8_SB(1, 1), b3 + hstepB, voffB);
            PG8_WAIT_V(6); PG8_BAR; PG8_MMA(1, 1, At, B1); PG8_BAR;
            }
        }
        if constexpr (ALIGN_EPI) { if (wr == 0) PG8_BAR; }
        if constexpr (!Epi::AFTER_DRAIN) { E(acc, cur, wr, wc, fr, fq); S.done(cur); }
        if (!has_next) break;
#pragma unroll
        for (int a = 0; a < 2; ++a)
#pragma unroll
            for (int b = 0; b < 2; ++b)
#pragma unroll
                for (int m = 0; m < 4; ++m)
#pragma unroll
                    for (int n = 0; n < 2; ++n) acc[a][b][m][n] = (f32x4){0.f, 0.f, 0.f, 0.f};
        cur = nxt; cA = nA; cB = nB; ++ui;
        if constexpr (ALIGN_EPI) { if (wr == 1) PG8_BAR; }
    }
    PG8_WAIT_V(0);
    if constexpr (!ALIGN_EPI) { if (wr == 0) PG8_BAR; }
    PG8_BAR;
    if constexpr (Epi::AFTER_DRAIN) { E.fused(acc, cur, wr, wc, fr, fq, lds, wid, lane); S.done(cur); }
#undef PG8_SA
#undef PG8_SB
#undef PG8_STAGE
#undef PG8_LDA
#undef PG8_LDB
#undef PG8_MMA
#undef PG8_WAIT_V
#undef PG8_WAIT_L
#undef PG8_BAR
#undef PG8_SCHED
}
}

constexpr int DM = 2048, NB = 4, SEQ = 2048, NMETA = 16, LP = SEQ + NMETA  , DECB = 128, DECS = 8;
constexpr int DFF = 5632, DPOOL = 1024, DIN = 11264;
constexpr int MP_ROWS = NB * LP;
constexpr int MS_ROWS = DECB * DECS;
constexpr int MREAL = MP_ROWS + MS_ROWS;
constexpr int MPAD = 9472;
constexpr float EPS = 1e-6f;
constexpr int NWAVES = 8;

constexpr size_t O_YP = 0, O_YS = O_YP + (size_t)NB * SEQ * DM, O_NCP = O_YS + (size_t)MS_ROWS * DM, O_NPP = O_NCP + (size_t)NB * 2 * DM,
                 O_NCS = O_NPP + (size_t)NB * 15 * DPOOL, O_NPS = O_NCS + (size_t)DECB * 2 * DM, O_END = O_NPS + (size_t)DECB * 15 * DPOOL;

constexpr size_t MiB = 1u << 20;
constexpr size_t WS_W1GU = 1 * MiB;
constexpr size_t WS_W1D = WS_W1GU + 44 * MiB;
constexpr size_t WS_WIN = WS_W1D + 22 * MiB;
constexpr size_t WS_WCO = WS_WIN + 44 * MiB;
constexpr size_t WS_WPG = WS_WCO + 8 * MiB;
constexpr size_t WS_WO = WS_WPG + 1 * MiB;
constexpr size_t WS_W2GU = WS_WO + 8 * MiB;
constexpr size_t WS_W2D = WS_W2GU + 44 * MiB;
constexpr size_t WS_H = WS_W2D + 22 * MiB;
constexpr size_t WS_R = WS_H + 74 * MiB;
constexpr size_t WS_BG = WS_R, WS_CV = WS_R + 37 * MiB, WS_SGC = WS_R + 74 * MiB, WS_SGP = WS_R + 111 * MiB, WS_Z = WS_R + 148 * MiB, WS_PL = WS_Z + 19 * MiB;
constexpr size_t WS_XN1 = WS_SGP;
constexpr size_t WS_END = WS_PL + 19 * MiB;
static_assert((size_t)MPAD * DFF * 2 <= 111 * MiB, "ACT fits below XN1");

#define GAS __attribute__((address_space(1)))
#define LAS __attribute__((address_space(3)))
typedef unsigned short bf16;
typedef unsigned v4u __attribute__((ext_vector_type(4)));
typedef float f32x4 __attribute__((ext_vector_type(4)));
#define LDS_WAIT() asm volatile("s_waitcnt lgkmcnt(0)" ::: "memory")
constexpr int LDS_BYTES = 147456;

struct Args {
    const float *x_prompt, *x_sample, *state_conv, *state_pool, *meta, *norm_ffn1, *w1g, *w1u, *w1d, *norm_mix, *w_in, *conv_w, *w_conv_out, *w_pool, *pool_scale, *w_o, *norm_ffn2, *w2g, *w2u, *w2d, *norm_final;
    float* out; unsigned char* ws;
};

__device__ __forceinline__ unsigned pk2(float lo, float hi) { return pg8::cvt_pk_bf16(lo, hi); }
__device__ __forceinline__ float wave_sum(float v) {
#pragma unroll
    for (int o = 1; o < 64; o <<= 1) v += __shfl_xor(v, o);
    return v;
}
__device__ __forceinline__ const float* src_row(const Args& a, int r) {
    if (r < MP_ROWS) { const int b = r / LP, t = r - b * LP; return t < NMETA ? a.meta + (size_t)t * DM : a.x_prompt + ((size_t)b * SEQ + (t - NMETA)) * DM; }
    if (r < MREAL) return a.x_sample + (size_t)(r - MP_ROWS) * DM;
    return nullptr;
}
__device__ __forceinline__ void p0_transpose_item(const float* W, int N, bf16* WT, int K, int k0, int n0, int drow0, LAS float* scr, int lane) {
    const int lr = lane >> 4, lc = (lane & 15) * 4;
    f32x4 v[16];
#pragma unroll
    for (int i = 0; i < 16; ++i) v[i] = *(const f32x4*)(W + (size_t)(k0 + 4 * i + lr) * N + n0 + lc);
#pragma unroll
    for (int i = 0; i < 16; ++i) { LAS float* s = scr + (4 * i + lr) * 65 + lc; s[0] = v[i].x; s[1] = v[i].y; s[2] = v[i].z; s[3] = v[i].w; }
    LDS_WAIT(); asm volatile("" ::: "memory");
    const int c = lane & 7;
#pragma unroll
    for (int j = 0; j < 8; ++j) { const int n = (lane >> 3) + 8 * j; const LAS float* s = scr + (8 * c) * 65 + n;
        v4u o; o.x = pk2(s[0 * 65], s[1 * 65]); o.y = pk2(s[2 * 65], s[3 * 65]); o.z = pk2(s[4 * 65], s[5 * 65]); o.w = pk2(s[6 * 65], s[7 * 65]);
        *(v4u*)(WT + (size_t)(drow0 + n) * K + k0 + 8 * c) = o; }
    LDS_WAIT(); asm volatile("" ::: "memory");
}
__device__ __forceinline__ bool p0_job(int& r, const float* W, int K, int N, bf16* WT, int kind, int roff, LAS float* scr, int lane) {
    const int nb = N / 64, items = (K / 64) * nb;
    if (r >= items) { r -= items; return false; }
    const int kb = r / nb, n0 = (r % nb) * 64;
    int d;
    if (kind == 0) d = roff + n0;
    else if (kind == 1) d = (n0 >> 7) * 256 + (n0 & 127);
    else if (kind == 2) d = (n0 >> 7) * 256 + 128 + (n0 & 127);
    else { if (n0 < 2048 || n0 >= 6144) d = n0; else if (n0 < 4096) { const int j = n0 - 2048; d = 2048 + (j >> 7) * 256 + (j & 127); } else { const int j = n0 - 4096; d = 2048 + (j >> 7) * 256 + 128 + (j & 127); } }
    p0_transpose_item(W, N, WT, K, kb * 64, n0, d, scr, lane);
    return true;
}
__device__ __forceinline__ f32x4 slab_sum(const float* SL, int m, int j, int lane) {
    const float* p = SL + (size_t)(((m >> 8) - 32) * 8 + j) * 6 * 65536 + (size_t)(m & 255) * 256 + 4 * lane;
    f32x4 a = *(const f32x4*)p;
#pragma unroll
    for (int ch = 1; ch < 6; ++ch) a += *(const f32x4*)(p + (size_t)ch * 65536);
    return a;
}
__device__ __forceinline__ void rms_row_bf16(const float* xrow, const float* g, bf16* orow, float* hout, int lane, const float* SL = nullptr, float sc = 0.f, int m = 0) {
    f32x4 v[8]; float s = 0.f;
    const bool red = SL && m >= 8192;
#pragma unroll
    for (int j = 0; j < 8; ++j) {
        v[j] = xrow ? ((const f32x4*)xrow)[lane + 64 * j] : (f32x4){0.f, 0.f, 0.f, 0.f};
        if (red) v[j] += slab_sum(SL, m, j, lane) * sc;
        s += (v[j].x * v[j].x + v[j].y * v[j].y) + (v[j].z * v[j].z + v[j].w * v[j].w);
    }
    const float r = 1.0f / sqrtf(wave_sum(s) * (1.0f / DM) + EPS);
#pragma unroll
    for (int j = 0; j < 8; ++j) {
        if (hout) ((f32x4*)hout)[lane + 64 * j] = v[j];
        const f32x4 gg = ((const f32x4*)g)[lane + 64 * j];
        const unsigned lo = pk2(v[j].x * r * gg.x, v[j].y * r * gg.y), hi = pk2(v[j].z * r * gg.z, v[j].w * r * gg.w);
        ((unsigned long long*)orow)[lane + 64 * j] = (unsigned long long)lo | ((unsigned long long)hi << 32);
    }
}
__device__ __forceinline__ void load8_bf16(const bf16* p, float (&o)[8]) { const v4u w = *(const v4u*)p; o[0] = pg8::bf_lo(w.x); o[1] = pg8::bf_hi(w.x); o[2] = pg8::bf_lo(w.y); o[3] = pg8::bf_hi(w.y); o[4] = pg8::bf_lo(w.z); o[5] = pg8::bf_hi(w.z); o[6] = pg8::bf_lo(w.w); o[7] = pg8::bf_hi(w.w); }
__device__ __forceinline__ void load8_f32(const float* p, float (&o)[8]) { const f32x4 a = ((const f32x4*)p)[0], b = ((const f32x4*)p)[1]; o[0] = a.x; o[1] = a.y; o[2] = a.z; o[3] = a.w; o[4] = b.x; o[5] = b.y; o[6] = b.z; o[7] = b.w; }
__device__ __forceinline__ void store8_f32(float* p, const float (&o)[8]) { ((f32x4*)p)[0] = (f32x4){o[0], o[1], o[2], o[3]}; ((f32x4*)p)[1] = (f32x4){o[4], o[5], o[6], o[7]}; }


__device__ __forceinline__ void acc8_bf16(const v4u& w, float msk, float (&s)[8]) {
    s[0] += msk * pg8::bf_lo(w.x); s[1] += msk * pg8::bf_hi(w.x); s[2] += msk * pg8::bf_lo(w.y); s[3] += msk * pg8::bf_hi(w.y);
    s[4] += msk * pg8::bf_lo(w.z); s[5] += msk * pg8::bf_hi(w.z); s[6] += msk * pg8::bf_lo(w.w); s[7] += msk * pg8::bf_hi(w.w);
}
template <bool SMP>
__device__ __forceinline__ void p3b_row(const Args& a, int m, int lane, bf16* BG, const bf16* CV, const bf16* Z, bf16* PL) {
    int sq, t;
    if (SMP) { sq = (m - MP_ROWS) >> 3; t = (m - MP_ROWS) & 7; } else { sq = m / LP; t = m - sq * LP; }
    constexpr int L = SMP ? DECS : LP;
    const float* sc = a.state_conv + (size_t)sq * 2 * DM;
    const float* sp = a.state_pool + (size_t)sq * 15 * DPOOL;
    float* ncv = (t >= L - 2) ? a.out + (SMP ? O_NCS : O_NCP) + ((size_t)sq * 2 + (t - (L - 2))) * DM : nullptr;
    const float m1 = t >= 1 ? 1.f : 0.f, m2 = t >= 2 ? 1.f : 0.f;
    const int r1 = t >= 1 ? m - 1 : m, r2 = t >= 2 ? m - 2 : m;
#pragma unroll 2
    for (int j = 0; j < 4; ++j) {
        const int col = 512 * j + 8 * lane;
        float c0[8], c1[8], c2[8], bg[8], w0[8], w1[8], w2[8], o[8];
        load8_bf16(CV + (size_t)m * DM + col, c2); load8_bf16(CV + (size_t)r1 * DM + col, c1); load8_bf16(CV + (size_t)r2 * DM + col, c0);
        load8_bf16(BG + (size_t)m * DM + col, bg);
        load8_f32(a.conv_w + col, w0); load8_f32(a.conv_w + DM + col, w1); load8_f32(a.conv_w + 2 * DM + col, w2);
#pragma unroll
        for (int e = 0; e < 8; ++e) { c1[e] *= m1; c0[e] *= m2; }
        if (SMP) {
            float s1[8], s0[8];
            load8_f32(sc + (size_t)DM + col, s1); load8_f32(sc + (size_t)(t == 1 ? DM : 0) + col, s0);
#pragma unroll
            for (int e = 0; e < 8; ++e) { c1[e] += (1.f - m1) * s1[e]; c0[e] += (1.f - m2) * s0[e]; }
        }
#pragma unroll
        for (int e = 0; e < 8; ++e) o[e] = bg[e] * (w0[e] * c0[e] + w1[e] * c1[e] + w2[e] * c2[e]);
        v4u w; w.x = pk2(o[0], o[1]); w.y = pk2(o[2], o[3]); w.z = pk2(o[4], o[5]); w.w = pk2(o[6], o[7]);
        *(v4u*)(BG + (size_t)m * DM + col) = w;
        if (ncv) store8_f32(ncv + col, c2);
    }
    float* npp = nullptr;
    if (SMP) npp = a.out + O_NPS + ((size_t)sq * 15 + 7 + t) * DPOOL; else if (t >= L - 15) npp = a.out + O_NPP + ((size_t)sq * 15 + (t - (L - 15))) * DPOOL;
#pragma unroll
    for (int j = 0; j < 2; ++j) {
        const int col = 512 * j + 8 * lane, gq = col >> 8, k = 2 << gq;
        float z0[8], s[8];
        load8_bf16(Z + (size_t)m * DPOOL + col, z0);
#pragma unroll
        for (int e = 0; e < 8; ++e) s[e] = z0[e];
        if (j == 0) {
#pragma unroll
            for (int i = 1; i < 4; ++i) { const bool in = t - i >= 0; const v4u w = *(const v4u*)(Z + (size_t)(in ? m - i : m) * DPOOL + col); acc8_bf16(w, (in && i < k) ? 1.f : 0.f, s); }
            if (SMP) {
#pragma unroll
                for (int i = 1; i < 4; ++i) { const bool st = t - i < 0; float q[8]; load8_f32(sp + (size_t)(st ? 15 + t - i : 0) * DPOOL + col, q); const float mk = (st && i < k) ? 1.f : 0.f;
#pragma unroll
                    for (int e = 0; e < 8; ++e) s[e] += mk * q[e]; }
            }
        } else {
#pragma unroll
            for (int i = 1; i < 16; ++i) { const bool in = t - i >= 0; const v4u w = *(const v4u*)(Z + (size_t)(in ? m - i : m) * DPOOL + col); acc8_bf16(w, (in && i < k) ? 1.f : 0.f, s); }
            if (SMP) {
#pragma unroll
                for (int i = 1; i < 16; ++i) { const bool st = t - i < 0; float q[8]; load8_f32(sp + (size_t)(st ? 15 + t - i : 0) * DPOOL + col, q); const float mk = (st && i < k) ? 1.f : 0.f;
#pragma unroll
                    for (int e = 0; e < 8; ++e) s[e] += mk * q[e]; }
            }
        }
        const int cnt = SMP ? k : (k < t + 1 ? k : t + 1);
        const float inv = 1.0f / (float)cnt;
        float o[8];
#pragma unroll
        for (int e = 0; e < 8; ++e) o[e] = s[e] * inv - z0[e];
        v4u w; w.x = pk2(o[0], o[1]); w.y = pk2(o[2], o[3]); w.z = pk2(o[4], o[5]); w.w = pk2(o[6], o[7]);
        *(v4u*)(PL + (size_t)m * DPOOL + col) = w;
        if (npp) store8_f32(npp + col, z0);
        if (SMP && t < 7) { float q[8]; load8_f32(sp + (size_t)(8 + t) * DPOOL + col, q); store8_f32(a.out + O_NPS + ((size_t)sq * 15 + t) * DPOOL + col, q); }
    }
}

constexpr int NI_GU = (DM / 64) * (DFF / 64), NI_D = (DFF / 64) * (DM / 64), NI_IN = (DM / 64) * (DIN / 64), NI_SQ = (DM / 64) * (DM / 64), NI_PG = (256 / 64) * (512 / 64);
constexpr int IT_W1G = 0, IT_W1D = 2 * NI_GU, IT_WCO = IT_W1D + NI_D + NI_IN, IT_W2G = IT_WCO + 2 * NI_SQ + 4 * NI_PG, IT_W2D = IT_W2G + 2 * NI_GU, IT_END = IT_W2D + NI_D;
__device__ __forceinline__ void convert_items(const Args& a, unsigned char* ws, int it_lo, int it_hi, int widx, int nw, LAS unsigned char* lds, int wave, int lane) {
    LAS float* scr = (LAS float*)(lds + wave * 16640);
    bf16 *W1GU = (bf16*)(ws + WS_W1GU), *W1D = (bf16*)(ws + WS_W1D), *WIN = (bf16*)(ws + WS_WIN), *WCO = (bf16*)(ws + WS_WCO), *WPG = (bf16*)(ws + WS_WPG), *WO = (bf16*)(ws + WS_WO),
         *W2GU = (bf16*)(ws + WS_W2GU), *W2D = (bf16*)(ws + WS_W2D);
    for (int it = it_lo + widx; it < it_hi; it += nw) {
        int r = it;
        if (p0_job(r, a.w1g, DM, DFF, W1GU, 1, 0, scr, lane)) continue;
        if (p0_job(r, a.w1u, DM, DFF, W1GU, 2, 0, scr, lane)) continue;
        if (p0_job(r, a.w1d, DFF, DM, W1D, 0, 0, scr, lane)) continue;
        if (p0_job(r, a.w_in, DM, DIN, WIN, 3, 0, scr, lane)) continue;
        if (p0_job(r, a.w_conv_out, DM, DM, WCO, 0, 0, scr, lane)) continue;
        if (p0_job(r, a.w_o, DM, DM, WO, 0, 0, scr, lane)) continue;
        if (p0_job(r, a.w_pool + 0 * 256 * 512, 256, 512, WPG, 0, 0, scr, lane)) continue;
        if (p0_job(r, a.w_pool + 1 * 256 * 512, 256, 512, WPG, 0, 512, scr, lane)) continue;
        if (p0_job(r, a.w_pool + 2 * 256 * 512, 256, 512, WPG, 0, 1024, scr, lane)) continue;
        if (p0_job(r, a.w_pool + 3 * 256 * 512, 256, 512, WPG, 0, 1536, scr, lane)) continue;
        if (p0_job(r, a.w2g, DM, DFF, W2GU, 1, 0, scr, lane)) continue;
        if (p0_job(r, a.w2u, DM, DFF, W2GU, 2, 0, scr, lane)) continue;
        p0_job(r, a.w2d, DFF, DM, W2D, 0, 0, scr, lane);
    }
}

#define XB_TMO      128
#define XB_XCNT(j)  (256  + 64 * (j))
#define XB_XSUB(j)  (1280 + 64 * (j))
#define XB_XGEN(j)  (2304 + 64 * (j))
#define XB_TOP      3328
#define XB_TOPGEN   3392
#define XCD_BAR_WORDS 3456
#define XB_SPIN_CAP (1u << 18)

__device__ __forceinline__ unsigned xb_ld(unsigned* p)              { return __hip_atomic_load(p, __ATOMIC_RELAXED, __HIP_MEMORY_SCOPE_AGENT); }
__device__ __forceinline__ unsigned xb_add(unsigned* p, unsigned v) { return __hip_atomic_fetch_add(p, v, __ATOMIC_RELAXED, __HIP_MEMORY_SCOPE_AGENT); }
__device__ __forceinline__ unsigned xb_xcc_id() { return (unsigned)__builtin_amdgcn_s_getreg((3 << 11) | 20) & 0xFu; }
#define XB_SPIN(cond, bar) do { unsigned _sp = 0; while (cond) { __builtin_amdgcn_s_sleep(1); \
    if ((++_sp & 255u) == 0u) { if (xb_ld(&(bar)[XB_TMO])) break; if (_sp > XB_SPIN_CAP) { atomicAdd(&(bar)[XB_TMO], 1u); break; } } } } while (0)

struct XcdBarrier {
    unsigned* bar; unsigned x;
    volatile LAS unsigned* st;
};

__device__ __forceinline__ XcdBarrier xcd_barrier_post(unsigned* bar, volatile LAS unsigned* st) {
    XcdBarrier b; b.bar = bar; b.x = xb_xcc_id(); b.st = st;
    if (threadIdx.x == 0) (void)xb_add(&bar[XB_XCNT(b.x)], 1u);
    return b;
}
__device__ __forceinline__ void xcd_barrier_complete(unsigned* bar, unsigned x, unsigned& nloc, unsigned& nx) {
    const unsigned G = gridDim.x * gridDim.y * gridDim.z;
    unsigned sum, cnt, mine, sp = 0u;
    for (;;) {
        sum = 0u; cnt = 0u; mine = 0u;
#pragma unroll
        for (unsigned j = 0; j < 16; ++j) { const unsigned c = xb_ld(&bar[XB_XCNT(j)]); sum += c; cnt += (c > 0u) ? 1u : 0u; mine = (j == x) ? c : mine; }
        if (sum == G) break;
        __builtin_amdgcn_s_sleep(1);
        if ((++sp & 255u) == 0u) { if (xb_ld(&bar[XB_TMO])) break; if (sp > XB_SPIN_CAP) { atomicAdd(&bar[XB_TMO], 1u); break; } }
    }
    nloc = mine > 0u ? mine : 1u; nx = cnt > 0u ? cnt : 1u;
}

__device__ __forceinline__ void xcd_barrier(const XcdBarrier& b) {
    asm volatile("s_waitcnt vmcnt(0)" ::: "memory");
    __syncthreads();
    if (threadIdx.x == 0) {
        unsigned* bar = b.bar;
        __builtin_amdgcn_s_waitcnt(0);
        unsigned nloc = b.st[0], nx = b.st[1];
        if (nloc == 0u) { xcd_barrier_complete(bar, b.x, nloc, nx); b.st[0] = nloc; b.st[1] = nx; }
        const unsigned old = xb_add(&bar[XB_XSUB(b.x)], 1u);
        const unsigned gen = old / nloc;
        if (old + 1u == (gen + 1u) * nloc) {
            __builtin_amdgcn_fence(__ATOMIC_RELEASE, "agent");
            asm volatile("s_waitcnt vmcnt(0)" ::: "memory");
            const unsigned og = xb_add(&bar[XB_TOP], 1u);
            const unsigned tg = og / nx;
            if (og + 1u == (tg + 1u) * nx) xb_add(&bar[XB_TOPGEN], 1u);
            else XB_SPIN(xb_ld(&bar[XB_TOPGEN]) == tg, bar);
            __builtin_amdgcn_fence(__ATOMIC_ACQUIRE, "agent");
            xb_add(&bar[XB_XGEN(b.x)], 1u);
            asm volatile("s_waitcnt vmcnt(0)" ::: "memory");
        } else {
            XB_SPIN(xb_ld(&bar[XB_XGEN(b.x)]) == gen, bar);
            __builtin_amdgcn_fence(__ATOMIC_ACQUIRE, "agent");
            asm volatile("s_waitcnt vmcnt(0)" ::: "memory");
        }
    }
    __syncthreads();
}

__global__ void __launch_bounds__(NWAVES * 64) fwd_megakernel(Args a) {
    extern __shared__ __attribute__((aligned(16))) unsigned char lds_raw[];
    cg::grid_group grid = cg::this_grid();
    LAS unsigned char* lds = (LAS unsigned char*)lds_raw;
    const int tid = threadIdx.x, lane = tid & 63, wave = __builtin_amdgcn_readfirstlane(tid >> 6);
    const int G = gridDim.x, bx = blockIdx.x;
    const int gw = bx * NWAVES + wave, NGW = G * NWAVES;
    unsigned char* ws = a.ws;
    bf16 *W1GU = (bf16*)(ws + WS_W1GU), *W1D = (bf16*)(ws + WS_W1D), *WIN = (bf16*)(ws + WS_WIN), *WCO = (bf16*)(ws + WS_WCO), *WPG = (bf16*)(ws + WS_WPG), *WO = (bf16*)(ws + WS_WO),
         *W2GU = (bf16*)(ws + WS_W2GU), *W2D = (bf16*)(ws + WS_W2D);
    float* H = (float*)(ws + WS_H);
    bf16 *ACT = (bf16*)(ws + WS_R), *BG = (bf16*)(ws + WS_BG), *CV = (bf16*)(ws + WS_CV), *SGC = (bf16*)(ws + WS_SGC), *SGP = (bf16*)(ws + WS_SGP), *Z = (bf16*)(ws + WS_Z), *PL = (bf16*)(ws + WS_PL);
    bf16 *XN1 = (bf16*)(ws + WS_XN1), *XN = (bf16*)(ws + WS_W1GU);
    float* SLAB = (float*)(ws + WS_SGP);
    volatile LAS unsigned* MISC = (volatile LAS unsigned*)(lds + LDS_BYTES - 128);
    if (tid < 32) MISC[tid] = 0u;
    unsigned* barw = (unsigned*)ws;
    if (bx == 0) for (int i = tid; i < XCD_BAR_WORDS; i += NWAVES * 64) __hip_atomic_store(barw + i, 0u, __ATOMIC_RELAXED, __HIP_MEMORY_SCOPE_AGENT);
    __syncthreads();

    {
        convert_items(a, ws, IT_W1G, IT_W1D, gw, NGW, lds, wave, lane);
        for (int m = gw; m < MPAD; m += NGW) rms_row_bf16(src_row(a, m), a.norm_ffn1, XN1 + (size_t)m * DM, nullptr, lane);
    }
    grid.sync();
    const XcdBarrier bar = xcd_barrier_post(barw, MISC + 8);

    {
        pg8::Gemm g{XN1, W1GU, MPAD, 2 * DFF, DM, DM, DM, 0}; pg8::StaticOrder S; S.init(MPAD, 2 * DFF, DM, G, bx);
        pg8::EpiSwiglu E{ACT, DFF};
        pg8::gemm_phase<pg8::EpiSwiglu, pg8::StaticOrder, true, true>(lds, g, S, E);
        constexpr int FULL = (MPAD / 256) * (2 * DFF / 256) % 256;
        if (bx >= FULL) convert_items(a, ws, IT_W1D, IT_WCO, (bx - FULL) * NWAVES + wave, (G - FULL) * NWAVES, lds, wave, lane);
    }
    xcd_barrier(bar);
    {
        pg8::Gemm g{ACT, W1D, MPAD, DM, DFF, DFF, DFF, 0}; pg8::TailOrder S; S.init(DFF, bx);
        pg8::EpiResid<true> E{H, DM, 0.5f, SLAB, a.x_prompt, a.x_sample, a.meta};
        pg8::gemm_phase<pg8::EpiResid<true>, pg8::TailOrder, true, true>(lds, g, S, E);
    }
    xcd_barrier(bar);
    for (int m = gw; m < MPAD; m += NGW) { float* hr = H + (size_t)m * DM; if (m < 8192) rms_row_bf16(hr, a.norm_mix, XN + (size_t)m * DM, nullptr, lane); else rms_row_bf16(src_row(a, m), a.norm_mix, XN + (size_t)m * DM, hr, lane, SLAB, 0.5f, m); }
    xcd_barrier(bar);
    {
        pg8::Gemm g{XN, WIN, MPAD, DIN, DM, DM, DM, 0}; pg8::StaticOrder S; S.init(MPAD, DIN, DM, G, bx);
        pg8::EpiProj E{BG, CV, Z, SGC, SGP};
        pg8::gemm_phase<pg8::EpiProj, pg8::StaticOrder, true, true>(lds, g, S, E);
        constexpr int FULL = (MPAD / 256) * (DIN / 256) % 256;
        if (bx >= FULL) convert_items(a, ws, IT_WCO, IT_W2G, (bx - FULL) * NWAVES + wave, (G - FULL) * NWAVES, lds, wave, lane);
    }
    xcd_barrier(bar);
    for (int m = gw; m < MREAL; m += NGW) {
        if (m >= MP_ROWS) p3b_row<true>(a, m, lane, BG, CV, Z, PL); else p3b_row<false>(a, m, lane, BG, CV, Z, PL);
    }
    xcd_barrier(bar);
    {
        pg8::Gemm g{PL, WPG, MPAD, DM, 256, DPOOL, 256, 1}; pg8::StaticOrder S; S.init(MPAD, DM, 256, G, bx);
        pg8::EpiPool E{SGP, a.pool_scale};
        pg8::gemm_phase<pg8::EpiPool, pg8::StaticOrder, true, true>(lds, g, S, E);
    }
    __syncthreads();
    {
        pg8::Gemm g{BG, WCO, MPAD, DM, DM, DM, DM, 0}; pg8::StaticOrder S; S.init(MPAD, DM, DM, G, bx);
        pg8::EpiMerge E{SGC, SGP};
        pg8::gemm_phase<pg8::EpiMerge, pg8::StaticOrder, true, true>(lds, g, S, E);
        constexpr int FULL = (MPAD / 256) * (DM / 256) % 256;
        if (bx >= FULL) convert_items(a, ws, IT_W2G, IT_W2D, (bx - FULL) * NWAVES + wave, (G - FULL) * NWAVES, lds, wave, lane);
    }
    xcd_barrier(bar);
    {
        pg8::Gemm g{SGC, WO, MPAD, DM, DM, DM, DM, 0}; pg8::TailOrder S; S.init(DM, bx);
        pg8::EpiResid<false> E{H, DM, 1.0f, SLAB, nullptr, nullptr, nullptr};
        pg8::gemm_phase<pg8::EpiResid<false>, pg8::TailOrder, true, true>(lds, g, S, E);
    }
    xcd_barrier(bar);
    for (int m = gw; m < MPAD; m += NGW) { float* hr = H + (size_t)m * DM; if (m < 8192) rms_row_bf16(hr, a.norm_ffn2, XN + (size_t)m * DM, nullptr, lane); else rms_row_bf16(hr, a.norm_ffn2, XN + (size_t)m * DM, hr, lane, SLAB, 1.0f, m); }
    xcd_barrier(bar);
    {
        pg8::Gemm g{XN, W2GU, MPAD, 2 * DFF, DM, DM, DM, 0}; pg8::StaticOrder S; S.init(MPAD, 2 * DFF, DM, G, bx);
        pg8::EpiSwiglu E{ACT, DFF};
        pg8::gemm_phase<pg8::EpiSwiglu, pg8::StaticOrder, true, true>(lds, g, S, E);
        constexpr int FULL = (MPAD / 256) * (2 * DFF / 256) % 256;
        if (bx >= FULL) convert_items(a, ws, IT_W2D, IT_END, (bx - FULL) * NWAVES + wave, (G - FULL) * NWAVES, lds, wave, lane);
    }
    xcd_barrier(bar);
    {
        pg8::Gemm g{ACT, W2D, MPAD, DM, DFF, DFF, DFF, 0}; pg8::TailOrder S; S.init(DFF, bx);
        pg8::EpiResid<false> E{H, DM, 0.5f, SLAB, nullptr, nullptr, nullptr};
        pg8::gemm_phase<pg8::EpiResid<false>, pg8::TailOrder, true, true>(lds, g, S, E);
    }
    xcd_barrier(bar);
    for (int m = gw; m < MREAL; m += NGW) {
        float* dst;
        if (m < MP_ROWS) { const int b = m / LP, t = m - b * LP; if (t < NMETA) continue; dst = a.out + O_YP + ((size_t)b * SEQ + (t - NMETA)) * DM; }
        else dst = a.out + O_YS + (size_t)(m - MP_ROWS) * DM;
        const float* hr = H + (size_t)m * DM;
        f32x4 v[8]; float s = 0.f;
#pragma unroll
        for (int j = 0; j < 8; ++j) { v[j] = ((const f32x4*)hr)[lane + 64 * j]; if (m >= 8192) v[j] += slab_sum(SLAB, m, j, lane) * 0.5f; s += (v[j].x * v[j].x + v[j].y * v[j].y) + (v[j].z * v[j].z + v[j].w * v[j].w); }
        const float r = 1.0f / sqrtf(wave_sum(s) * (1.0f / DM) + EPS);
#pragma unroll
        for (int j = 0; j < 8; ++j) { const f32x4 gg = ((const f32x4*)a.norm_final)[lane + 64 * j]; ((f32x4*)dst)[lane + 64 * j] = v[j] * r * gg; }
    }
}

extern "C" void kernel_launch(void* const* d_in, const int* in_sizes, int n_in, void* d_out, int out_size, void* d_ws, size_t ws_size, hipStream_t stream) {
    static int grid = 0;
    if (grid == 0) {
        if (n_in != 21 || (size_t)out_size != O_END || ws_size < WS_END) { fprintf(stderr, "kernel_launch: unexpected shapes: n_in %d out %d ws %zu (need %zu)\n", n_in, out_size, ws_size, (size_t)WS_END); grid = -1; return; }
        int dev = 0, cus = 0, per_cu = 0;
        hipGetDevice(&dev); hipDeviceGetAttribute(&cus, hipDeviceAttributeMultiprocessorCount, dev);
        if (hipFuncSetAttribute((const void*)fwd_megakernel, hipFuncAttributeMaxDynamicSharedMemorySize, LDS_BYTES) != hipSuccess) { fprintf(stderr, "kernel_launch: hipFuncSetAttribute failed\n"); grid = -1; return; }
        if (hipOccupancyMaxActiveBlocksPerMultiprocessor(&per_cu, (const void*)fwd_megakernel, NWAVES * 64, LDS_BYTES) != hipSuccess || per_cu < 1) { fprintf(stderr, "kernel_launch: occupancy query failed (%d)\n", per_cu); (void)hipGetLastError(); per_cu = 1; }
        grid = cus * 1;
        fprintf(stderr, "kernel_launch: grid %d (cus %d, per_cu %d)\n", grid, cus, per_cu);
    }
    if (grid < 0) return;
    Args a{};
    a.x_prompt = (const float*)d_in[0]; a.x_sample = (const float*)d_in[1]; a.state_conv = (const float*)d_in[2]; a.state_pool = (const float*)d_in[3]; a.meta = (const float*)d_in[4];
    a.norm_ffn1 = (const float*)d_in[5]; a.w1g = (const float*)d_in[6]; a.w1u = (const float*)d_in[7]; a.w1d = (const float*)d_in[8]; a.norm_mix = (const float*)d_in[9]; a.w_in = (const float*)d_in[10];
    a.conv_w = (const float*)d_in[11]; a.w_conv_out = (const float*)d_in[12]; a.w_pool = (const float*)d_in[13]; a.pool_scale = (const float*)d_in[14]; a.w_o = (const float*)d_in[15];
    a.norm_ffn2 = (const float*)d_in[16]; a.w2g = (const float*)d_in[17]; a.w2u = (const float*)d_in[18]; a.w2d = (const float*)d_in[19]; a.norm_final = (const float*)d_in[20];
    a.out = (float*)d_out; a.ws = (unsigned char*)d_ws;
    void* args[] = {&a};
    hipError_t e = hipLaunchCooperativeKernel((const void*)fwd_megakernel, dim3(grid), dim3(NWAVES * 64), args, LDS_BYTES, stream);
    if (e != hipSuccess) fprintf(stderr, "kernel_launch: cooperative launch failed: %s (grid %d)\n", hipGetErrorString(e), grid);
}
```

```cpp
#include <hip/hip_runtime.h>
#include <hip/hip_cooperative_groups.h>
#include <cstdio>
#include <cstdint>
namespace cg = cooperative_groups;

namespace pg8 {
#define PG8_LAS __attribute__((address_space(3)))
typedef unsigned short bf16_t;
typedef short bf16x8 __attribute__((ext_vector_type(8)));
typedef float f32x4 __attribute__((ext_vector_type(4)));
typedef unsigned u32x4 __attribute__((ext_vector_type(4)));
constexpr int BM = 256, BK = 64, HALF = 128, HTB = HALF * BK * 2  , STAGE_BYTES = 8 * HTB, NXCD = 8, WGM = 8;

__host__ __device__ __forceinline__ int lds_byte(int r, int c) { const int st = (r >> 4) * 2 + (c >> 5), rr = r & 15, cc = c & 31, ob = rr * 64 + cc * 2; return st * 1024 + (ob ^ (((ob >> 9) & 1) << 5)); }
__host__ __device__ __forceinline__ void stage_rc(int b, int& R, int& C) { const int st = b / 1024, sb = b % 1024, swz = sb ^ (((sb >> 9) & 1) << 5); R = (st >> 1) * 16 + swz / 64; C = (st & 1) * 32 + (swz % 64) / 2; }
__host__ __device__ __forceinline__ int perm32(int rho) { const int n = rho >> 4, i = rho & 15; return 8 * (i >> 2) + 4 * n + (i & 3); }

struct Unit { int pm, pn, kt0, nkt, slab; };
struct Gemm { const bf16_t* A; const bf16_t* Bt; int M, N, K, lda, ldb, agrp; };
__device__ __forceinline__ size_t acolb(const Gemm& g, const Unit& u) { return g.agrp ? (size_t)((u.pn >> 1) * 256) * 2 : (size_t)0; }

struct StaticOrder {
    int nM, nN, nwg, G, c, nt;
    __host__ __device__ void init(int M, int N, int K, int G_, int c_) { nM = M / BM; nN = N / BM; nwg = nM * nN; G = G_; c = c_; nt = K / BK; }
    __host__ __device__ bool next(int i, Unit& u) const {
        const long L = (long)i * G + c; if (L >= nwg) return false;
        int wgid = (int)L; { const int q = nwg / NXCD, r = nwg % NXCD, xcd = wgid % NXCD, off = wgid / NXCD; wgid = (xcd < r ? xcd * (q + 1) : r * (q + 1) + (xcd - r) * q) + off; }
        const int nig = WGM * nN, gid = wgid / nig, fm = gid * WGM, gsz = (nM - fm) < WGM ? (nM - fm) : WGM;
        u.pm = fm + ((wgid % nig) % gsz); u.pn = (wgid % nig) / gsz; u.kt0 = 0; u.nkt = nt; u.slab = -1; return true;
    }
    __device__ __forceinline__ void a_ready(const Unit&) const {}
    __device__ __forceinline__ void done(const Unit&) const {}
};
struct TailOrder {
    int c, nt;
    __host__ __device__ void init(int K, int c_) { c = c_; nt = K / BK; }
    __host__ __device__ bool next(int i, Unit& u) const {
        if (i == 0) { const int x = c & 7, idx = c >> 3; u.pm = 4 * x + (idx >> 3); u.pn = idx & 7; u.kt0 = 0; u.nkt = nt; u.slab = -1; return true; }
        if (i == 1 && c < 240) { const int j = c / 6, ch = c - 6 * j, np = nt >> 1, base = np / 6, rem = np % 6, p0 = ch * base + (ch < rem ? ch : rem), pc = base + (ch < rem ? 1 : 0);
            u.pm = 32 + (j >> 3); u.pn = j & 7; u.kt0 = 2 * p0; u.nkt = 2 * pc; u.slab = c; return true; }
        return false;
    }
    __device__ __forceinline__ void a_ready(const Unit&) const {}
    __device__ __forceinline__ void done(const Unit&) const {}
};

__device__ __forceinline__ unsigned cvt_pk_bf16(float lo, float hi) { unsigned r; asm volatile("v_cvt_pk_bf16_f32 %0, %1, %2" : "=v"(r) : "v"(lo), "v"(hi)); return r; }
__device__ __forceinline__ float bf_lo(unsigned w) { return __uint_as_float(w << 16); }
__device__ __forceinline__ float bf_hi(unsigned w) { return __uint_as_float(w & 0xffff0000u); }
__device__ __forceinline__ float sigmoidf_(float x) { return __builtin_amdgcn_rcpf(1.0f + __builtin_amdgcn_exp2f(-1.4426950408889634f * x)); }
__device__ __forceinline__ u32x4 pack8(const f32x4& a, const f32x4& b) { u32x4 w; w.x = cvt_pk_bf16(a[0], a[1]); w.y = cvt_pk_bf16(a[2], a[3]); w.z = cvt_pk_bf16(b[0], b[1]); w.w = cvt_pk_bf16(b[2], b[3]); return w; }
__device__ __forceinline__ void unpack8(const u32x4& w, f32x4& a, f32x4& b) { a = (f32x4){bf_lo(w.x), bf_hi(w.x), bf_lo(w.y), bf_hi(w.y)}; b = (f32x4){bf_lo(w.z), bf_hi(w.z), bf_lo(w.w), bf_hi(w.w)}; }

struct EpiSwiglu {
    static constexpr bool PERM = true, AFTER_DRAIN = false;
    bf16_t* O; int ldc;
    __device__ __forceinline__ void operator()(const f32x4 (&acc)[2][2][4][2], const Unit& u, int wr, int wc, int fr, int fq) const {
        const int row0 = u.pm * BM + wr * 64 + fr, col0 = u.pn * HALF + wc * 32 + 8 * fq;
#pragma unroll
        for (int ai = 0; ai < 2; ++ai)
#pragma unroll
            for (int m = 0; m < 4; ++m) {
                f32x4 v[2];
#pragma unroll
                for (int n = 0; n < 2; ++n) { const f32x4 gt = acc[ai][0][m][n], up = acc[ai][1][m][n];
#pragma unroll
                    for (int e = 0; e < 4; ++e) v[n][e] = gt[e] * sigmoidf_(gt[e]) * up[e]; }
                *(u32x4*)(O + (size_t)(row0 + ai * HALF + m * 16) * ldc + col0) = pack8(v[0], v[1]);
            }
    }
};
template <bool FROMX> struct EpiResid {
    static constexpr bool PERM = true, AFTER_DRAIN = false;
    float* H; int ldc; float s; float* SL;
    const float *xp, *xs, *meta;
    __device__ __forceinline__ void operator()(const f32x4 (&acc)[2][2][4][2], const Unit& u, int wr, int wc, int fr, int fq) const {
        if (u.slab >= 0) {
            bf16_t* base = (bf16_t*)SL + (size_t)u.slab * (BM * BM) + (size_t)(wr * 64 + fr) * BM + wc * 32 + 8 * fq;
#pragma unroll
            for (int ai = 0; ai < 2; ++ai)
#pragma unroll
                for (int m = 0; m < 4; ++m)
#pragma unroll
                    for (int bj = 0; bj < 2; ++bj) *(u32x4*)(base + (size_t)(ai * HALF + m * 16) * BM + bj * HALF) = pack8(acc[ai][bj][m][0], acc[ai][bj][m][1]);
            return;
        }
        const int row0 = u.pm * BM + wr * 64 + fr, col0 = u.pn * BM + wc * 32 + 8 * fq;
#pragma unroll
        for (int ai = 0; ai < 2; ++ai)
#pragma unroll
            for (int m = 0; m < 4; ++m) { const int r = row0 + ai * HALF + m * 16; float* rowp = H + (size_t)r * ldc + col0;
                const float* srcp = rowp;
                if (FROMX) {
                    const int b = r / 2064, t = r - b * 2064;
                    srcp = (t < 16 ? meta + (size_t)t * 2048 : xp + ((size_t)b * 2048 + (t - 16)) * 2048) + col0;
                }
#pragma unroll
                for (int bj = 0; bj < 2; ++bj)
#pragma unroll
                    for (int n = 0; n < 2; ++n) { const f32x4 h = *(const f32x4*)(srcp + bj * HALF + n * 4); *(f32x4*)(rowp + bj * HALF + n * 4) = h + acc[ai][bj][m][n] * s; }
                if (m & 1) asm volatile("" ::: "memory"); }
    }
};
struct EpiProj {
    static constexpr bool PERM = true, AFTER_DRAIN = false;
    bf16_t *BG, *CV, *Z, *SGC, *SGP;
    __device__ __forceinline__ void operator()(const f32x4 (&acc)[2][2][4][2], const Unit& u, int wr, int wc, int fr, int fq) const {
        const int row0 = u.pm * BM + wr * 64 + fr, pn = u.pn;
        if (pn >= 8 && pn < 24) {
            const int col0 = (pn - 8) * HALF + wc * 32 + 8 * fq;
#pragma unroll
            for (int ai = 0; ai < 2; ++ai)
#pragma unroll
                for (int m = 0; m < 4; ++m)
                    *(u32x4*)(CV + (size_t)(row0 + ai * HALF + m * 16) * 2048 + col0) = pack8(acc[ai][0][m][0] * acc[ai][1][m][0], acc[ai][0][m][1] * acc[ai][1][m][1]);
        } else {
            bf16_t* base; int ld, ct; bool sg;
            if (pn < 8) { base = BG; ld = 2048; ct = pn; sg = false; }
            else if (pn < 28) { base = Z; ld = 1024; ct = pn - 24; sg = false; }
            else if (pn < 36) { base = SGC; ld = 2048; ct = pn - 28; sg = true; }
            else { base = SGP; ld = 2048; ct = pn - 36; sg = true; }
            const int col0 = ct * BM + wc * 32 + 8 * fq;
#pragma unroll
            for (int ai = 0; ai < 2; ++ai)
#pragma unroll
                for (int m = 0; m < 4; ++m) { bf16_t* rowp = base + (size_t)(row0 + ai * HALF + m * 16) * ld + col0;
#pragma unroll
                    for (int bj = 0; bj < 2; ++bj) { f32x4 v0 = acc[ai][bj][m][0], v1 = acc[ai][bj][m][1];
                        if (sg) {
#pragma unroll
                            for (int e = 0; e < 4; ++e) { v0[e] = sigmoidf_(v0[e]); v1[e] = sigmoidf_(v1[e]); } }
                        *(u32x4*)(rowp + bj * HALF) = pack8(v0, v1); } }
        }
    }
};
struct EpiPool {
    static constexpr bool PERM = true, AFTER_DRAIN = false;
    bf16_t* SGP; const float* ps;
    __device__ __forceinline__ void operator()(const f32x4 (&acc)[2][2][4][2], const Unit& u, int wr, int wc, int fr, int fq) const {
        const int row0 = u.pm * BM + wr * 64 + fr, col0 = u.pn * BM + wc * 32 + 8 * fq;
#pragma unroll
        for (int ai = 0; ai < 2; ++ai)
#pragma unroll
            for (int m = 0; m < 4; ++m) { bf16_t* rowp = SGP + (size_t)(row0 + ai * HALF + m * 16) * 2048 + col0;
#pragma unroll
                for (int bj = 0; bj < 2; ++bj) { u32x4* p = (u32x4*)(rowp + bj * HALF); f32x4 g0, g1; unpack8(*p, g0, g1);
                    const f32x4 s0 = *(const f32x4*)(ps + col0 + bj * HALF), s1 = *(const f32x4*)(ps + col0 + bj * HALF + 4);
                    *p = pack8(g0 * s0 * acc[ai][bj][m][0], g1 * s1 * acc[ai][bj][m][1]); }
                asm volatile("" ::: "memory"); }
    }
};
struct EpiMerge {
    static constexpr bool PERM = true, AFTER_DRAIN = false;
    bf16_t* SGC; const bf16_t* MP;
    __device__ __forceinline__ void operator()(const f32x4 (&acc)[2][2][4][2], const Unit& u, int wr, int wc, int fr, int fq) const {
        const int row0 = u.pm * BM + wr * 64 + fr, col0 = u.pn * BM + wc * 32 + 8 * fq;
#pragma unroll
        for (int ai = 0; ai < 2; ++ai)
#pragma unroll
            for (int m = 0; m < 4; ++m) { const size_t off = (size_t)(row0 + ai * HALF + m * 16) * 2048 + col0;
#pragma unroll
                for (int bj = 0; bj < 2; ++bj) { u32x4* p = (u32x4*)(SGC + off + bj * HALF); f32x4 g0, g1, q0, q1; unpack8(*p, g0, g1); unpack8(*(const u32x4*)(MP + off + bj * HALF), q0, q1);
                    *p = pack8(g0 * acc[ai][bj][m][0] + q0, g1 * acc[ai][bj][m][1] + q1); }
                if (m & 1) asm volatile("" ::: "memory"); }
    }
};

template <class Epi, class Sched, bool ALIGN_EPI = false, bool SP2 = false>
__device__ __forceinline__ void gemm_phase(PG8_LAS unsigned char* lds, const Gemm g, const Sched& S, const Epi& E) {
    int tid_ = threadIdx.x; asm volatile("" : "+v"(tid_));
    const int tid = tid_, wid = __builtin_amdgcn_readfirstlane(tid >> 6), lane = tid & 63, wr = wid >> 2, wc = wid & 3, fr = lane & 15, fq = lane >> 4;

    unsigned voffA[2], voffB[2];
#pragma unroll
    for (int i = 0; i < 2; ++i) { int R, C; stage_rc(tid * 16 + i * 8192, R, C); const int Rb = Epi::PERM ? ((R & ~31) + perm32(R & 31)) : R;
        voffA[i] = (unsigned)(R * g.lda + C) * 2u; voffB[i] = (unsigned)(Rb * g.ldb + C) * 2u; }
    const size_t kstep = (size_t)(BK * 2);
    const size_t hstepA = (size_t)HALF * g.lda * 2, hstepB = (size_t)HALF * g.ldb * 2;
    const size_t tstepA = 2 * hstepA, tstepB = 2 * hstepB;
    const unsigned ldsw = (unsigned)wid * 1024u;
    const int aoff = lds_byte(wr * 64 + fr, fq * 8), boff = lds_byte(wc * 32 + fr, fq * 8);
#define PG8_SA(b, h) (((b) * 2 + (h)) * HTB)
#define PG8_SB(b, h) ((4 + (b) * 2 + (h)) * HTB)
#define PG8_STAGE(bufoff, gbase, voff) do { _Pragma("unroll") for (int _i = 0; _i < 2; ++_i) \
        __builtin_amdgcn_global_load_lds((const unsigned*)((const char*)(gbase) + (voff)[_i]), (PG8_LAS unsigned*)(lds + (bufoff) + ldsw + _i * 8192), 16, 0, 0); } while (0)
#define PG8_LDA(dst, b, h) do { _Pragma("unroll") for (int m = 0; m < 4; ++m) _Pragma("unroll") for (int k = 0; k < 2; ++k) dst[m][k] = *(const PG8_LAS bf16x8*)(lds + PG8_SA(b, h) + aoff + m * 2048 + k * 1024); } while (0)
#define PG8_LDB(dst, b, h) do { _Pragma("unroll") for (int n = 0; n < 2; ++n) _Pragma("unroll") for (int k = 0; k < 2; ++k) dst[n][k] = *(const PG8_LAS bf16x8*)(lds + PG8_SB(b, h) + boff + n * 2048 + k * 1024); } while (0)
#define PG8_MMA(ai, bj, At, Bt) do { __builtin_amdgcn_s_setprio(1); _Pragma("unroll") for (int m = 0; m < 4; ++m) _Pragma("unroll") for (int n = 0; n < 2; ++n) _Pragma("unroll") for (int k = 0; k < 2; ++k) \
        acc[ai][bj][m][n] = __builtin_amdgcn_mfma_f32_16x16x32_bf16(Bt[n][k], At[m][k], acc[ai][bj][m][n], 0, 0, 0); __builtin_amdgcn_s_setprio(0); } while (0)
#define PG8_WAIT_V(n) asm volatile("s_waitcnt vmcnt(" #n ")" ::: "memory")
#define PG8_WAIT_L(n) asm volatile("s_waitcnt lgkmcnt(" #n ")" ::: "memory")
#define PG8_BAR __builtin_amdgcn_s_barrier()
#define PG8_SCHED __builtin_amdgcn_sched_barrier(0)
    Unit cur, nxt; int ui = 0;
    if (!S.next(0, cur)) return;
    f32x4 acc[2][2][4][2];
#pragma unroll
    for (int a = 0; a < 2; ++a)
#pragma unroll
        for (int b = 0; b < 2; ++b)
#pragma unroll
            for (int m = 0; m < 4; ++m)
#pragma unroll
                for (int n = 0; n < 2; ++n) acc[a][b][m][n] = (f32x4){0.f, 0.f, 0.f, 0.f};
    bf16x8 At[4][2], B0[2][2], B1[2][2];
    const char* cA = (const char*)g.A + (size_t)cur.pm * tstepA + acolb(g, cur) + (size_t)cur.kt0 * kstep; const char* cB = (const char*)g.Bt + (size_t)cur.pn * tstepB + (size_t)cur.kt0 * kstep;
    S.a_ready(cur);
    if constexpr (SP2) {
        PG8_STAGE(PG8_SB(0, 0), cB, voffB); PG8_STAGE(PG8_SB(0, 1), cB + hstepB, voffB); PG8_STAGE(PG8_SA(0, 0), cA, voffA); PG8_STAGE(PG8_SA(0, 1), cA + hstepA, voffA);
        if (wr == 1) PG8_BAR;
        PG8_WAIT_V(2); PG8_BAR;
        PG8_STAGE(PG8_SB(1, 0), cB + kstep, voffB); PG8_STAGE(PG8_SA(1, 0), cA + kstep, voffA); PG8_STAGE(PG8_SB(1, 1), cB + hstepB + kstep, voffB);
        PG8_WAIT_V(6); PG8_BAR;
    } else {
        PG8_STAGE(PG8_SB(0, 0), cB, voffB); PG8_STAGE(PG8_SA(0, 0), cA, voffA); PG8_STAGE(PG8_SB(0, 1), cB + hstepB, voffB); PG8_STAGE(PG8_SA(0, 1), cA + hstepA, voffA);
        if (wr == 1) PG8_BAR;
        PG8_WAIT_V(4); PG8_BAR;
        PG8_STAGE(PG8_SB(1, 0), cB + kstep, voffB); PG8_STAGE(PG8_SA(1, 0), cA + kstep, voffA); PG8_STAGE(PG8_SB(1, 1), cB + hstepB + kstep, voffB);
        PG8_WAIT_V(6); PG8_BAR;
    }
    for (;;) {
        const bool has_next = S.next(ui + 1, nxt);
        const char* nA = has_next ? (const char*)g.A + (size_t)nxt.pm * tstepA + acolb(g, nxt) + (size_t)nxt.kt0 * kstep : cA; const char* nB = has_next ? (const char*)g.Bt + (size_t)nxt.pn * tstepB + (size_t)nxt.kt0 * kstep : cB;
        const int nt = cur.nkt;
        for (int t = 0; t < nt; t += 2) {
            const bool last = (t == nt - 2);
            const char* a1 = cA + (size_t)(t + 1) * kstep;
            const char* a2 = last ? nA : cA + (size_t)(t + 2) * kstep; const char* b2 = last ? nB : cB + (size_t)(t + 2) * kstep;
            const char* a3 = a2 + kstep; const char* b3 = b2 + kstep;
            if (last && has_next) S.a_ready(nxt);
            if constexpr (SP2) {
            PG8_LDB(B0, 0, 0); PG8_LDB(B1, 0, 1); PG8_SCHED; PG8_LDA(At, 0, 0); PG8_STAGE(PG8_SA(1, 1), a1 + hstepA, voffA);
            PG8_WAIT_V(8); PG8_WAIT_L(0); PG8_BAR; PG8_MMA(0, 0, At, B0); PG8_MMA(0, 1, At, B1); PG8_BAR; PG8_SCHED;
            PG8_LDA(At, 0, 1); PG8_STAGE(PG8_SB(0, 0), b2, voffB); PG8_STAGE(PG8_SB(0, 1), b2 + hstepB, voffB); PG8_STAGE(PG8_SA(0, 0), a2, voffA);
            PG8_WAIT_V(8); PG8_WAIT_L(0); PG8_BAR; PG8_MMA(1, 0, At, B0); PG8_MMA(1, 1, At, B1); PG8_BAR; PG8_SCHED;
            PG8_LDB(B0, 1, 0); PG8_LDB(B1, 1, 1); PG8_SCHED; PG8_LDA(At, 1, 0); PG8_STAGE(PG8_SA(0, 1), a2 + hstepA, voffA);
            PG8_WAIT_V(8); PG8_WAIT_L(0); PG8_BAR; PG8_MMA(0, 0, At, B0); PG8_MMA(0, 1, At, B1); PG8_BAR; PG8_SCHED;
            PG8_LDA(At, 1, 1); PG8_STAGE(PG8_SB(1, 0), b3, voffB); PG8_STAGE(PG8_SB(1, 1), b3 + hstepB, voffB); PG8_STAGE(PG8_SA(1, 0), a3, voffA);
            PG8_WAIT_V(8); PG8_WAIT_L(0); PG8_BAR; PG8_MMA(1, 0, At, B0); PG8_MMA(1, 1, At, B1); PG8_BAR; PG8_SCHED;
            } else {
            PG8_LDB(B0, 0, 0); PG8_SCHED; PG8_LDA(At, 0, 0); PG8_STAGE(PG8_SA(1, 1), a1 + hstepA, voffA);
            PG8_WAIT_L(8); PG8_BAR; PG8_WAIT_L(0); PG8_MMA(0, 0, At, B0); PG8_BAR; PG8_SCHED;
            PG8_LDB(B1, 0, 1); PG8_STAGE(PG8_SB(0, 0), b2, voffB);
            PG8_BAR; PG8_WAIT_L(0); PG8_MMA(0, 1, At, B1); PG8_BAR;
            PG8_LDA(At, 0, 1); PG8_STAGE(PG8_SA(0, 0), a2, voffA);
            PG8_BAR; PG8_WAIT_L(0); PG8_MMA(1, 0, At, B0); PG8_BAR; PG8_SCHED;
            PG8_STAGE(PG8_SB(0, 1), b2 + hstepB, voffB);
            PG8_WAIT_V(6); PG8_BAR; PG8_MMA(1, 1, At, B1); PG8_BAR;
            PG8_LDB(B0, 1, 0); PG8_SCHED; PG8_LDA(At, 1, 0); PG8_STAGE(PG8_SA(0, 1), a2 + hstepA, voffA);
            PG8_WAIT_L(8); PG8_BAR; PG8_WAIT_L(0); PG8_MMA(0, 0, At, B0); PG8_BAR; PG8_SCHED;
            PG8_LDB(B1, 1, 1); PG8_STAGE(PG8_SB(1, 0), b3, voffB);
            PG8_BAR; PG8_WAIT_L(0); PG8_MMA(0, 1, At, B1); PG8_BAR;
            PG8_LDA(At, 1, 1); PG8_STAGE(PG8_SA(1, 0), a3, voffA);
            PG8_BAR; PG8_WAIT_L(0); PG8_MMA(1, 0, At, B0); PG8_BAR; PG8_SCHED;
            PG8_STAGE(PG8_SB(1, 1), b3 + hstepB, voffB);
            PG8_WAIT_V(6); PG8_BAR; PG8_MMA(1, 1, At, B1); PG8_BAR;
            }
        }
        if constexpr (ALIGN_EPI) { if (wr == 0) PG8_BAR; }
        if constexpr (!Epi::AFTER_DRAIN) { E(acc, cur, wr, wc, fr, fq); S.done(cur); }
        if (!has_next) break;
#pragma unroll
        for (int a = 0; a < 2; ++a)
#pragma unroll
            for (int b = 0; b < 2; ++b)
#pragma unroll
                for (int m = 0; m < 4; ++m)
#pragma unroll
                    for (int n = 0; n < 2; ++n) acc[a][b][m][n] = (f32x4){0.f, 0.f, 0.f, 0.f};
        cur = nxt; cA = nA; cB = nB; ++ui;
        if constexpr (ALIGN_EPI) { if (wr == 1) PG8_BAR; }
    }
    PG8_WAIT_V(0);
    if constexpr (!ALIGN_EPI) { if (wr == 0) PG8_BAR; }
    PG8_BAR;
    if constexpr (Epi::AFTER_DRAIN) { E.fused(acc, cur, wr, wc, fr, fq, lds, wid, lane); S.done(cur); }
#undef PG8_SA
#undef PG8_SB
#undef PG8_STAGE
#undef PG8_LDA
#undef PG8_LDB
#undef PG8_MMA
#undef PG8_WAIT_V
#undef PG8_WAIT_L
#undef PG8_BAR
#undef PG8_SCHED
}
}

constexpr int DM = 2048, NB = 4, SEQ = 2048, NMETA = 16, LP = SEQ + NMETA  , DECB = 128, DECS = 8;
constexpr int DFF = 5632, DPOOL = 1024, DIN = 11264;
constexpr int MP_ROWS = NB * LP;
constexpr int MS_ROWS = DECB * DECS;
constexpr int MREAL = MP_ROWS + MS_ROWS;
constexpr int MPAD = 9472;
constexpr float EPS = 1e-6f;
constexpr int NWAVES = 8;

constexpr size_t O_YP = 0, O_YS = O_YP + (size_t)NB * SEQ * DM, O_NCP = O_YS + (size_t)MS_ROWS * DM, O_NPP = O_NCP + (size_t)NB * 2 * DM,
                 O_NCS = O_NPP + (size_t)NB * 15 * DPOOL, O_NPS = O_NCS + (size_t)DECB * 2 * DM, O_END = O_NPS + (size_t)DECB * 15 * DPOOL;

constexpr size_t MiB = 1u << 20;
constexpr size_t WS_W1GU = 1 * MiB;
constexpr size_t WS_W1D = WS_W1GU + 44 * MiB;
constexpr size_t WS_WIN = WS_W1D + 22 * MiB;
constexpr size_t WS_WCO = WS_WIN + 44 * MiB;
constexpr size_t WS_WPG = WS_WCO + 8 * MiB;
constexpr size_t WS_WO = WS_WPG + 1 * MiB;
constexpr size_t WS_W2GU = WS_WO + 8 * MiB;
constexpr size_t WS_W2D = WS_W2GU + 44 * MiB;
constexpr size_t WS_H = WS_W2D + 22 * MiB;
constexpr size_t WS_R = WS_H + 74 * MiB;
constexpr size_t WS_BG = WS_R, WS_CV = WS_R + 37 * MiB, WS_SGC = WS_R + 74 * MiB, WS_SGP = WS_R + 111 * MiB, WS_Z = WS_R + 148 * MiB, WS_PL = WS_Z + 19 * MiB;
constexpr size_t WS_XN1 = WS_SGP;
constexpr size_t WS_END = WS_PL + 19 * MiB;
static_assert((size_t)MPAD * DFF * 2 <= 111 * MiB, "ACT fits below XN1");

#define GAS __attribute__((address_space(1)))
#define LAS __attribute__((address_space(3)))
typedef unsigned short bf16;
typedef unsigned v4u __attribute__((ext_vector_type(4)));
typedef float f32x4 __attribute__((ext_vector_type(4)));
#define LDS_WAIT() asm volatile("s_waitcnt lgkmcnt(0)" ::: "memory")
constexpr int LDS_BYTES = 147456;

struct Args {
    const float *x_prompt, *x_sample, *state_conv, *state_pool, *meta, *norm_ffn1, *w1g, *w1u, *w1d, *norm_mix, *w_in, *conv_w, *w_conv_out, *w_pool, *pool_scale, *w_o, *norm_ffn2, *w2g, *w2u, *w2d, *norm_final;
    float* out; unsigned char* ws;
};

__device__ __forceinline__ unsigned pk2(float lo, float hi) { return pg8::cvt_pk_bf16(lo, hi); }
__device__ __forceinline__ float wave_sum(float v) {
#pragma unroll
    for (int o = 1; o < 64; o <<= 1) v += __shfl_xor(v, o);
    return v;
}
__device__ __forceinline__ const float* src_row(const Args& a, int r) {
    if (r < MP_ROWS) { const int b = r / LP, t = r - b * LP; return t < NMETA ? a.meta + (size_t)t * DM : a.x_prompt + ((size_t)b * SEQ + (t - NMETA)) * DM; }
    if (r < MREAL) return a.x_sample + (size_t)(r - MP_ROWS) * DM;
    return nullptr;
}
__device__ __forceinline__ void p0_transpose_item(const float* W, int N, bf16* WT, int K, int k0, int n0, int drow0, LAS float* scr, int lane) {
    const int lr = lane >> 4, lc = (lane & 15) * 4;
    f32x4 v[16];
#pragma unroll
    for (int i = 0; i < 16; ++i) v[i] = *(const f32x4*)(W + (size_t)(k0 + 4 * i + lr) * N + n0 + lc);
#pragma unroll
    for (int i = 0; i < 16; ++i) { LAS float* s = scr + (4 * i + lr) * 65 + lc; s[0] = v[i].x; s[1] = v[i].y; s[2] = v[i].z; s[3] = v[i].w; }
    LDS_WAIT(); asm volatile("" ::: "memory");
    const int c = lane & 7;
#pragma unroll
    for (int j = 0; j < 8; ++j) { const int n = (lane >> 3) + 8 * j; const LAS float* s = scr + (8 * c) * 65 + n;
        v4u o; o.x = pk2(s[0 * 65], s[1 * 65]); o.y = pk2(s[2 * 65], s[3 * 65]); o.z = pk2(s[4 * 65], s[5 * 65]); o.w = pk2(s[6 * 65], s[7 * 65]);
        *(v4u*)(WT + (size_t)(drow0 + n) * K + k0 + 8 * c) = o; }
    LDS_WAIT(); asm volatile("" ::: "memory");
}
__device__ __forceinline__ bool p0_job(int& r, const float* W, int K, int N, bf16* WT, int kind, int roff, LAS float* scr, int lane) {
    const int nb = N / 64, items = (K / 64) * nb;
    if (r >= items) { r -= items; return false; }
    const int kb = r / nb, n0 = (r % nb) * 64;
    int d;
    if (kind == 0) d = roff + n0;
    else if (kind == 1) d = (n0 >> 7) * 256 + (n0 & 127);
    else if (kind == 2) d = (n0 >> 7) * 256 + 128 + (n0 & 127);
    else { if (n0 < 2048 || n0 >= 6144) d = n0; else if (n0 < 4096) { const int j = n0 - 2048; d = 2048 + (j >> 7) * 256 + (j & 127); } else { const int j = n0 - 4096; d = 2048 + (j >> 7) * 256 + 128 + (j & 127); } }
    p0_transpose_item(W, N, WT, K, kb * 64, n0, d, scr, lane);
    return true;
}
__device__ __forceinline__ f32x4 slab_sum(const float* SL, int m, int j, int lane) {
    typedef unsigned u32x2 __attribute__((ext_vector_type(2)));
    const bf16* p = (const bf16*)SL + (size_t)(((m >> 8) - 32) * 8 + j) * 6 * 65536 + (size_t)(m & 255) * 256 + 4 * lane;
    f32x4 a = (f32x4){0.f, 0.f, 0.f, 0.f};
#pragma unroll
    for (int ch = 0; ch < 6; ++ch) { const u32x2 w = *(const u32x2*)(p + (size_t)ch * 65536); a += (f32x4){pg8::bf_lo(w.x), pg8::bf_hi(w.x), pg8::bf_lo(w.y), pg8::bf_hi(w.y)}; }
    return a;
}
__device__ __forceinline__ void rms_row_bf16(const float* xrow, const float* g, bf16* orow, float* hout, int lane, const float* SL = nullptr, float sc = 0.f, int m = 0) {
    f32x4 v[8]; float s = 0.f;
    const bool red = SL && m >= 8192;
#pragma unroll
    for (int j = 0; j < 8; ++j) {
        v[j] = xrow ? ((const f32x4*)xrow)[lane + 64 * j] : (f32x4){0.f, 0.f, 0.f, 0.f};
        if (red) v[j] += slab_sum(SL, m, j, lane) * sc;
        s += (v[j].x * v[j].x + v[j].y * v[j].y) + (v[j].z * v[j].z + v[j].w * v[j].w);
    }
    const float r = 1.0f / sqrtf(wave_sum(s) * (1.0f / DM) + EPS);
#pragma unroll
    for (int j = 0; j < 8; ++j) {
        if (hout) ((f32x4*)hout)[lane + 64 * j] = v[j];
        const f32x4 gg = ((const f32x4*)g)[lane + 64 * j];
        const unsigned lo = pk2(v[j].x * r * gg.x, v[j].y * r * gg.y), hi = pk2(v[j].z * r * gg.z, v[j].w * r * gg.w);
        ((unsigned long long*)orow)[lane + 64 * j] = (unsigned long long)lo | ((unsigned long long)hi << 32);
    }
}
__device__ __forceinline__ void load8_bf16(const bf16* p, float (&o)[8]) { const v4u w = *(const v4u*)p; o[0] = pg8::bf_lo(w.x); o[1] = pg8::bf_hi(w.x); o[2] = pg8::bf_lo(w.y); o[3] = pg8::bf_hi(w.y); o[4] = pg8::bf_lo(w.z); o[5] = pg8::bf_hi(w.z); o[6] = pg8::bf_lo(w.w); o[7] = pg8::bf_hi(w.w); }
__device__ __forceinline__ void load8_f32(const float* p, float (&o)[8]) { const f32x4 a = ((const f32x4*)p)[0], b = ((const f32x4*)p)[1]; o[0] = a.x; o[1] = a.y; o[2] = a.z; o[3] = a.w; o[4] = b.x; o[5] = b.y; o[6] = b.z; o[7] = b.w; }
__device__ __forceinline__ void store8_f32(float* p, const float (&o)[8]) { ((f32x4*)p)[0] = (f32x4){o[0], o[1], o[2], o[3]}; ((f32x4*)p)[1] = (f32x4){o[4], o[5], o[6], o[7]}; }


__device__ __forceinline__ void acc8_bf16(const v4u& w, float msk, float (&s)[8]) {
    s[0] += msk * pg8::bf_lo(w.x); s[1] += msk * pg8::bf_hi(w.x); s[2] += msk * pg8::bf_lo(w.y); s[3] += msk * pg8::bf_hi(w.y);
    s[4] += msk * pg8::bf_lo(w.z); s[5] += msk * pg8::bf_hi(w.z); s[6] += msk * pg8::bf_lo(w.w); s[7] += msk * pg8::bf_hi(w.w);
}
template <bool SMP>
__device__ __forceinline__ void p3b_row(const Args& a, int m, int lane, bf16* BG, const bf16* CV, const bf16* Z, bf16* PL) {
    int sq, t;
    if (SMP) { sq = (m - MP_ROWS) >> 3; t = (m - MP_ROWS) & 7; } else { sq = m / LP; t = m - sq * LP; }
    constexpr int L = SMP ? DECS : LP;
    const float* sc = a.state_conv + (size_t)sq * 2 * DM;
    const float* sp = a.state_pool + (size_t)sq * 15 * DPOOL;
    float* ncv = (t >= L - 2) ? a.out + (SMP ? O_NCS : O_NCP) + ((size_t)sq * 2 + (t - (L - 2))) * DM : nullptr;
    const float m1 = t >= 1 ? 1.f : 0.f, m2 = t >= 2 ? 1.f : 0.f;
    const int r1 = t >= 1 ? m - 1 : m, r2 = t >= 2 ? m - 2 : m;
#pragma unroll 2
    for (int j = 0; j < 4; ++j) {
        const int col = 512 * j + 8 * lane;
        float c0[8], c1[8], c2[8], bg[8], w0[8], w1[8], w2[8], o[8];
        load8_bf16(CV + (size_t)m * DM + col, c2); load8_bf16(CV + (size_t)r1 * DM + col, c1); load8_bf16(CV + (size_t)r2 * DM + col, c0);
        load8_bf16(BG + (size_t)m * DM + col, bg);
        load8_f32(a.conv_w + col, w0); load8_f32(a.conv_w + DM + col, w1); load8_f32(a.conv_w + 2 * DM + col, w2);
#pragma unroll
        for (int e = 0; e < 8; ++e) { c1[e] *= m1; c0[e] *= m2; }
        if (SMP) {
            float s1[8], s0[8];
            load8_f32(sc + (size_t)DM + col, s1); load8_f32(sc + (size_t)(t == 1 ? DM : 0) + col, s0);
#pragma unroll
            for (int e = 0; e < 8; ++e) { c1[e] += (1.f - m1) * s1[e]; c0[e] += (1.f - m2) * s0[e]; }
        }
#pragma unroll
        for (int e = 0; e < 8; ++e) o[e] = bg[e] * (w0[e] * c0[e] + w1[e] * c1[e] + w2[e] * c2[e]);
        v4u w; w.x = pk2(o[0], o[1]); w.y = pk2(o[2], o[3]); w.z = pk2(o[4], o[5]); w.w = pk2(o[6], o[7]);
        *(v4u*)(BG + (size_t)m * DM + col) = w;
        if (ncv) store8_f32(ncv + col, c2);
    }
    float* npp = nullptr;
    if (SMP) npp = a.out + O_NPS + ((size_t)sq * 15 + 7 + t) * DPOOL; else if (t >= L - 15) npp = a.out + O_NPP + ((size_t)sq * 15 + (t - (L - 15))) * DPOOL;
#pragma unroll
    for (int j = 0; j < 2; ++j) {
        const int col = 512 * j + 8 * lane, gq = col >> 8, k = 2 << gq;
        float z0[8], s[8];
        load8_bf16(Z + (size_t)m * DPOOL + col, z0);
#pragma unroll
        for (int e = 0; e < 8; ++e) s[e] = z0[e];
        if (j == 0) {
#pragma unroll
            for (int i = 1; i < 4; ++i) { const bool in = t - i >= 0; const v4u w = *(const v4u*)(Z + (size_t)(in ? m - i : m) * DPOOL + col); acc8_bf16(w, (in && i < k) ? 1.f : 0.f, s); }
            if (SMP) {
#pragma unroll
                for (int i = 1; i < 4; ++i) { const bool st = t - i < 0; float q[8]; load8_f32(sp + (size_t)(st ? 15 + t - i : 0) * DPOOL + col, q); const float mk = (st && i < k) ? 1.f : 0.f;
#pragma unroll
                    for (int e = 0; e < 8; ++e) s[e] += mk * q[e]; }
            }
        } else {
#pragma unroll
            for (int i = 1; i < 16; ++i) { const bool in = t - i >= 0; const v4u w = *(const v4u*)(Z + (size_t)(in ? m - i : m) * DPOOL + col); acc8_bf16(w, (in && i < k) ? 1.f : 0.f, s); }
            if (SMP) {
#pragma unroll
                for (int i = 1; i < 16; ++i) { const bool st = t - i < 0; float q[8]; load8_f32(sp + (size_t)(st ? 15 + t - i : 0) * DPOOL + col, q); const float mk = (st && i < k) ? 1.f : 0.f;
#pragma unroll
                    for (int e = 0; e < 8; ++e) s[e] += mk * q[e]; }
            }
        }
        const int cnt = SMP ? k : (k < t + 1 ? k : t + 1);
        const float inv = 1.0f / (float)cnt;
        float o[8];
#pragma unroll
        for (int e = 0; e < 8; ++e) o[e] = s[e] * inv - z0[e];
        v4u w; w.x = pk2(o[0], o[1]); w.y = pk2(o[2], o[3]); w.z = pk2(o[4], o[5]); w.w = pk2(o[6], o[7]);
        *(v4u*)(PL + (size_t)m * DPOOL + col) = w;
        if (npp) store8_f32(npp + col, z0);
        if (SMP && t < 7) { float q[8]; load8_f32(sp + (size_t)(8 + t) * DPOOL + col, q); store8_f32(a.out + O_NPS + ((size_t)sq * 15 + t) * DPOOL + col, q); }
    }
}

constexpr int NI_GU = (DM / 64) * (DFF / 64), NI_D = (DFF / 64) * (DM / 64), NI_IN = (DM / 64) * (DIN / 64), NI_SQ = (DM / 64) * (DM / 64), NI_PG = (256 / 64) * (512 / 64);
constexpr int IT_W1G = 0, IT_W1D = 2 * NI_GU, IT_WCO = IT_W1D + NI_D + NI_IN, IT_W2G = IT_WCO + 2 * NI_SQ + 4 * NI_PG, IT_W2D = IT_W2G + 2 * NI_GU, IT_END = IT_W2D + NI_D;
__device__ __forceinline__ void convert_items(const Args& a, unsigned char* ws, int it_lo, int it_hi, int widx, int nw, LAS unsigned char* lds, int wave, int lane) {
    LAS float* scr = (LAS float*)(lds + wave * 16640);
    bf16 *W1GU = (bf16*)(ws + WS_W1GU), *W1D = (bf16*)(ws + WS_W1D), *WIN = (bf16*)(ws + WS_WIN), *WCO = (bf16*)(ws + WS_WCO), *WPG = (bf16*)(ws + WS_WPG), *WO = (bf16*)(ws + WS_WO),
         *W2GU = (bf16*)(ws + WS_W2GU), *W2D = (bf16*)(ws + WS_W2D);
    for (int it = it_lo + widx; it < it_hi; it += nw) {
        int r = it;
        if (p0_job(r, a.w1g, DM, DFF, W1GU, 1, 0, scr, lane)) continue;
        if (p0_job(r, a.w1u, DM, DFF, W1GU, 2, 0, scr, lane)) continue;
        if (p0_job(r, a.w1d, DFF, DM, W1D, 0, 0, scr, lane)) continue;
        if (p0_job(r, a.w_in, DM, DIN, WIN, 3, 0, scr, lane)) continue;
        if (p0_job(r, a.w_conv_out, DM, DM, WCO, 0, 0, scr, lane)) continue;
        if (p0_job(r, a.w_o, DM, DM, WO, 0, 0, scr, lane)) continue;
        if (p0_job(r, a.w_pool + 0 * 256 * 512, 256, 512, WPG, 0, 0, scr, lane)) continue;
        if (p0_job(r, a.w_pool + 1 * 256 * 512, 256, 512, WPG, 0, 512, scr, lane)) continue;
        if (p0_job(r, a.w_pool + 2 * 256 * 512, 256, 512, WPG, 0, 1024, scr, lane)) continue;
        if (p0_job(r, a.w_pool + 3 * 256 * 512, 256, 512, WPG, 0, 1536, scr, lane)) continue;
        if (p0_job(r, a.w2g, DM, DFF, W2GU, 1, 0, scr, lane)) continue;
        if (p0_job(r, a.w2u, DM, DFF, W2GU, 2, 0, scr, lane)) continue;
        p0_job(r, a.w2d, DFF, DM, W2D, 0, 0, scr, lane);
    }
}

#define XB_TMO      128
#define XB_XCNT(j)  (256  + 64 * (j))
#define XB_XSUB(j)  (1280 + 64 * (j))
#define XB_XGEN(j)  (2304 + 64 * (j))
#define XB_TOP      3328
#define XB_TOPGEN   3392
#define XCD_BAR_WORDS 3456
#define XB_SPIN_CAP (1u << 18)

__device__ __forceinline__ unsigned xb_ld(unsigned* p)              { return __hip_atomic_load(p, __ATOMIC_RELAXED, __HIP_MEMORY_SCOPE_AGENT); }
__device__ __forceinline__ unsigned xb_add(unsigned* p, unsigned v) { return __hip_atomic_fetch_add(p, v, __ATOMIC_RELAXED, __HIP_MEMORY_SCOPE_AGENT); }
__device__ __forceinline__ unsigned xb_xcc_id() { return (unsigned)__builtin_amdgcn_s_getreg((3 << 11) | 20) & 0xFu; }
#define XB_SPIN(cond, bar) do { unsigned _sp = 0; while (cond) { __builtin_amdgcn_s_sleep(1); \
    if ((++_sp & 255u) == 0u) { if (xb_ld(&(bar)[XB_TMO])) break; if (_sp > XB_SPIN_CAP) { atomicAdd(&(bar)[XB_TMO], 1u); break; } } } } while (0)

struct XcdBarrier {
    unsigned* bar; unsigned x;
    volatile LAS unsigned* st;
};

__device__ __forceinline__ XcdBarrier xcd_barrier_post(unsigned* bar, volatile LAS unsigned* st) {
    XcdBarrier b; b.bar = bar; b.x = xb_xcc_id(); b.st = st;
    if (threadIdx.x == 0) (void)xb_add(&bar[XB_XCNT(b.x)], 1u);
    return b;
}
__device__ __forceinline__ void xcd_barrier_complete(unsigned* bar, unsigned x, unsigned& nloc, unsigned& nx) {
    const unsigned G = gridDim.x * gridDim.y * gridDim.z;
    unsigned sum, cnt, mine, sp = 0u;
    for (;;) {
        sum = 0u; cnt = 0u; mine = 0u;
#pragma unroll
        for (unsigned j = 0; j < 16; ++j) { const unsigned c = xb_ld(&bar[XB_XCNT(j)]); sum += c; cnt += (c > 0u) ? 1u : 0u; mine = (j == x) ? c : mine; }
        if (sum == G) break;
        __builtin_amdgcn_s_sleep(1);
        if ((++sp & 255u) == 0u) { if (xb_ld(&bar[XB_TMO])) break; if (sp > XB_SPIN_CAP) { atomicAdd(&bar[XB_TMO], 1u); break; } }
    }
    nloc = mine > 0u ? mine : 1u; nx = cnt > 0u ? cnt : 1u;
}

__device__ __forceinline__ void xcd_barrier(const XcdBarrier& b) {
    asm volatile("s_waitcnt vmcnt(0)" ::: "memory");
    __syncthreads();
    if (threadIdx.x == 0) {
        unsigned* bar = b.bar;
        __builtin_amdgcn_s_waitcnt(0);
        unsigned nloc = b.st[0], nx = b.st[1];
        if (nloc == 0u) { xcd_barrier_complete(bar, b.x, nloc, nx); b.st[0] = nloc; b.st[1] = nx; }
        const unsigned old = xb_add(&bar[XB_XSUB(b.x)], 1u);
        const unsigned gen = old / nloc;
        if (old + 1u == (gen + 1u) * nloc) {
            __builtin_amdgcn_fence(__ATOMIC_RELEASE, "agent");
            asm volatile("s_waitcnt vmcnt(0)" ::: "memory");
            const unsigned og = xb_add(&bar[XB_TOP], 1u);
            const unsigned tg = og / nx;
            if (og + 1u == (tg + 1u) * nx) xb_add(&bar[XB_TOPGEN], 1u);
            else XB_SPIN(xb_ld(&bar[XB_TOPGEN]) == tg, bar);
            __builtin_amdgcn_fence(__ATOMIC_ACQUIRE, "agent");
            xb_add(&bar[XB_XGEN(b.x)], 1u);
            asm volatile("s_waitcnt vmcnt(0)" ::: "memory");
        } else {
            XB_SPIN(xb_ld(&bar[XB_XGEN(b.x)]) == gen, bar);
            __builtin_amdgcn_fence(__ATOMIC_ACQUIRE, "agent");
            asm volatile("s_waitcnt vmcnt(0)" ::: "memory");
        }
    }
    __syncthreads();
}

__global__ void __launch_bounds__(NWAVES * 64) fwd_megakernel(Args a) {
    extern __shared__ __attribute__((aligned(16))) unsigned char lds_raw[];
    cg::grid_group grid = cg::this_grid();
    LAS unsigned char* lds = (LAS unsigned char*)lds_raw;
    const int tid = threadIdx.x, lane = tid & 63, wave = __builtin_amdgcn_readfirstlane(tid >> 6);
    const int G = gridDim.x, bx = blockIdx.x;
    const int gw = bx * NWAVES + wave, NGW = G * NWAVES;
    unsigned char* ws = a.ws;
    bf16 *W1GU = (bf16*)(ws + WS_W1GU), *W1D = (bf16*)(ws + WS_W1D), *WIN = (bf16*)(ws + WS_WIN), *WCO = (bf16*)(ws + WS_WCO), *WPG = (bf16*)(ws + WS_WPG), *WO = (bf16*)(ws + WS_WO),
         *W2GU = (bf16*)(ws + WS_W2GU), *W2D = (bf16*)(ws + WS_W2D);
    float* H = (float*)(ws + WS_H);
    bf16 *ACT = (bf16*)(ws + WS_R), *BG = (bf16*)(ws + WS_BG), *CV = (bf16*)(ws + WS_CV), *SGC = (bf16*)(ws + WS_SGC), *SGP = (bf16*)(ws + WS_SGP), *Z = (bf16*)(ws + WS_Z), *PL = (bf16*)(ws + WS_PL);
    bf16 *XN1 = (bf16*)(ws + WS_XN1), *XN = (bf16*)(ws + WS_W1GU);
    float* SLAB = (float*)(ws + WS_SGP);
    volatile LAS unsigned* MISC = (volatile LAS unsigned*)(lds + LDS_BYTES - 128);
    if (tid < 32) MISC[tid] = 0u;
    unsigned* barw = (unsigned*)ws;
    if (bx == 0) for (int i = tid; i < XCD_BAR_WORDS; i += NWAVES * 64) __hip_atomic_store(barw + i, 0u, __ATOMIC_RELAXED, __HIP_MEMORY_SCOPE_AGENT);
    __syncthreads();

    {
        convert_items(a, ws, IT_W1G, IT_W1D, gw, NGW, lds, wave, lane);
        for (int m = gw; m < MPAD; m += NGW) rms_row_bf16(src_row(a, m), a.norm_ffn1, XN1 + (size_t)m * DM, nullptr, lane);
    }
    grid.sync();
    const XcdBarrier bar = xcd_barrier_post(barw, MISC + 8);

    {
        pg8::Gemm g{XN1, W1GU, MPAD, 2 * DFF, DM, DM, DM, 0}; pg8::StaticOrder S; S.init(MPAD, 2 * DFF, DM, G, bx);
        pg8::EpiSwiglu E{ACT, DFF};
        pg8::gemm_phase<pg8::EpiSwiglu, pg8::StaticOrder, true, true>(lds, g, S, E);
        constexpr int FULL = (MPAD / 256) * (2 * DFF / 256) % 256;
        if (bx >= FULL) convert_items(a, ws, IT_W1D, IT_WCO, (bx - FULL) * NWAVES + wave, (G - FULL) * NWAVES, lds, wave, lane);
    }
    xcd_barrier(bar);
    {
        pg8::Gemm g{ACT, W1D, MPAD, DM, DFF, DFF, DFF, 0}; pg8::TailOrder S; S.init(DFF, bx);
        pg8::EpiResid<true> E{H, DM, 0.5f, SLAB, a.x_prompt, a.x_sample, a.meta};
        pg8::gemm_phase<pg8::EpiResid<true>, pg8::TailOrder, true, true>(lds, g, S, E);
    }
    xcd_barrier(bar);
    for (int m = gw; m < MPAD; m += NGW) { float* hr = H + (size_t)m * DM; if (m < 8192) rms_row_bf16(hr, a.norm_mix, XN + (size_t)m * DM, nullptr, lane); else rms_row_bf16(src_row(a, m), a.norm_mix, XN + (size_t)m * DM, hr, lane, SLAB, 0.5f, m); }
    xcd_barrier(bar);
    {
        pg8::Gemm g{XN, WIN, MPAD, DIN, DM, DM, DM, 0}; pg8::StaticOrder S; S.init(MPAD, DIN, DM, G, bx);
        pg8::EpiProj E{BG, CV, Z, SGC, SGP};
        pg8::gemm_phase<pg8::EpiProj, pg8::StaticOrder, true, true>(lds, g, S, E);
        constexpr int FULL = (MPAD / 256) * (DIN / 256) % 256;
        if (bx >= FULL) convert_items(a, ws, IT_WCO, IT_W2G, (bx - FULL) * NWAVES + wave, (G - FULL) * NWAVES, lds, wave, lane);
    }
    xcd_barrier(bar);
    for (int m = gw; m < MREAL; m += NGW) {
        if (m >= MP_ROWS) p3b_row<true>(a, m, lane, BG, CV, Z, PL); else p3b_row<false>(a, m, lane, BG, CV, Z, PL);
    }
    xcd_barrier(bar);
    {
        pg8::Gemm g{PL, WPG, MPAD, DM, 256, DPOOL, 256, 1}; pg8::StaticOrder S; S.init(MPAD, DM, 256, G, bx);
        pg8::EpiPool E{SGP, a.pool_scale};
        pg8::gemm_phase<pg8::EpiPool, pg8::StaticOrder, true, true>(lds, g, S, E);
    }
    __syncthreads();
    {
        pg8::Gemm g{BG, WCO, MPAD, DM, DM, DM, DM, 0}; pg8::StaticOrder S; S.init(MPAD, DM, DM, G, bx);
        pg8::EpiMerge E{SGC, SGP};
        pg8::gemm_phase<pg8::EpiMerge, pg8::StaticOrder, true, true>(lds, g, S, E);
        constexpr int FULL = (MPAD / 256) * (DM / 256) % 256;
        if (bx >= FULL) convert_items(a, ws, IT_W2G, IT_W2D, (bx - FULL) * NWAVES + wave, (G - FULL) * NWAVES, lds, wave, lane);
    }
    xcd_barrier(bar);
    {
        pg8::Gemm g{SGC, WO, MPAD, DM, DM, DM, DM, 0}; pg8::TailOrder S; S.init(DM, bx);
        pg8::EpiResid<false> E{H, DM, 1.0f, SLAB, nullptr, nullptr, nullptr};
        pg8::gemm_phase<pg8::EpiResid<false>, pg8::TailOrder, true, true>(lds, g, S, E);
    }
    xcd_barrier(bar);
    for (int m = gw; m < MPAD; m += NGW) { float* hr = H + (size_t)m * DM; if (m < 8192) rms_row_bf16(hr, a.norm_ffn2, XN + (size_t)m * DM, nullptr, lane); else rms_row_bf16(hr, a.norm_ffn2, XN + (size_t)m * DM, hr, lane, SLAB, 1.0f, m); }
    xcd_barrier(bar);
    {
        pg8::Gemm g{XN, W2GU, MPAD, 2 * DFF, DM, DM, DM, 0}; pg8::StaticOrder S; S.init(MPAD, 2 * DFF, DM, G, bx);
        pg8::EpiSwiglu E{ACT, DFF};
        pg8::gemm_phase<pg8::EpiSwiglu, pg8::StaticOrder, true, true>(lds, g, S, E);
        constexpr int FULL = (MPAD / 256) * (2 * DFF / 256) % 256;
        if (bx >= FULL) convert_items(a, ws, IT_W2D, IT_END, (bx - FULL) * NWAVES + wave, (G - FULL) * NWAVES, lds, wave, lane);
    }
    xcd_barrier(bar);
    {
        pg8::Gemm g{ACT, W2D, MPAD, DM, DFF, DFF, DFF, 0}; pg8::TailOrder S; S.init(DFF, bx);
        pg8::EpiResid<false> E{H, DM, 0.5f, SLAB, nullptr, nullptr, nullptr};
        pg8::gemm_phase<pg8::EpiResid<false>, pg8::TailOrder, true, true>(lds, g, S, E);
    }
    xcd_barrier(bar);
    for (int m = gw; m < MREAL; m += NGW) {
        float* dst;
        if (m < MP_ROWS) { const int b = m / LP, t = m - b * LP; if (t < NMETA) continue; dst = a.out + O_YP + ((size_t)b * SEQ + (t - NMETA)) * DM; }
        else dst = a.out + O_YS + (size_t)(m - MP_ROWS) * DM;
        const float* hr = H + (size_t)m * DM;
        f32x4 v[8]; float s = 0.f;
#pragma unroll
        for (int j = 0; j < 8; ++j) { v[j] = ((const f32x4*)hr)[lane + 64 * j]; if (m >= 8192) v[j] += slab_sum(SLAB, m, j, lane) * 0.5f; s += (v[j].x * v[j].x + v[j].y * v[j].y) + (v[j].z * v[j].z + v[j].w * v[j].w); }
        const float r = 1.0f / sqrtf(wave_sum(s) * (1.0f / DM) + EPS);
#pragma unroll
        for (int j = 0; j < 8; ++j) { const f32x4 gg = ((const f32x4*)a.norm_final)[lane + 64 * j]; ((f32x4*)dst)[lane + 64 * j] = v[j] * r * gg; }
    }
}

extern "C" void kernel_launch(void* const* d_in, const int* in_sizes, int n_in, void* d_out, int out_size, void* d_ws, size_t ws_size, hipStream_t stream) {
    static int grid = 0;
    if (grid == 0) {
        if (n_in != 21 || (size_t)out_size != O_END || ws_size < WS_END) { fprintf(stderr, "kernel_launch: unexpected shapes: n_in %d out %d ws %zu (need %zu)\n", n_in, out_size, ws_size, (size_t)WS_END); grid = -1; return; }
        int dev = 0, cus = 0, per_cu = 0;
        hipGetDevice(&dev); hipDeviceGetAttribute(&cus, hipDeviceAttributeMultiprocessorCount, dev);
        if (hipFuncSetAttribute((const void*)fwd_megakernel, hipFuncAttributeMaxDynamicSharedMemorySize, LDS_BYTES) != hipSuccess) { fprintf(stderr, "kernel_launch: hipFuncSetAttribute failed\n"); grid = -1; return; }
        if (hipOccupancyMaxActiveBlocksPerMultiprocessor(&per_cu, (const void*)fwd_megakernel, NWAVES * 64, LDS_BYTES) != hipSuccess || per_cu < 1) { fprintf(stderr, "kernel_launch: occupancy query failed (%d)\n", per_cu); (void)hipGetLastError(); per_cu = 1; }
        grid = cus * 1;
        fprintf(stderr, "kernel_launch: grid %d (cus %d, per_cu %d)\n", grid, cus, per_cu);
    }
    if (grid < 0) return;
    Args a{};
    a.x_prompt = (const float*)d_in[0]; a.x_sample = (const float*)d_in[1]; a.state_conv = (const float*)d_in[2]; a.state_pool = (const float*)d_in[3]; a.meta = (const float*)d_in[4];
    a.norm_ffn1 = (const float*)d_in[5]; a.w1g = (const float*)d_in[6]; a.w1u = (const float*)d_in[7]; a.w1d = (const float*)d_in[8]; a.norm_mix = (const float*)d_in[9]; a.w_in = (const float*)d_in[10];
    a.conv_w = (const float*)d_in[11]; a.w_conv_out = (const float*)d_in[12]; a.w_pool = (const float*)d_in[13]; a.pool_scale = (const float*)d_in[14]; a.w_o = (const float*)d_in[15];
    a.norm_ffn2 = (const float*)d_in[16]; a.w2g = (const float*)d_in[17]; a.w2u = (const float*)d_in[18]; a.w2d = (const float*)d_in[19]; a.norm_final = (const float*)d_in[20];
    a.out = (float*)d_out; a.ws = (unsigned char*)d_ws;
    void* args[] = {&a};
    hipError_t e = hipLaunchCooperativeKernel((const void*)fwd_megakernel, dim3(grid), dim3(NWAVES * 64), args, LDS_BYTES, stream);
    if (e != hipSuccess) fprintf(stderr, "kernel_launch: cooperative launch failed: %s (grid %d)\n", hipGetErrorString(e), grid);
}
```

```cpp
#include <hip/hip_runtime.h>
#include <hip/hip_cooperative_groups.h>
#include <cstdio>
#include <cstdint>
namespace cg = cooperative_groups;

namespace pg8 {
#define PG8_LAS __attribute__((address_space(3)))
typedef unsigned short bf16_t;
typedef short bf16x8 __attribute__((ext_vector_type(8)));
typedef float f32x4 __attribute__((ext_vector_type(4)));
typedef unsigned u32x4 __attribute__((ext_vector_type(4)));
constexpr int BM = 256, BK = 64, HALF = 128, HTB = HALF * BK * 2  , STAGE_BYTES = 8 * HTB, NXCD = 8, WGM = 8;

__host__ __device__ __forceinline__ int lds_byte(int r, int c) { const int st = (r >> 4) * 2 + (c >> 5), rr = r & 15, cc = c & 31, ob = rr * 64 + cc * 2; return st * 1024 + (ob ^ (((ob >> 9) & 1) << 5)); }
__host__ __device__ __forceinline__ void stage_rc(int b, int& R, int& C) { const int st = b / 1024, sb = b % 1024, swz = sb ^ (((sb >> 9) & 1) << 5); R = (st >> 1) * 16 + swz / 64; C = (st & 1) * 32 + (swz % 64) / 2; }
__host__ __device__ __forceinline__ int perm32(int rho) { const int n = rho >> 4, i = rho & 15; return 8 * (i >> 2) + 4 * n + (i & 3); }

struct Unit { int pm, pn, kt0, nkt, slab; };
struct Gemm { const bf16_t* A; const bf16_t* Bt; int M, N, K, lda, ldb, agrp; };
__device__ __forceinline__ size_t acolb(const Gemm& g, const Unit& u) { return g.agrp ? (size_t)((u.pn >> 1) * 256) * 2 : (size_t)0; }

struct StaticOrder {
    int nM, nN, nwg, G, c, nt;
    __host__ __device__ void init(int M, int N, int K, int G_, int c_) { nM = M / BM; nN = N / BM; nwg = nM * nN; G = G_; c = c_; nt = K / BK; }
    __host__ __device__ bool next(int i, Unit& u) const {
        const long L = (long)i * G + c; if (L >= nwg) return false;
        int wgid = (int)L; { const int q = nwg / NXCD, r = nwg % NXCD, xcd = wgid % NXCD, off = wgid / NXCD; wgid = (xcd < r ? xcd * (q + 1) : r * (q + 1) + (xcd - r) * q) + off; }
        const int nig = WGM * nN, gid = wgid / nig, fm = gid * WGM, gsz = (nM - fm) < WGM ? (nM - fm) : WGM;
        u.pm = fm + ((wgid % nig) % gsz); u.pn = (wgid % nig) / gsz; u.kt0 = 0; u.nkt = nt; u.slab = -1; return true;
    }
    __device__ __forceinline__ void a_ready(const Unit&) const {}
    __device__ __forceinline__ void done(const Unit&) const {}
};
struct TailOrder {
    int c, nt;
    __host__ __device__ void init(int K, int c_) { c = c_; nt = K / BK; }
    __host__ __device__ bool next(int i, Unit& u) const {
        if (i == 0) { const int x = c & 7, idx = c >> 3; u.pm = 4 * x + (idx >> 3); u.pn = idx & 7; u.kt0 = 0; u.nkt = nt; u.slab = -1; return true; }
        if (i == 1 && c < 240) {
            const int x = c & 7, idx = c >> 3, q = idx / 6, r6 = idx - 6 * q, ch = x < 6 ? x : r6, pn = x < 6 ? r6 : x;
            const int np = nt >> 1, base = np / 6, rem = np % 6, p0 = ch * base + (ch < rem ? ch : rem), pc = base + (ch < rem ? 1 : 0);
            u.pm = 32 + q; u.pn = pn; u.kt0 = 2 * p0; u.nkt = 2 * pc; u.slab = (q * 8 + pn) * 6 + ch; return true; }
        return false;
    }
    __device__ __forceinline__ void a_ready(const Unit&) const {}
    __device__ __forceinline__ void done(const Unit&) const {}
};

__device__ __forceinline__ unsigned cvt_pk_bf16(float lo, float hi) { unsigned r; asm volatile("v_cvt_pk_bf16_f32 %0, %1, %2" : "=v"(r) : "v"(lo), "v"(hi)); return r; }
__device__ __forceinline__ float bf_lo(unsigned w) { return __uint_as_float(w << 16); }
__device__ __forceinline__ float bf_hi(unsigned w) { return __uint_as_float(w & 0xffff0000u); }
__device__ __forceinline__ float sigmoidf_(float x) { return __builtin_amdgcn_rcpf(1.0f + __builtin_amdgcn_exp2f(-1.4426950408889634f * x)); }
__device__ __forceinline__ u32x4 pack8(const f32x4& a, const f32x4& b) { u32x4 w; w.x = cvt_pk_bf16(a[0], a[1]); w.y = cvt_pk_bf16(a[2], a[3]); w.z = cvt_pk_bf16(b[0], b[1]); w.w = cvt_pk_bf16(b[2], b[3]); return w; }
__device__ __forceinline__ void unpack8(const u32x4& w, f32x4& a, f32x4& b) { a = (f32x4){bf_lo(w.x), bf_hi(w.x), bf_lo(w.y), bf_hi(w.y)}; b = (f32x4){bf_lo(w.z), bf_hi(w.z), bf_lo(w.w), bf_hi(w.w)}; }

struct EpiSwiglu {
    static constexpr bool PERM = true, AFTER_DRAIN = false;
    bf16_t* O; int ldc;
    __device__ __forceinline__ void operator()(const f32x4 (&acc)[2][2][4][2], const Unit& u, int wr, int wc, int fr, int fq) const {
        const int row0 = u.pm * BM + wr * 64 + fr, col0 = u.pn * HALF + wc * 32 + 8 * fq;
#pragma unroll
        for (int ai = 0; ai < 2; ++ai)
#pragma unroll
            for (int m = 0; m < 4; ++m) {
                f32x4 v[2];
#pragma unroll
                for (int n = 0; n < 2; ++n) { const f32x4 gt = acc[ai][0][m][n], up = acc[ai][1][m][n];
#pragma unroll
                    for (int e = 0; e < 4; ++e) v[n][e] = gt[e] * sigmoidf_(gt[e]) * up[e]; }
                *(u32x4*)(O + (size_t)(row0 + ai * HALF + m * 16) * ldc + col0) = pack8(v[0], v[1]);
            }
    }
};
template <bool FROMX> struct EpiResid {
    static constexpr bool PERM = true, AFTER_DRAIN = false;
    float* H; int ldc; float s; float* SL;
    const float *xp, *xs, *meta;
    __device__ __forceinline__ void operator()(const f32x4 (&acc)[2][2][4][2], const Unit& u, int wr, int wc, int fr, int fq) const {
        if (u.slab >= 0) {
            bf16_t* base = (bf16_t*)SL + (size_t)u.slab * (BM * BM) + (size_t)(wr * 64 + fr) * BM + wc * 32 + 8 * fq;
#pragma unroll
            for (int ai = 0; ai < 2; ++ai)
#pragma unroll
                for (int m = 0; m < 4; ++m)
#pragma unroll
                    for (int bj = 0; bj < 2; ++bj) *(u32x4*)(base + (size_t)(ai * HALF + m * 16) * BM + bj * HALF) = pack8(acc[ai][bj][m][0], acc[ai][bj][m][1]);
            return;
        }
        const int row0 = u.pm * BM + wr * 64 + fr, col0 = u.pn * BM + wc * 32 + 8 * fq;
#pragma unroll
        for (int ai = 0; ai < 2; ++ai)
#pragma unroll
            for (int m = 0; m < 4; ++m) { const int r = row0 + ai * HALF + m * 16; float* rowp = H + (size_t)r * ldc + col0;
                const float* srcp = rowp;
                if (FROMX) {
                    const int b = r / 2064, t = r - b * 2064;
                    srcp = (t < 16 ? meta + (size_t)t * 2048 : xp + ((size_t)b * 2048 + (t - 16)) * 2048) + col0;
                }
#pragma unroll
                for (int bj = 0; bj < 2; ++bj)
#pragma unroll
                    for (int n = 0; n < 2; ++n) { const f32x4 h = *(const f32x4*)(srcp + bj * HALF + n * 4); *(f32x4*)(rowp + bj * HALF + n * 4) = h + acc[ai][bj][m][n] * s; }
                if (m & 1) asm volatile("" ::: "memory"); }
    }
};
struct EpiProj {
    static constexpr bool PERM = true, AFTER_DRAIN = false;
    bf16_t *BG, *CV, *Z, *SGC, *SGP;
    __device__ __forceinline__ void operator()(const f32x4 (&acc)[2][2][4][2], const Unit& u, int wr, int wc, int fr, int fq) const {
        const int row0 = u.pm * BM + wr * 64 + fr, pn = u.pn;
        if (pn >= 8 && pn < 24) {
            const int col0 = (pn - 8) * HALF + wc * 32 + 8 * fq;
#pragma unroll
            for (int ai = 0; ai < 2; ++ai)
#pragma unroll
                for (int m = 0; m < 4; ++m)
                    *(u32x4*)(CV + (size_t)(row0 + ai * HALF + m * 16) * 2048 + col0) = pack8(acc[ai][0][m][0] * acc[ai][1][m][0], acc[ai][0][m][1] * acc[ai][1][m][1]);
        } else {
            bf16_t* base; int ld, ct; bool sg;
            if (pn < 8) { base = BG; ld = 2048; ct = pn; sg = false; }
            else if (pn < 28) { base = Z; ld = 1024; ct = pn - 24; sg = false; }
            else if (pn < 36) { base = SGC; ld = 2048; ct = pn - 28; sg = true; }
            else { base = SGP; ld = 2048; ct = pn - 36; sg = true; }
            const int col0 = ct * BM + wc * 32 + 8 * fq;
#pragma unroll
            for (int ai = 0; ai < 2; ++ai)
#pragma unroll
                for (int m = 0; m < 4; ++m) { bf16_t* rowp = base + (size_t)(row0 + ai * HALF + m * 16) * ld + col0;
#pragma unroll
                    for (int bj = 0; bj < 2; ++bj) { f32x4 v0 = acc[ai][bj][m][0], v1 = acc[ai][bj][m][1];
                        if (sg) {
#pragma unroll
                            for (int e = 0; e < 4; ++e) { v0[e] = sigmoidf_(v0[e]); v1[e] = sigmoidf_(v1[e]); } }
                        *(u32x4*)(rowp + bj * HALF) = pack8(v0, v1); } }
        }
    }
};
struct EpiPool {
    static constexpr bool PERM = true, AFTER_DRAIN = false;
    bf16_t* SGP; const float* ps;
    __device__ __forceinline__ void operator()(const f32x4 (&acc)[2][2][4][2], const Unit& u, int wr, int wc, int fr, int fq) const {
        const int row0 = u.pm * BM + wr * 64 + fr, col0 = u.pn * BM + wc * 32 + 8 * fq;
#pragma unroll
        for (int ai = 0; ai < 2; ++ai)
#pragma unroll
            for (int m = 0; m < 4; ++m) { bf16_t* rowp = SGP + (size_t)(row0 + ai * HALF + m * 16) * 2048 + col0;
#pragma unroll
                for (int bj = 0; bj < 2; ++bj) { u32x4* p = (u32x4*)(rowp + bj * HALF); f32x4 g0, g1; unpack8(*p, g0, g1);
                    const f32x4 s0 = *(const f32x4*)(ps + col0 + bj * HALF), s1 = *(const f32x4*)(ps + col0 + bj * HALF + 4);
                    *p = pack8(g0 * s0 * acc[ai][bj][m][0], g1 * s1 * acc[ai][bj][m][1]); }
                asm volatile("" ::: "memory"); }
    }
};
struct EpiMerge {
    static constexpr bool PERM = true, AFTER_DRAIN = false;
    bf16_t* SGC; const bf16_t* MP;
    __device__ __forceinline__ void operator()(const f32x4 (&acc)[2][2][4][2], const Unit& u, int wr, int wc, int fr, int fq) const {
        const int row0 = u.pm * BM + wr * 64 + fr, col0 = u.pn * BM + wc * 32 + 8 * fq;
#pragma unroll
        for (int ai = 0; ai < 2; ++ai)
#pragma unroll
            for (int m = 0; m < 4; ++m) { const size_t off = (size_t)(row0 + ai * HALF + m * 16) * 2048 + col0;
#pragma unroll
                for (int bj = 0; bj < 2; ++bj) { u32x4* p = (u32x4*)(SGC + off + bj * HALF); f32x4 g0, g1, q0, q1; unpack8(*p, g0, g1); unpack8(*(const u32x4*)(MP + off + bj * HALF), q0, q1);
                    *p = pack8(g0 * acc[ai][bj][m][0] + q0, g1 * acc[ai][bj][m][1] + q1); }
                if (m & 1) asm volatile("" ::: "memory"); }
    }
};

template <class Epi, class Sched, bool ALIGN_EPI = false, bool SP2 = false>
__device__ __forceinline__ void gemm_phase(PG8_LAS unsigned char* lds, const Gemm g, const Sched& S, const Epi& E) {
    int tid_ = threadIdx.x; asm volatile("" : "+v"(tid_));
    const int tid = tid_, wid = __builtin_amdgcn_readfirstlane(tid >> 6), lane = tid & 63, wr = wid >> 2, wc = wid & 3, fr = lane & 15, fq = lane >> 4;

    unsigned voffA[2], voffB[2];
#pragma unroll
    for (int i = 0; i < 2; ++i) { int R, C; stage_rc(tid * 16 + i * 8192, R, C); const int Rb = Epi::PERM ? ((R & ~31) + perm32(R & 31)) : R;
        voffA[i] = (unsigned)(R * g.lda + C) * 2u; voffB[i] = (unsigned)(Rb * g.ldb + C) * 2u; }
    const size_t kstep = (size_t)(BK * 2);
    const size_t hstepA = (size_t)HALF * g.lda * 2, hstepB = (size_t)HALF * g.ldb * 2;
    const size_t tstepA = 2 * hstepA, tstepB = 2 * hstepB;
    const unsigned ldsw = (unsigned)wid * 1024u;
    const int aoff = lds_byte(wr * 64 + fr, fq * 8), boff = lds_byte(wc * 32 + fr, fq * 8);
#define PG8_SA(b, h) (((b) * 2 + (h)) * HTB)
#define PG8_SB(b, h) ((4 + (b) * 2 + (h)) * HTB)
#define PG8_STAGE(bufoff, gbase, voff) do { _Pragma("unroll") for (int _i = 0; _i < 2; ++_i) \
        __builtin_amdgcn_global_load_lds((const unsigned*)((const char*)(gbase) + (voff)[_i]), (PG8_LAS unsigned*)(lds + (bufoff) + ldsw + _i * 8192), 16, 0, 0); } while (0)
#define PG8_LDA(dst, b, h) do { _Pragma("unroll") for (int m = 0; m < 4; ++m) _Pragma("unroll") for (int k = 0; k < 2; ++k) dst[m][k] = *(const PG8_LAS bf16x8*)(lds + PG8_SA(b, h) + aoff + m * 2048 + k * 1024); } while (0)
#define PG8_LDB(dst, b, h) do { _Pragma("unroll") for (int n = 0; n < 2; ++n) _Pragma("unroll") for (int k = 0; k < 2; ++k) dst[n][k] = *(const PG8_LAS bf16x8*)(lds + PG8_SB(b, h) + boff + n * 2048 + k * 1024); } while (0)
#define PG8_MMA(ai, bj, At, Bt) do { __builtin_amdgcn_s_setprio(1); _Pragma("unroll") for (int m = 0; m < 4; ++m) _Pragma("unroll") for (int n = 0; n < 2; ++n) _Pragma("unroll") for (int k = 0; k < 2; ++k) \
        acc[ai][bj][m][n] = __builtin_amdgcn_mfma_f32_16x16x32_bf16(Bt[n][k], At[m][k], acc[ai][bj][m][n], 0, 0, 0); __builtin_amdgcn_s_setprio(0); } while (0)
#define PG8_WAIT_V(n) asm volatile("s_waitcnt vmcnt(" #n ")" ::: "memory")
#define PG8_WAIT_L(n) asm volatile("s_waitcnt lgkmcnt(" #n ")" ::: "memory")
#define PG8_BAR __builtin_amdgcn_s_barrier()
#define PG8_SCHED __builtin_amdgcn_sched_barrier(0)
    Unit cur, nxt; int ui = 0;
    if (!S.next(0, cur)) return;
    f32x4 acc[2][2][4][2];
#pragma unroll
    for (int a = 0; a < 2; ++a)
#pragma unroll
        for (int b = 0; b < 2; ++b)
#pragma unroll
            for (int m = 0; m < 4; ++m)
#pragma unroll
                for (int n = 0; n < 2; ++n) acc[a][b][m][n] = (f32x4){0.f, 0.f, 0.f, 0.f};
    bf16x8 At[4][2], B0[2][2], B1[2][2];
    const char* cA = (const char*)g.A + (size_t)cur.pm * tstepA + acolb(g, cur) + (size_t)cur.kt0 * kstep; const char* cB = (const char*)g.Bt + (size_t)cur.pn * tstepB + (size_t)cur.kt0 * kstep;
    S.a_ready(cur);
    if constexpr (SP2) {
        PG8_STAGE(PG8_SB(0, 0), cB, voffB); PG8_STAGE(PG8_SB(0, 1), cB + hstepB, voffB); PG8_STAGE(PG8_SA(0, 0), cA, voffA); PG8_STAGE(PG8_SA(0, 1), cA + hstepA, voffA);
        if (wr == 1) PG8_BAR;
        PG8_WAIT_V(2); PG8_BAR;
        PG8_STAGE(PG8_SB(1, 0), cB + kstep, voffB); PG8_STAGE(PG8_SA(1, 0), cA + kstep, voffA); PG8_STAGE(PG8_SB(1, 1), cB + hstepB + kstep, voffB);
        PG8_WAIT_V(6); PG8_BAR;
    } else {
        PG8_STAGE(PG8_SB(0, 0), cB, voffB); PG8_STAGE(PG8_SA(0, 0), cA, voffA); PG8_STAGE(PG8_SB(0, 1), cB + hstepB, voffB); PG8_STAGE(PG8_SA(0, 1), cA + hstepA, voffA);
        if (wr == 1) PG8_BAR;
        PG8_WAIT_V(4); PG8_BAR;
        PG8_STAGE(PG8_SB(1, 0), cB + kstep, voffB); PG8_STAGE(PG8_SA(1, 0), cA + kstep, voffA); PG8_STAGE(PG8_SB(1, 1), cB + hstepB + kstep, voffB);
        PG8_WAIT_V(6); PG8_BAR;
    }
    for (;;) {
        const bool has_next = S.next(ui + 1, nxt);
        const char* nA = has_next ? (const char*)g.A + (size_t)nxt.pm * tstepA + acolb(g, nxt) + (size_t)nxt.kt0 * kstep : cA; const char* nB = has_next ? (const char*)g.Bt + (size_t)nxt.pn * tstepB + (size_t)nxt.kt0 * kstep : cB;
        const int nt = cur.nkt;
        for (int t = 0; t < nt; t += 2) {
            const bool last = (t == nt - 2);
            const char* a1 = cA + (size_t)(t + 1) * kstep;
            const char* a2 = last ? nA : cA + (size_t)(t + 2) * kstep; const char* b2 = last ? nB : cB + (size_t)(t + 2) * kstep;
            const char* a3 = a2 + kstep; const char* b3 = b2 + kstep;
            if (last && has_next) S.a_ready(nxt);
            if constexpr (SP2) {
            PG8_LDB(B0, 0, 0); PG8_LDB(B1, 0, 1); PG8_SCHED; PG8_LDA(At, 0, 0); PG8_STAGE(PG8_SA(1, 1), a1 + hstepA, voffA);
            PG8_WAIT_V(8); PG8_WAIT_L(0); PG8_BAR; PG8_MMA(0, 0, At, B0); PG8_MMA(0, 1, At, B1); PG8_BAR; PG8_SCHED;
            PG8_LDA(At, 0, 1); PG8_STAGE(PG8_SB(0, 0), b2, voffB); PG8_STAGE(PG8_SB(0, 1), b2 + hstepB, voffB); PG8_STAGE(PG8_SA(0, 0), a2, voffA);
            PG8_WAIT_V(8); PG8_WAIT_L(0); PG8_BAR; PG8_MMA(1, 0, At, B0); PG8_MMA(1, 1, At, B1); PG8_BAR; PG8_SCHED;
            PG8_LDB(B0, 1, 0); PG8_LDB(B1, 1, 1); PG8_SCHED; PG8_LDA(At, 1, 0); PG8_STAGE(PG8_SA(0, 1), a2 + hstepA, voffA);
            PG8_WAIT_V(8); PG8_WAIT_L(0); PG8_BAR; PG8_MMA(0, 0, At, B0); PG8_MMA(0, 1, At, B1); PG8_BAR; PG8_SCHED;
            PG8_LDA(At, 1, 1); PG8_STAGE(PG8_SB(1, 0), b3, voffB); PG8_STAGE(PG8_SB(1, 1), b3 + hstepB, voffB); PG8_STAGE(PG8_SA(1, 0), a3, voffA);
            PG8_WAIT_V(8); PG8_WAIT_L(0); PG8_BAR; PG8_MMA(1, 0, At, B0); PG8_MMA(1, 1, At, B1); PG8_BAR; PG8_SCHED;
            } else {
            PG8_LDB(B0, 0, 0); PG8_SCHED; PG8_LDA(At, 0, 0); PG8_STAGE(PG8_SA(1, 1), a1 + hstepA, voffA);
            PG8_WAIT_L(8); PG8_BAR; PG8_WAIT_L(0); PG8_MMA(0, 0, At, B0); PG8_BAR; PG8_SCHED;
            PG8_LDB(B1, 0, 1); PG8_STAGE(PG8_SB(0, 0), b2, voffB);
            PG8_BAR; PG8_WAIT_L(0); PG8_MMA(0, 1, At, B1); PG8_BAR;
            PG8_LDA(At, 0, 1); PG8_STAGE(PG8_SA(0, 0), a2, voffA);
            PG8_BAR; PG8_WAIT_L(0); PG8_MMA(1, 0, At, B0); PG8_BAR; PG8_SCHED;
            PG8_STAGE(PG8_SB(0, 1), b2 + hstepB, voffB);
            PG8_WAIT_V(6); PG8_BAR; PG8_MMA(1, 1, At, B1); PG8_BAR;
            PG8_LDB(B0, 1, 0); PG8_SCHED; PG8_LDA(At, 1, 0); PG8_STAGE(PG8_SA(0, 1), a2 + hstepA, voffA);
            PG8_WAIT_L(8); PG8_BAR; PG8_WAIT_L(0); PG8_MMA(0, 0, At, B0); PG8_BAR; PG8_SCHED;
            PG8_LDB(B1, 1, 1); PG8_STAGE(PG8_SB(1, 0), b3, voffB);
            PG8_BAR; PG8_WAIT_L(0); PG8_MMA(0, 1, At, B1); PG8_BAR;
            PG8_LDA(At, 1, 1); PG8_STAGE(PG8_SA(1, 0), a3, voffA);
            PG8_BAR; PG8_WAIT_L(0); PG8_MMA(1, 0, At, B0); PG8_BAR; PG8_SCHED;
            PG8_STAGE(PG8_SB(1, 1), b3 + hstepB, voffB);
            PG8_WAIT_V(6); PG8_BAR; PG8_MMA(1, 1, At, B1); PG8_BAR;
            }
        }
        if constexpr (ALIGN_EPI) { if (wr == 0) PG8_BAR; }
        if constexpr (!Epi::AFTER_DRAIN) { E(acc, cur, wr, wc, fr, fq); S.done(cur); }
        if (!has_next) break;
#pragma unroll
        for (int a = 0; a < 2; ++a)
#pragma unroll
            for (int b = 0; b < 2; ++b)
#pragma unroll
                for (int m = 0; m < 4; ++m)
#pragma unroll
                    for (int n = 0; n < 2; ++n) acc[a][b][m][n] = (f32x4){0.f, 0.f, 0.f, 0.f};
        cur = nxt; cA = nA; cB = nB; ++ui;
        if constexpr (ALIGN_EPI) { if (wr == 1) PG8_BAR; }
    }
    PG8_WAIT_V(0);
    if constexpr (!ALIGN_EPI) { if (wr == 0) PG8_BAR; }
    PG8_BAR;
    if constexpr (Epi::AFTER_DRAIN) { E.fused(acc, cur, wr, wc, fr, fq, lds, wid, lane); S.done(cur); }
#undef PG8_SA
#undef PG8_SB
#undef PG8_STAGE
#undef PG8_LDA
#undef PG8_LDB
#undef PG8_MMA
#undef PG8_WAIT_V
#undef PG8_WAIT_L
#undef PG8_BAR
#undef PG8_SCHED
}
}

constexpr int DM = 2048, NB = 4, SEQ = 2048, NMETA = 16, LP = SEQ + NMETA  , DECB = 128, DECS = 8;
constexpr int DFF = 5632, DPOOL = 1024, DIN = 11264;
constexpr int MP_ROWS = NB * LP;
constexpr int MS_ROWS = DECB * DECS;
constexpr int MREAL = MP_ROWS + MS_ROWS;
constexpr int MPAD = 9472;
constexpr float EPS = 1e-6f;
constexpr int NWAVES = 8;

constexpr size_t O_YP = 0, O_YS = O_YP + (size_t)NB * SEQ * DM, O_NCP = O_YS + (size_t)MS_ROWS * DM, O_NPP = O_NCP + (size_t)NB * 2 * DM,
                 O_NCS = O_NPP + (size_t)NB * 15 * DPOOL, O_NPS = O_NCS + (size_t)DECB * 2 * DM, O_END = O_NPS + (size_t)DECB * 15 * DPOOL;

constexpr size_t MiB = 1u << 20;
constexpr size_t WS_W1GU = 1 * MiB;
constexpr size_t WS_W1D = WS_W1GU + 44 * MiB;
constexpr size_t WS_WIN = WS_W1D + 22 * MiB;
constexpr size_t WS_WCO = WS_WIN + 44 * MiB;
constexpr size_t WS_WPG = WS_WCO + 8 * MiB;
constexpr size_t WS_WO = WS_WPG + 1 * MiB;
constexpr size_t WS_W2GU = WS_WO + 8 * MiB;
constexpr size_t WS_W2D = WS_W2GU + 44 * MiB;
constexpr size_t WS_H = WS_W2D + 22 * MiB;
constexpr size_t WS_R = WS_H + 74 * MiB;
constexpr size_t WS_BG = WS_R, WS_CV = WS_R + 37 * MiB, WS_SGC = WS_R + 74 * MiB, WS_SGP = WS_R + 111 * MiB, WS_Z = WS_R + 148 * MiB, WS_PL = WS_Z + 19 * MiB;
constexpr size_t WS_XN1 = WS_SGP;
constexpr size_t WS_END = WS_PL + 19 * MiB;
static_assert((size_t)MPAD * DFF * 2 <= 111 * MiB, "ACT fits below XN1");

#define GAS __attribute__((address_space(1)))
#define LAS __attribute__((address_space(3)))
typedef unsigned short bf16;
typedef unsigned v4u __attribute__((ext_vector_type(4)));
typedef float f32x4 __attribute__((ext_vector_type(4)));
#define LDS_WAIT() asm volatile("s_waitcnt lgkmcnt(0)" ::: "memory")
constexpr int LDS_BYTES = 147456;

struct Args {
    const float *x_prompt, *x_sample, *state_conv, *state_pool, *meta, *norm_ffn1, *w1g, *w1u, *w1d, *norm_mix, *w_in, *conv_w, *w_conv_out, *w_pool, *pool_scale, *w_o, *norm_ffn2, *w2g, *w2u, *w2d, *norm_final;
    float* out; unsigned char* ws;
};

__device__ __forceinline__ unsigned pk2(float lo, float hi) { return pg8::cvt_pk_bf16(lo, hi); }
__device__ __forceinline__ float wave_sum(float v) {
#pragma unroll
    for (int o = 1; o < 64; o <<= 1) v += __shfl_xor(v, o);
    return v;
}
__device__ __forceinline__ const float* src_row(const Args& a, int r) {
    if (r < MP_ROWS) { const int b = r / LP, t = r - b * LP; return t < NMETA ? a.meta + (size_t)t * DM : a.x_prompt + ((size_t)b * SEQ + (t - NMETA)) * DM; }
    if (r < MREAL) return a.x_sample + (size_t)(r - MP_ROWS) * DM;
    return nullptr;
}
__device__ __forceinline__ void p0_transpose_item(const float* W, int N, bf16* WT, int K, int k0, int n0, int drow0, LAS float* scr, int lane) {
    const int lr = lane >> 4, lc = (lane & 15) * 4;
    f32x4 v[16];
#pragma unroll
    for (int i = 0; i < 16; ++i) v[i] = *(const f32x4*)(W + (size_t)(k0 + 4 * i + lr) * N + n0 + lc);
#pragma unroll
    for (int i = 0; i < 16; ++i) { LAS float* s = scr + (4 * i + lr) * 65 + lc; s[0] = v[i].x; s[1] = v[i].y; s[2] = v[i].z; s[3] = v[i].w; }
    LDS_WAIT(); asm volatile("" ::: "memory");
    const int c = lane & 7;
#pragma unroll
    for (int j = 0; j < 8; ++j) { const int n = (lane >> 3) + 8 * j; const LAS float* s = scr + (8 * c) * 65 + n;
        v4u o; o.x = pk2(s[0 * 65], s[1 * 65]); o.y = pk2(s[2 * 65], s[3 * 65]); o.z = pk2(s[4 * 65], s[5 * 65]); o.w = pk2(s[6 * 65], s[7 * 65]);
        *(v4u*)(WT + (size_t)(drow0 + n) * K + k0 + 8 * c) = o; }
    LDS_WAIT(); asm volatile("" ::: "memory");
}
__device__ __forceinline__ bool p0_job(int& r, const float* W, int K, int N, bf16* WT, int kind, int roff, LAS float* scr, int lane) {
    const int nb = N / 64, items = (K / 64) * nb;
    if (r >= items) { r -= items; return false; }
    const int kb = r / nb, n0 = (r % nb) * 64;
    int d;
    if (kind == 0) d = roff + n0;
    else if (kind == 1) d = (n0 >> 7) * 256 + (n0 & 127);
    else if (kind == 2) d = (n0 >> 7) * 256 + 128 + (n0 & 127);
    else { if (n0 < 2048 || n0 >= 6144) d = n0; else if (n0 < 4096) { const int j = n0 - 2048; d = 2048 + (j >> 7) * 256 + (j & 127); } else { const int j = n0 - 4096; d = 2048 + (j >> 7) * 256 + 128 + (j & 127); } }
    p0_transpose_item(W, N, WT, K, kb * 64, n0, d, scr, lane);
    return true;
}
__device__ __forceinline__ f32x4 slab_sum(const float* SL, int m, int j, int lane) {
    typedef unsigned u32x2 __attribute__((ext_vector_type(2)));
    const bf16* p = (const bf16*)SL + (size_t)(((m >> 8) - 32) * 8 + j) * 6 * 65536 + (size_t)(m & 255) * 256 + 4 * lane;
    f32x4 a = (f32x4){0.f, 0.f, 0.f, 0.f};
#pragma unroll
    for (int ch = 0; ch < 6; ++ch) { const u32x2 w = *(const u32x2*)(p + (size_t)ch * 65536); a += (f32x4){pg8::bf_lo(w.x), pg8::bf_hi(w.x), pg8::bf_lo(w.y), pg8::bf_hi(w.y)}; }
    return a;
}
__device__ __forceinline__ void rms_row_bf16(const float* xrow, const float* g, bf16* orow, float* hout, int lane, const float* SL = nullptr, float sc = 0.f, int m = 0) {
    f32x4 v[8]; float s = 0.f;
    const bool red = SL && m >= 8192;
#pragma unroll
    for (int j = 0; j < 8; ++j) {
        v[j] = xrow ? ((const f32x4*)xrow)[lane + 64 * j] : (f32x4){0.f, 0.f, 0.f, 0.f};
        if (red) v[j] += slab_sum(SL, m, j, lane) * sc;
        s += (v[j].x * v[j].x + v[j].y * v[j].y) + (v[j].z * v[j].z + v[j].w * v[j].w);
    }
    const float r = 1.0f / sqrtf(wave_sum(s) * (1.0f / DM) + EPS);
#pragma unroll
    for (int j = 0; j < 8; ++j) {
        if (hout) ((f32x4*)hout)[lane + 64 * j] = v[j];
        const f32x4 gg = ((const f32x4*)g)[lane + 64 * j];
        const unsigned lo = pk2(v[j].x * r * gg.x, v[j].y * r * gg.y), hi = pk2(v[j].z * r * gg.z, v[j].w * r * gg.w);
        ((unsigned long long*)orow)[lane + 64 * j] = (unsigned long long)lo | ((unsigned long long)hi << 32);
    }
}
__device__ __forceinline__ void load8_bf16(const bf16* p, float (&o)[8]) { const v4u w = *(const v4u*)p; o[0] = pg8::bf_lo(w.x); o[1] = pg8::bf_hi(w.x); o[2] = pg8::bf_lo(w.y); o[3] = pg8::bf_hi(w.y); o[4] = pg8::bf_lo(w.z); o[5] = pg8::bf_hi(w.z); o[6] = pg8::bf_lo(w.w); o[7] = pg8::bf_hi(w.w); }
__device__ __forceinline__ void load8_f32(const float* p, float (&o)[8]) { const f32x4 a = ((const f32x4*)p)[0], b = ((const f32x4*)p)[1]; o[0] = a.x; o[1] = a.y; o[2] = a.z; o[3] = a.w; o[4] = b.x; o[5] = b.y; o[6] = b.z; o[7] = b.w; }
__device__ __forceinline__ void store8_f32(float* p, const float (&o)[8]) { ((f32x4*)p)[0] = (f32x4){o[0], o[1], o[2], o[3]}; ((f32x4*)p)[1] = (f32x4){o[4], o[5], o[6], o[7]}; }


__device__ __forceinline__ void acc8_bf16(const v4u& w, float msk, float (&s)[8]) {
    s[0] += msk * pg8::bf_lo(w.x); s[1] += msk * pg8::bf_hi(w.x); s[2] += msk * pg8::bf_lo(w.y); s[3] += msk * pg8::bf_hi(w.y);
    s[4] += msk * pg8::bf_lo(w.z); s[5] += msk * pg8::bf_hi(w.z); s[6] += msk * pg8::bf_lo(w.w); s[7] += msk * pg8::bf_hi(w.w);
}
template <bool SMP>
__device__ __forceinline__ void p3b_row(const Args& a, int m, int lane, bf16* BG, const bf16* CV, const bf16* Z, bf16* PL) {
    int sq, t;
    if (SMP) { sq = (m - MP_ROWS) >> 3; t = (m - MP_ROWS) & 7; } else { sq = m / LP; t = m - sq * LP; }
    constexpr int L = SMP ? DECS : LP;
    const float* sc = a.state_conv + (size_t)sq * 2 * DM;
    const float* sp = a.state_pool + (size_t)sq * 15 * DPOOL;
    float* ncv = (t >= L - 2) ? a.out + (SMP ? O_NCS : O_NCP) + ((size_t)sq * 2 + (t - (L - 2))) * DM : nullptr;
    const float m1 = t >= 1 ? 1.f : 0.f, m2 = t >= 2 ? 1.f : 0.f;
    const int r1 = t >= 1 ? m - 1 : m, r2 = t >= 2 ? m - 2 : m;
#pragma unroll 2
    for (int j = 0; j < 4; ++j) {
        const int col = 512 * j + 8 * lane;
        float c0[8], c1[8], c2[8], bg[8], w0[8], w1[8], w2[8], o[8];
        load8_bf16(CV + (size_t)m * DM + col, c2); load8_bf16(CV + (size_t)r1 * DM + col, c1); load8_bf16(CV + (size_t)r2 * DM + col, c0);
        load8_bf16(BG + (size_t)m * DM + col, bg);
        load8_f32(a.conv_w + col, w0); load8_f32(a.conv_w + DM + col, w1); load8_f32(a.conv_w + 2 * DM + col, w2);
#pragma unroll
        for (int e = 0; e < 8; ++e) { c1[e] *= m1; c0[e] *= m2; }
        if (SMP) {
            float s1[8], s0[8];
            load8_f32(sc + (size_t)DM + col, s1); load8_f32(sc + (size_t)(t == 1 ? DM : 0) + col, s0);
#pragma unroll
            for (int e = 0; e < 8; ++e) { c1[e] += (1.f - m1) * s1[e]; c0[e] += (1.f - m2) * s0[e]; }
        }
#pragma unroll
        for (int e = 0; e < 8; ++e) o[e] = bg[e] * (w0[e] * c0[e] + w1[e] * c1[e] + w2[e] * c2[e]);
        v4u w; w.x = pk2(o[0], o[1]); w.y = pk2(o[2], o[3]); w.z = pk2(o[4], o[5]); w.w = pk2(o[6], o[7]);
        *(v4u*)(BG + (size_t)m * DM + col) = w;
        if (ncv) store8_f32(ncv + col, c2);
    }
    float* npp = nullptr;
    if (SMP) npp = a.out + O_NPS + ((size_t)sq * 15 + 7 + t) * DPOOL; else if (t >= L - 15) npp = a.out + O_NPP + ((size_t)sq * 15 + (t - (L - 15))) * DPOOL;
#pragma unroll
    for (int j = 0; j < 2; ++j) {
        const int col = 512 * j + 8 * lane, gq = col >> 8, k = 2 << gq;
        float z0[8], s[8];
        load8_bf16(Z + (size_t)m * DPOOL + col, z0);
#pragma unroll
        for (int e = 0; e < 8; ++e) s[e] = z0[e];
        if (j == 0) {
#pragma unroll
            for (int i = 1; i < 4; ++i) { const bool in = t - i >= 0; const v4u w = *(const v4u*)(Z + (size_t)(in ? m - i : m) * DPOOL + col); acc8_bf16(w, (in && i < k) ? 1.f : 0.f, s); }
            if (SMP) {
#pragma unroll
                for (int i = 1; i < 4; ++i) { const bool st = t - i < 0; float q[8]; load8_f32(sp + (size_t)(st ? 15 + t - i : 0) * DPOOL + col, q); const float mk = (st && i < k) ? 1.f : 0.f;
#pragma unroll
                    for (int e = 0; e < 8; ++e) s[e] += mk * q[e]; }
            }
        } else {
#pragma unroll
            for (int i = 1; i < 16; ++i) { const bool in = t - i >= 0; const v4u w = *(const v4u*)(Z + (size_t)(in ? m - i : m) * DPOOL + col); acc8_bf16(w, (in && i < k) ? 1.f : 0.f, s); }
            if (SMP) {
#pragma unroll
                for (int i = 1; i < 16; ++i) { const bool st = t - i < 0; float q[8]; load8_f32(sp + (size_t)(st ? 15 + t - i : 0) * DPOOL + col, q); const float mk = (st && i < k) ? 1.f : 0.f;
#pragma unroll
                    for (int e = 0; e < 8; ++e) s[e] += mk * q[e]; }
            }
        }
        const int cnt = SMP ? k : (k < t + 1 ? k : t + 1);
        const float inv = 1.0f / (float)cnt;
        float o[8];
#pragma unroll
        for (int e = 0; e < 8; ++e) o[e] = s[e] * inv - z0[e];
        v4u w; w.x = pk2(o[0], o[1]); w.y = pk2(o[2], o[3]); w.z = pk2(o[4], o[5]); w.w = pk2(o[6], o[7]);
        *(v4u*)(PL + (size_t)m * DPOOL + col) = w;
        if (npp) store8_f32(npp + col, z0);
        if (SMP && t < 7) { float q[8]; load8_f32(sp + (size_t)(8 + t) * DPOOL + col, q); store8_f32(a.out + O_NPS + ((size_t)sq * 15 + t) * DPOOL + col, q); }
    }
}

constexpr int NI_GU = (DM / 64) * (DFF / 64), NI_D = (DFF / 64) * (DM / 64), NI_IN = (DM / 64) * (DIN / 64), NI_SQ = (DM / 64) * (DM / 64), NI_PG = (256 / 64) * (512 / 64);
constexpr int IT_W1G = 0, IT_W1D = 2 * NI_GU, IT_WCO = IT_W1D + NI_D + NI_IN, IT_W2G = IT_WCO + 2 * NI_SQ + 4 * NI_PG, IT_W2D = IT_W2G + 2 * NI_GU, IT_END = IT_W2D + NI_D;
__device__ __forceinline__ void convert_items(const Args& a, unsigned char* ws, int it_lo, int it_hi, int widx, int nw, LAS unsigned char* lds, int wave, int lane) {
    LAS float* scr = (LAS float*)(lds + wave * 16640);
    bf16 *W1GU = (bf16*)(ws + WS_W1GU), *W1D = (bf16*)(ws + WS_W1D), *WIN = (bf16*)(ws + WS_WIN), *WCO = (bf16*)(ws + WS_WCO), *WPG = (bf16*)(ws + WS_WPG), *WO = (bf16*)(ws + WS_WO),
         *W2GU = (bf16*)(ws + WS_W2GU), *W2D = (bf16*)(ws + WS_W2D);
    for (int it = it_lo + widx; it < it_hi; it += nw) {
        int r = it;
        if (p0_job(r, a.w1g, DM, DFF, W1GU, 1, 0, scr, lane)) continue;
        if (p0_job(r, a.w1u, DM, DFF, W1GU, 2, 0, scr, lane)) continue;
        if (p0_job(r, a.w1d, DFF, DM, W1D, 0, 0, scr, lane)) continue;
        if (p0_job(r, a.w_in, DM, DIN, WIN, 3, 0, scr, lane)) continue;
        if (p0_job(r, a.w_conv_out, DM, DM, WCO, 0, 0, scr, lane)) continue;
        if (p0_job(r, a.w_o, DM, DM, WO, 0, 0, scr, lane)) continue;
        if (p0_job(r, a.w_pool + 0 * 256 * 512, 256, 512, WPG, 0, 0, scr, lane)) continue;
        if (p0_job(r, a.w_pool + 1 * 256 * 512, 256, 512, WPG, 0, 512, scr, lane)) continue;
        if (p0_job(r, a.w_pool + 2 * 256 * 512, 256, 512, WPG, 0, 1024, scr, lane)) continue;
        if (p0_job(r, a.w_pool + 3 * 256 * 512, 256, 512, WPG, 0, 1536, scr, lane)) continue;
        if (p0_job(r, a.w2g, DM, DFF, W2GU, 1, 0, scr, lane)) continue;
        if (p0_job(r, a.w2u, DM, DFF, W2GU, 2, 0, scr, lane)) continue;
        p0_job(r, a.w2d, DFF, DM, W2D, 0, 0, scr, lane);
    }
}

#define XB_TMO      128
#define XB_XCNT(j)  (256  + 64 * (j))
#define XB_XSUB(j)  (1280 + 64 * (j))
#define XB_XGEN(j)  (2304 + 64 * (j))
#define XB_TOP      3328
#define XB_TOPGEN   3392
#define XCD_BAR_WORDS 3456
#define XB_SPIN_CAP (1u << 18)

__device__ __forceinline__ unsigned xb_ld(unsigned* p)              { return __hip_atomic_load(p, __ATOMIC_RELAXED, __HIP_MEMORY_SCOPE_AGENT); }
__device__ __forceinline__ unsigned xb_add(unsigned* p, unsigned v) { return __hip_atomic_fetch_add(p, v, __ATOMIC_RELAXED, __HIP_MEMORY_SCOPE_AGENT); }
__device__ __forceinline__ unsigned xb_xcc_id() { return (unsigned)__builtin_amdgcn_s_getreg((3 << 11) | 20) & 0xFu; }
#define XB_SPIN(cond, bar) do { unsigned _sp = 0; while (cond) { __builtin_amdgcn_s_sleep(1); \
    if ((++_sp & 255u) == 0u) { if (xb_ld(&(bar)[XB_TMO])) break; if (_sp > XB_SPIN_CAP) { atomicAdd(&(bar)[XB_TMO], 1u); break; } } } } while (0)

struct XcdBarrier {
    unsigned* bar; unsigned x;
    volatile LAS unsigned* st;
};

__device__ __forceinline__ XcdBarrier xcd_barrier_post(unsigned* bar, volatile LAS unsigned* st) {
    XcdBarrier b; b.bar = bar; b.x = xb_xcc_id(); b.st = st;
    if (threadIdx.x == 0) (void)xb_add(&bar[XB_XCNT(b.x)], 1u);
    return b;
}
__device__ __forceinline__ void xcd_barrier_complete(unsigned* bar, unsigned x, unsigned& nloc, unsigned& nx) {
    const unsigned G = gridDim.x * gridDim.y * gridDim.z;
    unsigned sum, cnt, mine, sp = 0u;
    for (;;) {
        sum = 0u; cnt = 0u; mine = 0u;
#pragma unroll
        for (unsigned j = 0; j < 16; ++j) { const unsigned c = xb_ld(&bar[XB_XCNT(j)]); sum += c; cnt += (c > 0u) ? 1u : 0u; mine = (j == x) ? c : mine; }
        if (sum == G) break;
        __builtin_amdgcn_s_sleep(1);
        if ((++sp & 255u) == 0u) { if (xb_ld(&bar[XB_TMO])) break; if (sp > XB_SPIN_CAP) { atomicAdd(&bar[XB_TMO], 1u); break; } }
    }
    nloc = mine > 0u ? mine : 1u; nx = cnt > 0u ? cnt : 1u;
}

__device__ __forceinline__ void xcd_barrier(const XcdBarrier& b) {
    asm volatile("s_waitcnt vmcnt(0)" ::: "memory");
    __syncthreads();
    if (threadIdx.x == 0) {
        unsigned* bar = b.bar;
        __builtin_amdgcn_s_waitcnt(0);
        unsigned nloc = b.st[0], nx = b.st[1];
        if (nloc == 0u) { xcd_barrier_complete(bar, b.x, nloc, nx); b.st[0] = nloc; b.st[1] = nx; }
        const unsigned old = xb_add(&bar[XB_XSUB(b.x)], 1u);
        const unsigned gen = old / nloc;
        if (old + 1u == (gen + 1u) * nloc) {
            __builtin_amdgcn_fence(__ATOMIC_RELEASE, "agent");
            asm volatile("s_waitcnt vmcnt(0)" ::: "memory");
            const unsigned og = xb_add(&bar[XB_TOP], 1u);
            const unsigned tg = og / nx;
            if (og + 1u == (tg + 1u) * nx) xb_add(&bar[XB_TOPGEN], 1u);
            else XB_SPIN(xb_ld(&bar[XB_TOPGEN]) == tg, bar);
            __builtin_amdgcn_fence(__ATOMIC_ACQUIRE, "agent");
            xb_add(&bar[XB_XGEN(b.x)], 1u);
            asm volatile("s_waitcnt vmcnt(0)" ::: "memory");
        } else {
            XB_SPIN(xb_ld(&bar[XB_XGEN(b.x)]) == gen, bar);
            __builtin_amdgcn_fence(__ATOMIC_ACQUIRE, "agent");
            asm volatile("s_waitcnt vmcnt(0)" ::: "memory");
        }
    }
    __syncthreads();
}

__global__ void __launch_bounds__(NWAVES * 64) fwd_megakernel(Args a) {
    extern __shared__ __attribute__((aligned(16))) unsigned char lds_raw[];
    cg::grid_group grid = cg::this_grid();
    LAS unsigned char* lds = (LAS unsigned char*)lds_raw;
    const int tid = threadIdx.x, lane = tid & 63, wave = __builtin_amdgcn_readfirstlane(tid >> 6);
    const int G = gridDim.x, bx = blockIdx.x;
    const int gw = bx * NWAVES + wave, NGW = G * NWAVES;
    unsigned char* ws = a.ws;
    bf16 *W1GU = (bf16*)(ws + WS_W1GU), *W1D = (bf16*)(ws + WS_W1D), *WIN = (bf16*)(ws + WS_WIN), *WCO = (bf16*)(ws + WS_WCO), *WPG = (bf16*)(ws + WS_WPG), *WO = (bf16*)(ws + WS_WO),
         *W2GU = (bf16*)(ws + WS_W2GU), *W2D = (bf16*)(ws + WS_W2D);
    float* H = (float*)(ws + WS_H);
    bf16 *ACT = (bf16*)(ws + WS_R), *BG = (bf16*)(ws + WS_BG), *CV = (bf16*)(ws + WS_CV), *SGC = (bf16*)(ws + WS_SGC), *SGP = (bf16*)(ws + WS_SGP), *Z = (bf16*)(ws + WS_Z), *PL = (bf16*)(ws + WS_PL);
    bf16 *XN1 = (bf16*)(ws + WS_XN1), *XN = (bf16*)(ws + WS_W1GU);
    float* SLAB = (float*)(ws + WS_SGP);
    volatile LAS unsigned* MISC = (volatile LAS unsigned*)(lds + LDS_BYTES - 128);
    if (tid < 32) MISC[tid] = 0u;
    unsigned* barw = (unsigned*)ws;
    if (bx == 0) for (int i = tid; i < XCD_BAR_WORDS; i += NWAVES * 64) __hip_atomic_store(barw + i, 0u, __ATOMIC_RELAXED, __HIP_MEMORY_SCOPE_AGENT);
    __syncthreads();

    {
        convert_items(a, ws, IT_W1G, IT_W1D, gw, NGW, lds, wave, lane);
        for (int m = gw; m < MPAD; m += NGW) rms_row_bf16(src_row(a, m), a.norm_ffn1, XN1 + (size_t)m * DM, nullptr, lane);
    }
    grid.sync();
    const XcdBarrier bar = xcd_barrier_post(barw, MISC + 8);

    {
        pg8::Gemm g{XN1, W1GU, MPAD, 2 * DFF, DM, DM, DM, 0}; pg8::StaticOrder S; S.init(MPAD, 2 * DFF, DM, G, bx);
        pg8::EpiSwiglu E{ACT, DFF};
        pg8::gemm_phase<pg8::EpiSwiglu, pg8::StaticOrder, true, true>(lds, g, S, E);
        constexpr int FULL = (MPAD / 256) * (2 * DFF / 256) % 256;
        if (bx >= FULL) convert_items(a, ws, IT_W1D, IT_WCO, (bx - FULL) * NWAVES + wave, (G - FULL) * NWAVES, lds, wave, lane);
    }
    xcd_barrier(bar);
    {
        pg8::Gemm g{ACT, W1D, MPAD, DM, DFF, DFF, DFF, 0}; pg8::TailOrder S; S.init(DFF, bx);
        pg8::EpiResid<true> E{H, DM, 0.5f, SLAB, a.x_prompt, a.x_sample, a.meta};
        pg8::gemm_phase<pg8::EpiResid<true>, pg8::TailOrder, true, true>(lds, g, S, E);
    }
    xcd_barrier(bar);
    for (int m = gw; m < MPAD; m += NGW) { float* hr = H + (size_t)m * DM; if (m < 8192) rms_row_bf16(hr, a.norm_mix, XN + (size_t)m * DM, nullptr, lane); else rms_row_bf16(src_row(a, m), a.norm_mix, XN + (size_t)m * DM, hr, lane, SLAB, 0.5f, m); }
    xcd_barrier(bar);
    {
        pg8::Gemm g{XN, WIN, MPAD, DIN, DM, DM, DM, 0}; pg8::StaticOrder S; S.init(MPAD, DIN, DM, G, bx);
        pg8::EpiProj E{BG, CV, Z, SGC, SGP};
        pg8::gemm_phase<pg8::EpiProj, pg8::StaticOrder, true, true>(lds, g, S, E);
        constexpr int FULL = (MPAD / 256) * (DIN / 256) % 256;
        if (bx >= FULL) convert_items(a, ws, IT_WCO, IT_W2G, (bx - FULL) * NWAVES + wave, (G - FULL) * NWAVES, lds, wave, lane);
    }
    xcd_barrier(bar);
    for (int m = gw; m < MREAL; m += NGW) {
        if (m >= MP_ROWS) p3b_row<true>(a, m, lane, BG, CV, Z, PL); else p3b_row<false>(a, m, lane, BG, CV, Z, PL);
    }
    xcd_barrier(bar);
    {
        pg8::Gemm g{PL, WPG, MPAD, DM, 256, DPOOL, 256, 1}; pg8::StaticOrder S; S.init(MPAD, DM, 256, G, bx);
        pg8::EpiPool E{SGP, a.pool_scale};
        pg8::gemm_phase<pg8::EpiPool, pg8::StaticOrder, true, true>(lds, g, S, E);
    }
    __syncthreads();
    {
        pg8::Gemm g{BG, WCO, MPAD, DM, DM, DM, DM, 0}; pg8::StaticOrder S; S.init(MPAD, DM, DM, G, bx);
        pg8::EpiMerge E{SGC, SGP};
        pg8::gemm_phase<pg8::EpiMerge, pg8::StaticOrder, true, true>(lds, g, S, E);
        constexpr int FULL = (MPAD / 256) * (DM / 256) % 256;
        if (bx >= FULL) convert_items(a, ws, IT_W2G, IT_W2D, (bx - FULL) * NWAVES + wave, (G - FULL) * NWAVES, lds, wave, lane);
    }
    xcd_barrier(bar);
    {
        pg8::Gemm g{SGC, WO, MPAD, DM, DM, DM, DM, 0}; pg8::TailOrder S; S.init(DM, bx);
        pg8::EpiResid<false> E{H, DM, 1.0f, SLAB, nullptr, nullptr, nullptr};
        pg8::gemm_phase<pg8::EpiResid<false>, pg8::TailOrder, true, true>(lds, g, S, E);
    }
    xcd_barrier(bar);
    for (int m = gw; m < MPAD; m += NGW) { float* hr = H + (size_t)m * DM; if (m < 8192) rms_row_bf16(hr, a.norm_ffn2, XN + (size_t)m * DM, nullptr, lane); else rms_row_bf16(hr, a.norm_ffn2, XN + (size_t)m * DM, hr, lane, SLAB, 1.0f, m); }
    xcd_barrier(bar);
    {
        pg8::Gemm g{XN, W2GU, MPAD, 2 * DFF, DM, DM, DM, 0}; pg8::StaticOrder S; S.init(MPAD, 2 * DFF, DM, G, bx);
        pg8::EpiSwiglu E{ACT, DFF};
        pg8::gemm_phase<pg8::EpiSwiglu, pg8::StaticOrder, true, true>(lds, g, S, E);
        constexpr int FULL = (MPAD / 256) * (2 * DFF / 256) % 256;
        if (bx >= FULL) convert_items(a, ws, IT_W2D, IT_END, (bx - FULL) * NWAVES + wave, (G - FULL) * NWAVES, lds, wave, lane);
    }
    xcd_barrier(bar);
    {
        pg8::Gemm g{ACT, W2D, MPAD, DM, DFF, DFF, DFF, 0}; pg8::TailOrder S; S.init(DFF, bx);
        pg8::EpiResid<false> E{H, DM, 0.5f, SLAB, nullptr, nullptr, nullptr};
        pg8::gemm_phase<pg8::EpiResid<false>, pg8::TailOrder, true, true>(lds, g, S, E);
    }
    xcd_barrier(bar);
    for (int m = gw; m < MREAL; m += NGW) {
        float* dst;
        if (m < MP_ROWS) { const int b = m / LP, t = m - b * LP; if (t < NMETA) continue; dst = a.out + O_YP + ((size_t)b * SEQ + (t - NMETA)) * DM; }
        else dst = a.out + O_YS + (size_t)(m - MP_ROWS) * DM;
        const float* hr = H + (size_t)m * DM;
        f32x4 v[8]; float s = 0.f;
#pragma unroll
        for (int j = 0; j < 8; ++j) { v[j] = ((const f32x4*)hr)[lane + 64 * j]; if (m >= 8192) v[j] += slab_sum(SLAB, m, j, lane) * 0.5f; s += (v[j].x * v[j].x + v[j].y * v[j].y) + (v[j].z * v[j].z + v[j].w * v[j].w); }
        const float r = 1.0f / sqrtf(wave_sum(s) * (1.0f / DM) + EPS);
#pragma unroll
        for (int j = 0; j < 8; ++j) { const f32x4 gg = ((const f32x4*)a.norm_final)[lane + 64 * j]; ((f32x4*)dst)[lane + 64 * j] = v[j] * r * gg; }
    }
}

extern "C" void kernel_launch(void* const* d_in, const int* in_sizes, int n_in, void* d_out, int out_size, void* d_ws, size_t ws_size, hipStream_t stream) {
    static int grid = 0;
    if (grid == 0) {
        if (n_in != 21 || (size_t)out_size != O_END || ws_size < WS_END) { fprintf(stderr, "kernel_launch: unexpected shapes: n_in %d out %d ws %zu (need %zu)\n", n_in, out_size, ws_size, (size_t)WS_END); grid = -1; return; }
        int dev = 0, cus = 0, per_cu = 0;
        hipGetDevice(&dev); hipDeviceGetAttribute(&cus, hipDeviceAttributeMultiprocessorCount, dev);
        if (hipFuncSetAttribute((const void*)fwd_megakernel, hipFuncAttributeMaxDynamicSharedMemorySize, LDS_BYTES) != hipSuccess) { fprintf(stderr, "kernel_launch: hipFuncSetAttribute failed\n"); grid = -1; return; }
        if (hipOccupancyMaxActiveBlocksPerMultiprocessor(&per_cu, (const void*)fwd_megakernel, NWAVES * 64, LDS_BYTES) != hipSuccess || per_cu < 1) { fprintf(stderr, "kernel_launch: occupancy query failed (%d)\n", per_cu); (void)hipGetLastError(); per_cu = 1; }
        grid = cus * 1;
        fprintf(stderr, "kernel_launch: grid %d (cus %d, per_cu %d)\n", grid, cus, per_cu);
    }
    if (grid < 0) return;
    Args a{};
    a.x_prompt = (const float*)d_in[0]; a.x_sample = (const float*)d_in[1]; a.state_conv = (const float*)d_in[2]; a.state_pool = (const float*)d_in[3]; a.meta = (const float*)d_in[4];
    a.norm_ffn1 = (const float*)d_in[5]; a.w1g = (const float*)d_in[6]; a.w1u = (const float*)d_in[7]; a.w1d = (const float*)d_in[8]; a.norm_mix = (const float*)d_in[9]; a.w_in = (const float*)d_in[10];
    a.conv_w = (const float*)d_in[11]; a.w_conv_out = (const float*)d_in[12]; a.w_pool = (const float*)d_in[13]; a.pool_scale = (const float*)d_in[14]; a.w_o = (const float*)d_in[15];
    a.norm_ffn2 = (const float*)d_in[16]; a.w2g = (const float*)d_in[17]; a.w2u = (const float*)d_in[18]; a.w2d = (const float*)d_in[19]; a.norm_final = (const float*)d_in[20];
    a.out = (float*)d_out; a.ws = (unsigned char*)d_ws;
    void* args[] = {&a};
    hipError_t e = hipLaunchCooperativeKernel((const void*)fwd_megakernel, dim3(grid), dim3(NWAVES * 64), args, LDS_BYTES, stream);
    if (e != hipSuccess) fprintf(stderr, "kernel_launch: cooperative launch failed: %s (grid %d)\n", hipGetErrorString(e), grid);
}
```

```cpp
#include <hip/hip_runtime.h>
#include <hip/hip_cooperative_groups.h>
#include <cstdio>
#include <cstdint>
namespace cg = cooperative_groups;

namespace pg8 {
#define PG8_LAS __attribute__((address_space(3)))
typedef unsigned short bf16_t;
typedef short bf16x8 __attribute__((ext_vector_type(8)));
typedef float f32x4 __attribute__((ext_vector_type(4)));
typedef unsigned u32x4 __attribute__((ext_vector_type(4)));
constexpr int BM = 256, BK = 64, HALF = 128, HTB = HALF * BK * 2  , STAGE_BYTES = 8 * HTB, NXCD = 8, WGM = 8;

__host__ __device__ __forceinline__ int lds_byte(int r, int c) { const int st = (r >> 4) * 2 + (c >> 5), rr = r & 15, cc = c & 31, ob = rr * 64 + cc * 2; return st * 1024 + (ob ^ (((ob >> 9) & 1) << 5)); }
__host__ __device__ __forceinline__ void stage_rc(int b, int& R, int& C) { const int st = b / 1024, sb = b % 1024, swz = sb ^ (((sb >> 9) & 1) << 5); R = (st >> 1) * 16 + swz / 64; C = (st & 1) * 32 + (swz % 64) / 2; }
__host__ __device__ __forceinline__ int perm32(int rho) { const int n = rho >> 4, i = rho & 15; return 8 * (i >> 2) + 4 * n + (i & 3); }

struct Unit { int pm, pn, kt0, nkt, slab; };
struct Gemm { const bf16_t* A; const bf16_t* Bt; int M, N, K, lda, ldb, agrp; };
__device__ __forceinline__ size_t acolb(const Gemm& g, const Unit& u) { return g.agrp ? (size_t)((u.pn >> 1) * 256) * 2 : (size_t)0; }

struct StaticOrder {
    int nM, nN, nwg, G, c, nt;
    __host__ __device__ void init(int M, int N, int K, int G_, int c_) { nM = M / BM; nN = N / BM; nwg = nM * nN; G = G_; c = c_; nt = K / BK; }
    __host__ __device__ bool next(int i, Unit& u) const {
        const long L = (long)i * G + c; if (L >= nwg) return false;
        int wgid = (int)L; { const int q = nwg / NXCD, r = nwg % NXCD, xcd = wgid % NXCD, off = wgid / NXCD; wgid = (xcd < r ? xcd * (q + 1) : r * (q + 1) + (xcd - r) * q) + off; }
        const int nig = WGM * nN, gid = wgid / nig, fm = gid * WGM, gsz = (nM - fm) < WGM ? (nM - fm) : WGM;
        u.pm = fm + ((wgid % nig) % gsz); u.pn = (wgid % nig) / gsz; u.kt0 = 0; u.nkt = nt; u.slab = -1; return true;
    }
    __device__ __forceinline__ void a_ready(const Unit&) const {}
    __device__ __forceinline__ void done(const Unit&) const {}
};
struct TailOrder {
    int c, nt;
    __host__ __device__ void init(int K, int c_) { c = c_; nt = K / BK; }
    __host__ __device__ bool next(int i, Unit& u) const {
        if (i == 0) { const int x = c & 7, idx = c >> 3; u.pm = 4 * x + (idx >> 3); u.pn = idx & 7; u.kt0 = 0; u.nkt = nt; u.slab = -1; return true; }
        if (i == 1 && c < 240) {
            const int x = c & 7, idx = c >> 3, q = idx / 6, r6 = idx - 6 * q, ch = x < 6 ? x : r6, pn = x < 6 ? r6 : x;
            const int np = nt >> 1, base = np / 6, rem = np % 6, p0 = ch * base + (ch < rem ? ch : rem), pc = base + (ch < rem ? 1 : 0);
            u.pm = 32 + q; u.pn = pn; u.kt0 = 2 * p0; u.nkt = 2 * pc; u.slab = (q * 8 + pn) * 6 + ch; return true; }
        return false;
    }
    __device__ __forceinline__ void a_ready(const Unit&) const {}
    __device__ __forceinline__ void done(const Unit&) const {}
};

__device__ __forceinline__ unsigned cvt_pk_bf16(float lo, float hi) { unsigned r; asm volatile("v_cvt_pk_bf16_f32 %0, %1, %2" : "=v"(r) : "v"(lo), "v"(hi)); return r; }
__device__ __forceinline__ float bf_lo(unsigned w) { return __uint_as_float(w << 16); }
__device__ __forceinline__ float bf_hi(unsigned w) { return __uint_as_float(w & 0xffff0000u); }
__device__ __forceinline__ float sigmoidf_(float x) { return __builtin_amdgcn_rcpf(1.0f + __builtin_amdgcn_exp2f(-1.4426950408889634f * x)); }
__device__ __forceinline__ u32x4 pack8(const f32x4& a, const f32x4& b) { u32x4 w; w.x = cvt_pk_bf16(a[0], a[1]); w.y = cvt_pk_bf16(a[2], a[3]); w.z = cvt_pk_bf16(b[0], b[1]); w.w = cvt_pk_bf16(b[2], b[3]); return w; }
__device__ __forceinline__ void unpack8(const u32x4& w, f32x4& a, f32x4& b) { a = (f32x4){bf_lo(w.x), bf_hi(w.x), bf_lo(w.y), bf_hi(w.y)}; b = (f32x4){bf_lo(w.z), bf_hi(w.z), bf_lo(w.w), bf_hi(w.w)}; }

struct EpiSwiglu {
    static constexpr bool PERM = true, AFTER_DRAIN = false;
    bf16_t* O; int ldc;
    __device__ __forceinline__ void operator()(const f32x4 (&acc)[2][2][4][2], const Unit& u, int wr, int wc, int fr, int fq) const {
        const int row0 = u.pm * BM + wr * 64 + fr, col0 = u.pn * HALF + wc * 32 + 8 * fq;
#pragma unroll
        for (int ai = 0; ai < 2; ++ai)
#pragma unroll
            for (int m = 0; m < 4; ++m) {
                f32x4 v[2];
#pragma unroll
                for (int n = 0; n < 2; ++n) { const f32x4 gt = acc[ai][0][m][n], up = acc[ai][1][m][n];
#pragma unroll
                    for (int e = 0; e < 4; ++e) v[n][e] = gt[e] * sigmoidf_(gt[e]) * up[e]; }
                *(u32x4*)(O + (size_t)(row0 + ai * HALF + m * 16) * ldc + col0) = pack8(v[0], v[1]);
            }
    }
};
template <bool FROMX> struct EpiResid {
    static constexpr bool PERM = true, AFTER_DRAIN = false;
    float* H; int ldc; float s; float* SL;
    const float *xp, *xs, *meta;
    __device__ __forceinline__ void operator()(const f32x4 (&acc)[2][2][4][2], const Unit& u, int wr, int wc, int fr, int fq) const {
        if (u.slab >= 0) {
            bf16_t* base = (bf16_t*)SL + (size_t)u.slab * (BM * BM) + (size_t)(wr * 64 + fr) * BM + wc * 32 + 8 * fq;
#pragma unroll
            for (int ai = 0; ai < 2; ++ai)
#pragma unroll
                for (int m = 0; m < 4; ++m)
#pragma unroll
                    for (int bj = 0; bj < 2; ++bj) *(u32x4*)(base + (size_t)(ai * HALF + m * 16) * BM + bj * HALF) = pack8(acc[ai][bj][m][0], acc[ai][bj][m][1]);
            return;
        }
        const int row0 = u.pm * BM + wr * 64 + fr, col0 = u.pn * BM + wc * 32 + 8 * fq;
#pragma unroll
        for (int ai = 0; ai < 2; ++ai)
#pragma unroll
            for (int m = 0; m < 4; ++m) { const int r = row0 + ai * HALF + m * 16; float* rowp = H + (size_t)r * ldc + col0;
                const float* srcp = rowp;
                if (FROMX) {
                    const int b = r / 2064, t = r - b * 2064;
                    srcp = (t < 16 ? meta + (size_t)t * 2048 : xp + ((size_t)b * 2048 + (t - 16)) * 2048) + col0;
                }
#pragma unroll
                for (int bj = 0; bj < 2; ++bj)
#pragma unroll
                    for (int n = 0; n < 2; ++n) { const f32x4 h = *(const f32x4*)(srcp + bj * HALF + n * 4); *(f32x4*)(rowp + bj * HALF + n * 4) = h + acc[ai][bj][m][n] * s; }
                if (m & 1) asm volatile("" ::: "memory"); }
    }
};
struct EpiProj {
    static constexpr bool PERM = true, AFTER_DRAIN = false;
    bf16_t *BG, *CV, *Z, *SGC, *SGP;
    __device__ __forceinline__ void operator()(const f32x4 (&acc)[2][2][4][2], const Unit& u, int wr, int wc, int fr, int fq) const {
        const int row0 = u.pm * BM + wr * 64 + fr, pn = u.pn;
        if (pn >= 8 && pn < 24) {
            const int col0 = (pn - 8) * HALF + wc * 32 + 8 * fq;
#pragma unroll
            for (int ai = 0; ai < 2; ++ai)
#pragma unroll
                for (int m = 0; m < 4; ++m)
                    *(u32x4*)(CV + (size_t)(row0 + ai * HALF + m * 16) * 2048 + col0) = pack8(acc[ai][0][m][0] * acc[ai][1][m][0], acc[ai][0][m][1] * acc[ai][1][m][1]);
        } else {
            bf16_t* base; int ld, ct; bool sg;
            if (pn < 8) { base = BG; ld = 2048; ct = pn; sg = false; }
            else if (pn < 28) { base = Z; ld = 1024; ct = pn - 24; sg = false; }
            else if (pn < 36) { base = SGC; ld = 2048; ct = pn - 28; sg = true; }
            else { base = SGP; ld = 2048; ct = pn - 36; sg = true; }
            const int col0 = ct * BM + wc * 32 + 8 * fq;
#pragma unroll
            for (int ai = 0; ai < 2; ++ai)
#pragma unroll
                for (int m = 0; m < 4; ++m) { bf16_t* rowp = base + (size_t)(row0 + ai * HALF + m * 16) * ld + col0;
#pragma unroll
                    for (int bj = 0; bj < 2; ++bj) { f32x4 v0 = acc[ai][bj][m][0], v1 = acc[ai][bj][m][1];
                        if (sg) {
#pragma unroll
                            for (int e = 0; e < 4; ++e) { v0[e] = sigmoidf_(v0[e]); v1[e] = sigmoidf_(v1[e]); } }
                        *(u32x4*)(rowp + bj * HALF) = pack8(v0, v1); } }
        }
    }
};
struct EpiPool {
    static constexpr bool PERM = true, AFTER_DRAIN = false;
    bf16_t* SGP; const float* ps;
    __device__ __forceinline__ void operator()(const f32x4 (&acc)[2][2][4][2], const Unit& u, int wr, int wc, int fr, int fq) const {
        const int row0 = u.pm * BM + wr * 64 + fr, col0 = u.pn * BM + wc * 32 + 8 * fq;
#pragma unroll
        for (int ai = 0; ai < 2; ++ai)
#pragma unroll
            for (int m = 0; m < 4; ++m) { bf16_t* rowp = SGP + (size_t)(row0 + ai * HALF + m * 16) * 2048 + col0;
#pragma unroll
                for (int bj = 0; bj < 2; ++bj) { u32x4* p = (u32x4*)(rowp + bj * HALF); f32x4 g0, g1; unpack8(*p, g0, g1);
                    const f32x4 s0 = *(const f32x4*)(ps + col0 + bj * HALF), s1 = *(const f32x4*)(ps + col0 + bj * HALF + 4);
                    *p = pack8(g0 * s0 * acc[ai][bj][m][0], g1 * s1 * acc[ai][bj][m][1]); }
                asm volatile("" ::: "memory"); }
    }
};
struct EpiMerge {
    static constexpr bool PERM = true, AFTER_DRAIN = false;
    bf16_t* SGC; const bf16_t* MP;
    __device__ __forceinline__ void operator()(const f32x4 (&acc)[2][2][4][2], const Unit& u, int wr, int wc, int fr, int fq) const {
        const int row0 = u.pm * BM + wr * 64 + fr, col0 = u.pn * BM + wc * 32 + 8 * fq;
#pragma unroll
        for (int ai = 0; ai < 2; ++ai)
#pragma unroll
            for (int m = 0; m < 4; ++m) { const size_t off = (size_t)(row0 + ai * HALF + m * 16) * 2048 + col0;
#pragma unroll
                for (int bj = 0; bj < 2; ++bj) { u32x4* p = (u32x4*)(SGC + off + bj * HALF); f32x4 g0, g1, q0, q1; unpack8(*p, g0, g1); unpack8(*(const u32x4*)(MP + off + bj * HALF), q0, q1);
                    *p = pack8(g0 * acc[ai][bj][m][0] + q0, g1 * acc[ai][bj][m][1] + q1); }
                if (m & 1) asm volatile("" ::: "memory"); }
    }
};

template <class Epi, class Sched, bool ALIGN_EPI = false, bool SP2 = false>
__device__ __forceinline__ void gemm_phase(PG8_LAS unsigned char* lds, const Gemm g, const Sched& S, const Epi& E) {
    int tid_ = threadIdx.x; asm volatile("" : "+v"(tid_));
    const int tid = tid_, wid = __builtin_amdgcn_readfirstlane(tid >> 6), lane = tid & 63, wr = wid >> 2, wc = wid & 3, fr = lane & 15, fq = lane >> 4;

    unsigned voffA[2], voffB[2];
#pragma unroll
    for (int i = 0; i < 2; ++i) { int R, C; stage_rc(tid * 16 + i * 8192, R, C); const int Rb = Epi::PERM ? ((R & ~31) + perm32(R & 31)) : R;
        voffA[i] = (unsigned)(R * g.lda + C) * 2u; voffB[i] = (unsigned)(Rb * g.ldb + C) * 2u; }
    const size_t kstep = (size_t)(BK * 2);
    const size_t hstepA = (size_t)HALF * g.lda * 2, hstepB = (size_t)HALF * g.ldb * 2;
    const size_t tstepA = 2 * hstepA, tstepB = 2 * hstepB;
    const unsigned ldsw = (unsigned)wid * 1024u;
    const int aoff = lds_byte(wr * 64 + fr, fq * 8), boff = lds_byte(wc * 32 + fr, fq * 8);
#define PG8_SA(b, h) (((b) * 2 + (h)) * HTB)
#define PG8_SB(b, h) ((4 + (b) * 2 + (h)) * HTB)
#define PG8_STAGE(bufoff, gbase, voff) do { _Pragma("unroll") for (int _i = 0; _i < 2; ++_i) \
        __builtin_amdgcn_global_load_lds((const unsigned*)((const char*)(gbase) + (voff)[_i]), (PG8_LAS unsigned*)(lds + (bufoff) + ldsw + _i * 8192), 16, 0, 0); } while (0)
#define PG8_LDA(dst, b, h) do { _Pragma("unroll") for (int m = 0; m < 4; ++m) _Pragma("unroll") for (int k = 0; k < 2; ++k) dst[m][k] = *(const PG8_LAS bf16x8*)(lds + PG8_SA(b, h) + aoff + m * 2048 + k * 1024); } while (0)
#define PG8_LDB(dst, b, h) do { _Pragma("unroll") for (int n = 0; n < 2; ++n) _Pragma("unroll") for (int k = 0; k < 2; ++k) dst[n][k] = *(const PG8_LAS bf16x8*)(lds + PG8_SB(b, h) + boff + n * 2048 + k * 1024); } while (0)
#define PG8_MMA(ai, bj, At, Bt) do { __builtin_amdgcn_s_setprio(1); _Pragma("unroll") for (int m = 0; m < 4; ++m) _Pragma("unroll") for (int n = 0; n < 2; ++n) _Pragma("unroll") for (int k = 0; k < 2; ++k) \
        acc[ai][bj][m][n] = __builtin_amdgcn_mfma_f32_16x16x32_bf16(Bt[n][k], At[m][k], acc[ai][bj][m][n], 0, 0, 0); __builtin_amdgcn_s_setprio(0); } while (0)
#define PG8_WAIT_V(n) asm volatile("s_waitcnt vmcnt(" #n ")" ::: "memory")
#define PG8_WAIT_L(n) asm volatile("s_waitcnt lgkmcnt(" #n ")" ::: "memory")
#define PG8_BAR __builtin_amdgcn_s_barrier()
#define PG8_SCHED __builtin_amdgcn_sched_barrier(0)
    Unit cur, nxt; int ui = 0;
    if (!S.next(0, cur)) return;
    f32x4 acc[2][2][4][2];
#pragma unroll
    for (int a = 0; a < 2; ++a)
#pragma unroll
        for (int b = 0; b < 2; ++b)
#pragma unroll
            for (int m = 0; m < 4; ++m)
#pragma unroll
                for (int n = 0; n < 2; ++n) acc[a][b][m][n] = (f32x4){0.f, 0.f, 0.f, 0.f};
    bf16x8 At[4][2], B0[2][2], B1[2][2];
    const char* cA = (const char*)g.A + (size_t)cur.pm * tstepA + acolb(g, cur) + (size_t)cur.kt0 * kstep; const char* cB = (const char*)g.Bt + (size_t)cur.pn * tstepB + (size_t)cur.kt0 * kstep;
    S.a_ready(cur);
    if constexpr (SP2) {
        PG8_STAGE(PG8_SB(0, 0), cB, voffB); PG8_STAGE(PG8_SB(0, 1), cB + hstepB, voffB); PG8_STAGE(PG8_SA(0, 0), cA, voffA); PG8_STAGE(PG8_SA(0, 1), cA + hstepA, voffA);
        if (wr == 1) PG8_BAR;
        PG8_WAIT_V(2); PG8_BAR;
        PG8_STAGE(PG8_SB(1, 0), cB + kstep, voffB); PG8_STAGE(PG8_SA(1, 0), cA + kstep, voffA); PG8_STAGE(PG8_SB(1, 1), cB + hstepB + kstep, voffB);
        PG8_WAIT_V(6); PG8_BAR;
    } else {
        PG8_STAGE(PG8_SB(0, 0), cB, voffB); PG8_STAGE(PG8_SA(0, 0), cA, voffA); PG8_STAGE(PG8_SB(0, 1), cB + hstepB, voffB); PG8_STAGE(PG8_SA(0, 1), cA + hstepA, voffA);
        if (wr == 1) PG8_BAR;
        PG8_WAIT_V(4); PG8_BAR;
        PG8_STAGE(PG8_SB(1, 0), cB + kstep, voffB); PG8_STAGE(PG8_SA(1, 0), cA + kstep, voffA); PG8_STAGE(PG8_SB(1, 1), cB + hstepB + kstep, voffB);
        PG8_WAIT_V(6); PG8_BAR;
    }
    for (;;) {
        const bool has_next = S.next(ui + 1, nxt);
        const char* nA = has_next ? (const char*)g.A + (size_t)nxt.pm * tstepA + acolb(g, nxt) + (size_t)nxt.kt0 * kstep : cA; const char* nB = has_next ? (const char*)g.Bt + (size_t)nxt.pn * tstepB + (size_t)nxt.kt0 * kstep : cB;
        const int nt = cur.nkt;
        for (int t = 0; t < nt; t += 2) {
            const bool last = (t == nt - 2);
            const char* a1 = cA + (size_t)(t + 1) * kstep;
            const char* a2 = last ? nA : cA + (size_t)(t + 2) * kstep; const char* b2 = last ? nB : cB + (size_t)(t + 2) * kstep;
            const char* a3 = a2 + kstep; const char* b3 = b2 + kstep;
            if (last && has_next) S.a_ready(nxt);
            if constexpr (SP2) {
            PG8_LDB(B0, 0, 0); PG8_LDB(B1, 0, 1); PG8_SCHED; PG8_LDA(At, 0, 0); PG8_STAGE(PG8_SA(1, 1), a1 + hstepA, voffA);
            PG8_WAIT_V(8); PG8_WAIT_L(0); PG8_BAR; PG8_MMA(0, 0, At, B0); PG8_MMA(0, 1, At, B1); PG8_BAR; PG8_SCHED;
            PG8_LDA(At, 0, 1); PG8_STAGE(PG8_SB(0, 0), b2, voffB); PG8_STAGE(PG8_SB(0, 1), b2 + hstepB, voffB); PG8_STAGE(PG8_SA(0, 0), a2, voffA);
            PG8_WAIT_V(8); PG8_WAIT_L(0); PG8_BAR; PG8_MMA(1, 0, At, B0); PG8_MMA(1, 1, At, B1); PG8_BAR; PG8_SCHED;
            PG8_LDB(B0, 1, 0); PG8_LDB(B1, 1, 1); PG8_SCHED; PG8_LDA(At, 1, 0); PG8_STAGE(PG8_SA(0, 1), a2 + hstepA, voffA);
            PG8_WAIT_V(8); PG8_WAIT_L(0); PG8_BAR; PG8_MMA(0, 0, At, B0); PG8_MMA(0, 1, At, B1); PG8_BAR; PG8_SCHED;
            PG8_LDA(At, 1, 1); PG8_STAGE(PG8_SB(1, 0), b3, voffB); PG8_STAGE(PG8_SB(1, 1), b3 + hstepB, voffB); PG8_STAGE(PG8_SA(1, 0), a3, voffA);
            PG8_WAIT_V(8); PG8_WAIT_L(0); PG8_BAR; PG8_MMA(1, 0, At, B0); PG8_MMA(1, 1, At, B1); PG8_BAR; PG8_SCHED;
            } else {
            PG8_LDB(B0, 0, 0); PG8_SCHED; PG8_LDA(At, 0, 0); PG8_STAGE(PG8_SA(1, 1), a1 + hstepA, voffA);
            PG8_WAIT_L(8); PG8_BAR; PG8_WAIT_L(0); PG8_MMA(0, 0, At, B0); PG8_BAR; PG8_SCHED;
            PG8_LDB(B1, 0, 1); PG8_STAGE(PG8_SB(0, 0), b2, voffB);
            PG8_BAR; PG8_WAIT_L(0); PG8_MMA(0, 1, At, B1); PG8_BAR;
            PG8_LDA(At, 0, 1); PG8_STAGE(PG8_SA(0, 0), a2, voffA);
            PG8_BAR; PG8_WAIT_L(0); PG8_MMA(1, 0, At, B0); PG8_BAR; PG8_SCHED;
            PG8_STAGE(PG8_SB(0, 1), b2 + hstepB, voffB);
            PG8_WAIT_V(6); PG8_BAR; PG8_MMA(1, 1, At, B1); PG8_BAR;
            PG8_LDB(B0, 1, 0); PG8_SCHED; PG8_LDA(At, 1, 0); PG8_STAGE(PG8_SA(0, 1), a2 + hstepA, voffA);
            PG8_WAIT_L(8); PG8_BAR; PG8_WAIT_L(0); PG8_MMA(0, 0, At, B0); PG8_BAR; PG8_SCHED;
            PG8_LDB(B1, 1, 1); PG8_STAGE(PG8_SB(1, 0), b3, voffB);
            PG8_BAR; PG8_WAIT_L(0); PG8_MMA(0, 1, At, B1); PG8_BAR;
            PG8_LDA(At, 1, 1); PG8_STAGE(PG8_SA(1, 0), a3, voffA);
            PG8_BAR; PG8_WAIT_L(0); PG8_MMA(1, 0, At, B0); PG8_BAR; PG8_SCHED;
            PG8_STAGE(PG8_SB(1, 1), b3 + hstepB, voffB);
            PG8_WAIT_V(6); PG8_BAR; PG8_MMA(1, 1, At, B1); PG8_BAR;
            }
        }
        if constexpr (ALIGN_EPI) { if (wr == 0) PG8_BAR; }
        if constexpr (!Epi::AFTER_DRAIN) { E(acc, cur, wr, wc, fr, fq); S.done(cur); }
        if (!has_next) break;
#pragma unroll
        for (int a = 0; a < 2; ++a)
#pragma unroll
            for (int b = 0; b < 2; ++b)
#pragma unroll
                for (int m = 0; m < 4; ++m)
#pragma unroll
                    for (int n = 0; n < 2; ++n) acc[a][b][m][n] = (f32x4){0.f, 0.f, 0.f, 0.f};
        cur = nxt; cA = nA; cB = nB; ++ui;
        if constexpr (ALIGN_EPI) { if (wr == 1) PG8_BAR; }
    }
    PG8_WAIT_V(0);
    if constexpr (!ALIGN_EPI) { if (wr == 0) PG8_BAR; }
    PG8_BAR;
    if constexpr (Epi::AFTER_DRAIN) { E.fused(acc, cur, wr, wc, fr, fq, lds, wid, lane); S.done(cur); }
#undef PG8_SA
#undef PG8_SB
#undef PG8_STAGE
#undef PG8_LDA
#undef PG8_LDB
#undef PG8_MMA
#undef PG8_WAIT_V
#undef PG8_WAIT_L
#undef PG8_BAR
#undef PG8_SCHED
}
}

constexpr int DM = 2048, NB = 4, SEQ = 2048, NMETA = 16, LP = SEQ + NMETA  , DECB = 128, DECS = 8;
constexpr int DFF = 5632, DPOOL = 1024, DIN = 11264;
constexpr int MP_ROWS = NB * LP;
constexpr int MS_ROWS = DECB * DECS;
constexpr int MREAL = MP_ROWS + MS_ROWS;
constexpr int MPAD = 9472;
constexpr float EPS = 1e-6f;
constexpr int NWAVES = 8;

constexpr size_t O_YP = 0, O_YS = O_YP + (size_t)NB * SEQ * DM, O_NCP = O_YS + (size_t)MS_ROWS * DM, O_NPP = O_NCP + (size_t)NB * 2 * DM,
                 O_NCS = O_NPP + (size_t)NB * 15 * DPOOL, O_NPS = O_NCS + (size_t)DECB * 2 * DM, O_END = O_NPS + (size_t)DECB * 15 * DPOOL;

constexpr size_t MiB = 1u << 20;
constexpr size_t WS_W1GU = 1 * MiB;
constexpr size_t WS_W1D = WS_W1GU + 44 * MiB;
constexpr size_t WS_WIN = WS_W1D + 22 * MiB;
constexpr size_t WS_WCO = WS_WIN + 44 * MiB;
constexpr size_t WS_WPG = WS_WCO + 8 * MiB;
constexpr size_t WS_WO = WS_WPG + 1 * MiB;
constexpr size_t WS_W2GU = WS_WO + 8 * MiB;
constexpr size_t WS_W2D = WS_W2GU + 44 * MiB;
constexpr size_t WS_H = WS_W2D + 22 * MiB;
constexpr size_t WS_R = WS_H + 74 * MiB;
constexpr size_t WS_BG = WS_R, WS_CV = WS_R + 37 * MiB, WS_SGC = WS_R + 74 * MiB, WS_SGP = WS_R + 111 * MiB, WS_Z = WS_R + 148 * MiB, WS_PL = WS_Z + 19 * MiB;
constexpr size_t WS_XN1 = WS_SGP;
constexpr size_t WS_END = WS_PL + 19 * MiB;
static_assert((size_t)MPAD * DFF * 2 <= 111 * MiB, "ACT fits below XN1");

#define GAS __attribute__((address_space(1)))
#define LAS __attribute__((address_space(3)))
typedef unsigned short bf16;
typedef unsigned v4u __attribute__((ext_vector_type(4)));
typedef float f32x4 __attribute__((ext_vector_type(4)));
#define LDS_WAIT() asm volatile("s_waitcnt lgkmcnt(0)" ::: "memory")
constexpr int LDS_BYTES = 147456;

struct Args {
    const float *x_prompt, *x_sample, *state_conv, *state_pool, *meta, *norm_ffn1, *w1g, *w1u, *w1d, *norm_mix, *w_in, *conv_w, *w_conv_out, *w_pool, *pool_scale, *w_o, *norm_ffn2, *w2g, *w2u, *w2d, *norm_final;
    float* out; unsigned char* ws;
};

__device__ __forceinline__ unsigned pk2(float lo, float hi) { return pg8::cvt_pk_bf16(lo, hi); }
__device__ __forceinline__ float wave_sum(float v) {
#pragma unroll
    for (int o = 1; o < 64; o <<= 1) v += __shfl_xor(v, o);
    return v;
}
__device__ __forceinline__ const float* src_row(const Args& a, int r) {
    if (r < MP_ROWS) { const int b = r / LP, t = r - b * LP; return t < NMETA ? a.meta + (size_t)t * DM : a.x_prompt + ((size_t)b * SEQ + (t - NMETA)) * DM; }
    if (r < MREAL) return a.x_sample + (size_t)(r - MP_ROWS) * DM;
    return nullptr;
}
__device__ __forceinline__ void p0_transpose_item(const float* W, int N, bf16* WT, int K, int k0, int n0, int drow0, LAS float* scr, int lane) {
    const int lr = lane >> 4, lc = (lane & 15) * 4;
    f32x4 v[16];
#pragma unroll
    for (int i = 0; i < 16; ++i) v[i] = *(const f32x4*)(W + (size_t)(k0 + 4 * i + lr) * N + n0 + lc);
#pragma unroll
    for (int i = 0; i < 16; ++i) { LAS float* s = scr + (4 * i + lr) * 65 + lc; s[0] = v[i].x; s[1] = v[i].y; s[2] = v[i].z; s[3] = v[i].w; }
    LDS_WAIT(); asm volatile("" ::: "memory");
    const int c = lane & 7;
#pragma unroll
    for (int j = 0; j < 8; ++j) { const int n = (lane >> 3) + 8 * j; const LAS float* s = scr + (8 * c) * 65 + n;
        v4u o; o.x = pk2(s[0 * 65], s[1 * 65]); o.y = pk2(s[2 * 65], s[3 * 65]); o.z = pk2(s[4 * 65], s[5 * 65]); o.w = pk2(s[6 * 65], s[7 * 65]);
        *(v4u*)(WT + (size_t)(drow0 + n) * K + k0 + 8 * c) = o; }
    LDS_WAIT(); asm volatile("" ::: "memory");
}
__device__ __forceinline__ bool p0_job(int& r, const float* W, int K, int N, bf16* WT, int kind, int roff, LAS float* scr, int lane) {
    const int nb = N / 64, items = (K / 64) * nb;
    if (r >= items) { r -= items; return false; }
    const int kb = r / nb, n0 = (r % nb) * 64;
    int d;
    if (kind == 0) d = roff + n0;
    else if (kind == 1) d = (n0 >> 7) * 256 + (n0 & 127);
    else if (kind == 2) d = (n0 >> 7) * 256 + 128 + (n0 & 127);
    else { if (n0 < 2048 || n0 >= 6144) d = n0; else if (n0 < 4096) { const int j = n0 - 2048; d = 2048 + (j >> 7) * 256 + (j & 127); } else { const int j = n0 - 4096; d = 2048 + (j >> 7) * 256 + 128 + (j & 127); } }
    p0_transpose_item(W, N, WT, K, kb * 64, n0, d, scr, lane);
    return true;
}
__device__ __forceinline__ f32x4 slab_sum(const float* SL, int m, int j, int lane) {
    typedef unsigned u32x2 __attribute__((ext_vector_type(2)));
    const bf16* p = (const bf16*)SL + (size_t)(((m >> 8) - 32) * 8 + j) * 6 * 65536 + (size_t)(m & 255) * 256 + 4 * lane;
    f32x4 a = (f32x4){0.f, 0.f, 0.f, 0.f};
#pragma unroll
    for (int ch = 0; ch < 6; ++ch) { const u32x2 w = *(const u32x2*)(p + (size_t)ch * 65536); a += (f32x4){pg8::bf_lo(w.x), pg8::bf_hi(w.x), pg8::bf_lo(w.y), pg8::bf_hi(w.y)}; }
    return a;
}
__device__ __forceinline__ void rms_row_bf16(const float* xrow, const float* g, bf16* orow, float* hout, int lane, const float* SL = nullptr, float sc = 0.f, int m = 0) {
    f32x4 v[8]; float s = 0.f;
    const bool red = SL && m >= 8192;
#pragma unroll
    for (int j = 0; j < 8; ++j) {
        v[j] = xrow ? ((const f32x4*)xrow)[lane + 64 * j] : (f32x4){0.f, 0.f, 0.f, 0.f};
        if (red) v[j] += slab_sum(SL, m, j, lane) * sc;
        s += (v[j].x * v[j].x + v[j].y * v[j].y) + (v[j].z * v[j].z + v[j].w * v[j].w);
    }
    const float r = 1.0f / sqrtf(wave_sum(s) * (1.0f / DM) + EPS);
#pragma unroll
    for (int j = 0; j < 8; ++j) {
        if (hout) ((f32x4*)hout)[lane + 64 * j] = v[j];
        const f32x4 gg = ((const f32x4*)g)[lane + 64 * j];
        const unsigned lo = pk2(v[j].x * r * gg.x, v[j].y * r * gg.y), hi = pk2(v[j].z * r * gg.z, v[j].w * r * gg.w);
        ((unsigned long long*)orow)[lane + 64 * j] = (unsigned long long)lo | ((unsigned long long)hi << 32);
    }
}
__device__ __forceinline__ void load8_bf16(const bf16* p, float (&o)[8]) { const v4u w = *(const v4u*)p; o[0] = pg8::bf_lo(w.x); o[1] = pg8::bf_hi(w.x); o[2] = pg8::bf_lo(w.y); o[3] = pg8::bf_hi(w.y); o[4] = pg8::bf_lo(w.z); o[5] = pg8::bf_hi(w.z); o[6] = pg8::bf_lo(w.w); o[7] = pg8::bf_hi(w.w); }
__device__ __forceinline__ void load8_f32(const float* p, float (&o)[8]) { const f32x4 a = ((const f32x4*)p)[0], b = ((const f32x4*)p)[1]; o[0] = a.x; o[1] = a.y; o[2] = a.z; o[3] = a.w; o[4] = b.x; o[5] = b.y; o[6] = b.z; o[7] = b.w; }
__device__ __forceinline__ void store8_f32(float* p, const float (&o)[8]) { ((f32x4*)p)[0] = (f32x4){o[0], o[1], o[2], o[3]}; ((f32x4*)p)[1] = (f32x4){o[4], o[5], o[6], o[7]}; }


__device__ __forceinline__ void acc8_bf16(const v4u& w, float msk, float (&s)[8]) {
    s[0] += msk * pg8::bf_lo(w.x); s[1] += msk * pg8::bf_hi(w.x); s[2] += msk * pg8::bf_lo(w.y); s[3] += msk * pg8::bf_hi(w.y);
    s[4] += msk * pg8::bf_lo(w.z); s[5] += msk * pg8::bf_hi(w.z); s[6] += msk * pg8::bf_lo(w.w); s[7] += msk * pg8::bf_hi(w.w);
}
template <bool SMP>
__device__ __forceinline__ void p3b_row(const Args& a, int m, int lane, bf16* BG, const bf16* CV, const bf16* Z, bf16* PL) {
    int sq, t;
    if (SMP) { sq = (m - MP_ROWS) >> 3; t = (m - MP_ROWS) & 7; } else { sq = m / LP; t = m - sq * LP; }
    constexpr int L = SMP ? DECS : LP;
    const float* sc = a.state_conv + (size_t)sq * 2 * DM;
    const float* sp = a.state_pool + (size_t)sq * 15 * DPOOL;
    float* ncv = (t >= L - 2) ? a.out + (SMP ? O_NCS : O_NCP) + ((size_t)sq * 2 + (t - (L - 2))) * DM : nullptr;
    const float m1 = t >= 1 ? 1.f : 0.f, m2 = t >= 2 ? 1.f : 0.f;
    const int r1 = t >= 1 ? m - 1 : m, r2 = t >= 2 ? m - 2 : m;
#pragma unroll 2
    for (int j = 0; j < 4; ++j) {
        const int col = 512 * j + 8 * lane;
        float c0[8], c1[8], c2[8], bg[8], w0[8], w1[8], w2[8], o[8];
        load8_bf16(CV + (size_t)m * DM + col, c2); load8_bf16(CV + (size_t)r1 * DM + col, c1); load8_bf16(CV + (size_t)r2 * DM + col, c0);
        load8_bf16(BG + (size_t)m * DM + col, bg);
        load8_f32(a.conv_w + col, w0); load8_f32(a.conv_w + DM + col, w1); load8_f32(a.conv_w + 2 * DM + col, w2);
#pragma unroll
        for (int e = 0; e < 8; ++e) { c1[e] *= m1; c0[e] *= m2; }
        if (SMP) {
            float s1[8], s0[8];
            load8_f32(sc + (size_t)DM + col, s1); load8_f32(sc + (size_t)(t == 1 ? DM : 0) + col, s0);
#pragma unroll
            for (int e = 0; e < 8; ++e) { c1[e] += (1.f - m1) * s1[e]; c0[e] += (1.f - m2) * s0[e]; }
        }
#pragma unroll
        for (int e = 0; e < 8; ++e) o[e] = bg[e] * (w0[e] * c0[e] + w1[e] * c1[e] + w2[e] * c2[e]);
        v4u w; w.x = pk2(o[0], o[1]); w.y = pk2(o[2], o[3]); w.z = pk2(o[4], o[5]); w.w = pk2(o[6], o[7]);
        *(v4u*)(BG + (size_t)m * DM + col) = w;
        if (ncv) store8_f32(ncv + col, c2);
    }
    float* npp = nullptr;
    if (SMP) npp = a.out + O_NPS + ((size_t)sq * 15 + 7 + t) * DPOOL; else if (t >= L - 15) npp = a.out + O_NPP + ((size_t)sq * 15 + (t - (L - 15))) * DPOOL;
#pragma unroll
    for (int j = 0; j < 2; ++j) {
        const int col = 512 * j + 8 * lane, gq = col >> 8, k = 2 << gq;
        float z0[8], s[8];
        load8_bf16(Z + (size_t)m * DPOOL + col, z0);
#pragma unroll
        for (int e = 0; e < 8; ++e) s[e] = z0[e];
        if (j == 0) {
#pragma unroll
            for (int i = 1; i < 4; ++i) { const bool in = t - i >= 0; const v4u w = *(const v4u*)(Z + (size_t)(in ? m - i : m) * DPOOL + col); acc8_bf16(w, (in && i < k) ? 1.f : 0.f, s); }
            if (SMP) {
#pragma unroll
                for (int i = 1; i < 4; ++i) { const bool st = t - i < 0; float q[8]; load8_f32(sp + (size_t)(st ? 15 + t - i : 0) * DPOOL + col, q); const float mk = (st && i < k) ? 1.f : 0.f;
#pragma unroll
                    for (int e = 0; e < 8; ++e) s[e] += mk * q[e]; }
            }
        } else {
#pragma unroll
            for (int i = 1; i < 16; ++i) { const bool in = t - i >= 0; const v4u w = *(const v4u*)(Z + (size_t)(in ? m - i : m) * DPOOL + col); acc8_bf16(w, (in && i < k) ? 1.f : 0.f, s); }
            if (SMP) {
#pragma unroll
                for (int i = 1; i < 16; ++i) { const bool st = t - i < 0; float q[8]; load8_f32(sp + (size_t)(st ? 15 + t - i : 0) * DPOOL + col, q); const float mk = (st && i < k) ? 1.f : 0.f;
#pragma unroll
                    for (int e = 0; e < 8; ++e) s[e] += mk * q[e]; }
            }
        }
        const int cnt = SMP ? k : (k < t + 1 ? k : t + 1);
        const float inv = 1.0f / (float)cnt;
        float o[8];
#pragma unroll
        for (int e = 0; e < 8; ++e) o[e] = s[e] * inv - z0[e];
        v4u w; w.x = pk2(o[0], o[1]); w.y = pk2(o[2], o[3]); w.z = pk2(o[4], o[5]); w.w = pk2(o[6], o[7]);
        *(v4u*)(PL + (size_t)m * DPOOL + col) = w;
        if (npp) store8_f32(npp + col, z0);
        if (SMP && t < 7) { float q[8]; load8_f32(sp + (size_t)(8 + t) * DPOOL + col, q); store8_f32(a.out + O_NPS + ((size_t)sq * 15 + t) * DPOOL + col, q); }
    }
}

constexpr int NI_GU = (DM / 64) * (DFF / 64), NI_D = (DFF / 64) * (DM / 64), NI_IN = (DM / 64) * (DIN / 64), NI_SQ = (DM / 64) * (DM / 64), NI_PG = (256 / 64) * (512 / 64);
constexpr int IT_W1G = 0, IT_W1D = 2 * NI_GU, IT_WCO = IT_W1D + NI_D + NI_IN, IT_W2G = IT_WCO + 2 * NI_SQ + 4 * NI_PG, IT_W2D = IT_W2G + 2 * NI_GU, IT_END = IT_W2D + NI_D;
__device__ __forceinline__ void convert_items(const Args& a, unsigned char* ws, int it_lo, int it_hi, int widx, int nw, LAS unsigned char* lds, int wave, int lane) {
    LAS float* scr = (LAS float*)(lds + wave * 16640);
    bf16 *W1GU = (bf16*)(ws + WS_W1GU), *W1D = (bf16*)(ws + WS_W1D), *WIN = (bf16*)(ws + WS_WIN), *WCO = (bf16*)(ws + WS_WCO), *WPG = (bf16*)(ws + WS_WPG), *WO = (bf16*)(ws + WS_WO),
         *W2GU = (bf16*)(ws + WS_W2GU), *W2D = (bf16*)(ws + WS_W2D);
    for (int it = it_lo + widx; it < it_hi; it += nw) {
        int r = it;
        if (p0_job(r, a.w1g, DM, DFF, W1GU, 1, 0, scr, lane)) continue;
        if (p0_job(r, a.w1u, DM, DFF, W1GU, 2, 0, scr, lane)) continue;
        if (p0_job(r, a.w1d, DFF, DM, W1D, 0, 0, scr, lane)) continue;
        if (p0_job(r, a.w_in, DM, DIN, WIN, 3, 0, scr, lane)) continue;
        if (p0_job(r, a.w_conv_out, DM, DM, WCO, 0, 0, scr, lane)) continue;
        if (p0_job(r, a.w_o, DM, DM, WO, 0, 0, scr, lane)) continue;
        if (p0_job(r, a.w_pool + 0 * 256 * 512, 256, 512, WPG, 0, 0, scr, lane)) continue;
        if (p0_job(r, a.w_pool + 1 * 256 * 512, 256, 512, WPG, 0, 512, scr, lane)) continue;
        if (p0_job(r, a.w_pool + 2 * 256 * 512, 256, 512, WPG, 0, 1024, scr, lane)) continue;
        if (p0_job(r, a.w_pool + 3 * 256 * 512, 256, 512, WPG, 0, 1536, scr, lane)) continue;
        if (p0_job(r, a.w2g, DM, DFF, W2GU, 1, 0, scr, lane)) continue;
        if (p0_job(r, a.w2u, DM, DFF, W2GU, 2, 0, scr, lane)) continue;
        p0_job(r, a.w2d, DFF, DM, W2D, 0, 0, scr, lane);
    }
}

#define XB_TMO      128
#define XB_XCNT(j)  (256  + 64 * (j))
#define XB_XSUB(j)  (1280 + 64 * (j))
#define XB_XGEN(j)  (2304 + 64 * (j))
#define XB_TOP      3328
#define XB_TOPGEN   3392
#define XCD_BAR_WORDS 3456
#define XB_SPIN_CAP (1u << 18)

__device__ __forceinline__ unsigned xb_ld(unsigned* p)              { return __hip_atomic_load(p, __ATOMIC_RELAXED, __HIP_MEMORY_SCOPE_AGENT); }
__device__ __forceinline__ unsigned xb_add(unsigned* p, unsigned v) { return __hip_atomic_fetch_add(p, v, __ATOMIC_RELAXED, __HIP_MEMORY_SCOPE_AGENT); }
__device__ __forceinline__ unsigned xb_xcc_id() { return (unsigned)__builtin_amdgcn_s_getreg((3 << 11) | 20) & 0xFu; }
#define XB_SPIN(cond, bar) do { unsigned _sp = 0; while (cond) { __builtin_amdgcn_s_sleep(1); \
    if ((++_sp & 255u) == 0u) { if (xb_ld(&(bar)[XB_TMO])) break; if (_sp > XB_SPIN_CAP) { atomicAdd(&(bar)[XB_TMO], 1u); break; } } } } while (0)

struct XcdBarrier {
    unsigned* bar; unsigned x;
    volatile LAS unsigned* st;
};

__device__ __forceinline__ XcdBarrier xcd_barrier_post(unsigned* bar, volatile LAS unsigned* st) {
    XcdBarrier b; b.bar = bar; b.x = xb_xcc_id(); b.st = st;
    if (threadIdx.x == 0) (void)xb_add(&bar[XB_XCNT(b.x)], 1u);
    return b;
}
__device__ __forceinline__ void xcd_barrier_complete(unsigned* bar, unsigned x, unsigned& nloc, unsigned& nx) {
    const unsigned G = gridDim.x * gridDim.y * gridDim.z;
    unsigned sum, cnt, mine, sp = 0u;
    for (;;) {
        sum = 0u; cnt = 0u; mine = 0u;
#pragma unroll
        for (unsigned j = 0; j < 16; ++j) { const unsigned c = xb_ld(&bar[XB_XCNT(j)]); sum += c; cnt += (c > 0u) ? 1u : 0u; mine = (j == x) ? c : mine; }
        if (sum == G) break;
        __builtin_amdgcn_s_sleep(1);
        if ((++sp & 255u) == 0u) { if (xb_ld(&bar[XB_TMO])) break; if (sp > XB_SPIN_CAP) { atomicAdd(&bar[XB_TMO], 1u); break; } }
    }
    nloc = mine > 0u ? mine : 1u; nx = cnt > 0u ? cnt : 1u;
}

__device__ __forceinline__ void xcd_barrier(const XcdBarrier& b) {
    asm volatile("s_waitcnt vmcnt(0)" ::: "memory");
    __syncthreads();
    if (threadIdx.x == 0) {
        unsigned* bar = b.bar;
        __builtin_amdgcn_s_waitcnt(0);
        unsigned nloc = b.st[0], nx = b.st[1];
        if (nloc == 0u) { xcd_barrier_complete(bar, b.x, nloc, nx); b.st[0] = nloc; b.st[1] = nx; }
        const unsigned old = xb_add(&bar[XB_XSUB(b.x)], 1u);
        const unsigned gen = old / nloc;
        if (old + 1u == (gen + 1u) * nloc) {
            __builtin_amdgcn_fence(__ATOMIC_RELEASE, "agent");
            asm volatile("s_waitcnt vmcnt(0)" ::: "memory");
            const unsigned og = xb_add(&bar[XB_TOP], 1u);
            const unsigned tg = og / nx;
            if (og + 1u == (tg + 1u) * nx) xb_add(&bar[XB_TOPGEN], 1u);
            else XB_SPIN(xb_ld(&bar[XB_TOPGEN]) == tg, bar);
            __builtin_amdgcn_fence(__ATOMIC_ACQUIRE, "agent");
            xb_add(&bar[XB_XGEN(b.x)], 1u);
            asm volatile("s_waitcnt vmcnt(0)" ::: "memory");
        } else {
            XB_SPIN(xb_ld(&bar[XB_XGEN(b.x)]) == gen, bar);
            __builtin_amdgcn_fence(__ATOMIC_ACQUIRE, "agent");
            asm volatile("s_waitcnt vmcnt(0)" ::: "memory");
        }
    }
    __syncthreads();
}

__global__ void __launch_bounds__(NWAVES * 64) fwd_megakernel(Args a) {
    extern __shared__ __attribute__((aligned(16))) unsigned char lds_raw[];
    cg::grid_group grid = cg::this_grid();
    LAS unsigned char* lds = (LAS unsigned char*)lds_raw;
    const int tid = threadIdx.x, lane = tid & 63, wave = __builtin_amdgcn_readfirstlane(tid >> 6);
    const int G = gridDim.x, bx = blockIdx.x;
    const int gw = bx * NWAVES + wave, NGW = G * NWAVES;
#define FOR_ROWS(m, total) for (int it_ = 0, m = gw; (it_ < 4) || ((m = 8192 + bx + G * (wave + NWAVES * (it_ - 4))) < (total)); ++it_, m = gw + it_ * NGW)
    unsigned char* ws = a.ws;
    bf16 *W1GU = (bf16*)(ws + WS_W1GU), *W1D = (bf16*)(ws + WS_W1D), *WIN = (bf16*)(ws + WS_WIN), *WCO = (bf16*)(ws + WS_WCO), *WPG = (bf16*)(ws + WS_WPG), *WO = (bf16*)(ws + WS_WO),
         *W2GU = (bf16*)(ws + WS_W2GU), *W2D = (bf16*)(ws + WS_W2D);
    float* H = (float*)(ws + WS_H);
    bf16 *ACT = (bf16*)(ws + WS_R), *BG = (bf16*)(ws + WS_BG), *CV = (bf16*)(ws + WS_CV), *SGC = (bf16*)(ws + WS_SGC), *SGP = (bf16*)(ws + WS_SGP), *Z = (bf16*)(ws + WS_Z), *PL = (bf16*)(ws + WS_PL);
    bf16 *XN1 = (bf16*)(ws + WS_XN1), *XN = (bf16*)(ws + WS_W1GU);
    float* SLAB = (float*)(ws + WS_SGP);
    volatile LAS unsigned* MISC = (volatile LAS unsigned*)(lds + LDS_BYTES - 128);
    if (tid < 32) MISC[tid] = 0u;
    unsigned* barw = (unsigned*)ws;
    if (bx == 0) for (int i = tid; i < XCD_BAR_WORDS; i += NWAVES * 64) __hip_atomic_store(barw + i, 0u, __ATOMIC_RELAXED, __HIP_MEMORY_SCOPE_AGENT);
    __syncthreads();

    {
        convert_items(a, ws, IT_W1G, IT_W1D, gw, NGW, lds, wave, lane);
        for (int m = gw; m < MPAD; m += NGW) rms_row_bf16(src_row(a, m), a.norm_ffn1, XN1 + (size_t)m * DM, nullptr, lane);
    }
    grid.sync();
    const XcdBarrier bar = xcd_barrier_post(barw, MISC + 8);

    {
        pg8::Gemm g{XN1, W1GU, MPAD, 2 * DFF, DM, DM, DM, 0}; pg8::StaticOrder S; S.init(MPAD, 2 * DFF, DM, G, bx);
        pg8::EpiSwiglu E{ACT, DFF};
        pg8::gemm_phase<pg8::EpiSwiglu, pg8::StaticOrder, true, true>(lds, g, S, E);
        constexpr int FULL = (MPAD / 256) * (2 * DFF / 256) % 256;
        if (bx >= FULL) convert_items(a, ws, IT_W1D, IT_WCO, (bx - FULL) * NWAVES + wave, (G - FULL) * NWAVES, lds, wave, lane);
    }
    xcd_barrier(bar);
    {
        pg8::Gemm g{ACT, W1D, MPAD, DM, DFF, DFF, DFF, 0}; pg8::TailOrder S; S.init(DFF, bx);
        pg8::EpiResid<true> E{H, DM, 0.5f, SLAB, a.x_prompt, a.x_sample, a.meta};
        pg8::gemm_phase<pg8::EpiResid<true>, pg8::TailOrder, true, true>(lds, g, S, E);
    }
    xcd_barrier(bar);
    FOR_ROWS(m, MPAD) { float* hr = H + (size_t)m * DM; if (m < 8192) rms_row_bf16(hr, a.norm_mix, XN + (size_t)m * DM, nullptr, lane); else rms_row_bf16(src_row(a, m), a.norm_mix, XN + (size_t)m * DM, hr, lane, SLAB, 0.5f, m); }
    xcd_barrier(bar);
    {
        pg8::Gemm g{XN, WIN, MPAD, DIN, DM, DM, DM, 0}; pg8::StaticOrder S; S.init(MPAD, DIN, DM, G, bx);
        pg8::EpiProj E{BG, CV, Z, SGC, SGP};
        pg8::gemm_phase<pg8::EpiProj, pg8::StaticOrder, true, true>(lds, g, S, E);
        constexpr int FULL = (MPAD / 256) * (DIN / 256) % 256;
        if (bx >= FULL) convert_items(a, ws, IT_WCO, IT_W2G, (bx - FULL) * NWAVES + wave, (G - FULL) * NWAVES, lds, wave, lane);
    }
    xcd_barrier(bar);
    FOR_ROWS(m, MREAL) {
        if (m >= MP_ROWS) p3b_row<true>(a, m, lane, BG, CV, Z, PL); else p3b_row<false>(a, m, lane, BG, CV, Z, PL);
    }
    xcd_barrier(bar);
    {
        pg8::Gemm g{PL, WPG, MPAD, DM, 256, DPOOL, 256, 1}; pg8::StaticOrder S; S.init(MPAD, DM, 256, G, bx);
        pg8::EpiPool E{SGP, a.pool_scale};
        pg8::gemm_phase<pg8::EpiPool, pg8::StaticOrder, true, true>(lds, g, S, E);
    }
    __syncthreads();
    {
        pg8::Gemm g{BG, WCO, MPAD, DM, DM, DM, DM, 0}; pg8::StaticOrder S; S.init(MPAD, DM, DM, G, bx);
        pg8::EpiMerge E{SGC, SGP};
        pg8::gemm_phase<pg8::EpiMerge, pg8::StaticOrder, true, true>(lds, g, S, E);
        constexpr int FULL = (MPAD / 256) * (DM / 256) % 256;
        if (bx >= FULL) convert_items(a, ws, IT_W2G, IT_W2D, (bx - FULL) * NWAVES + wave, (G - FULL) * NWAVES, lds, wave, lane);
    }
    xcd_barrier(bar);
    {
        pg8::Gemm g{SGC, WO, MPAD, DM, DM, DM, DM, 0}; pg8::TailOrder S; S.init(DM, bx);
        pg8::EpiResid<false> E{H, DM, 1.0f, SLAB, nullptr, nullptr, nullptr};
        pg8::gemm_phase<pg8::EpiResid<false>, pg8::TailOrder, true, true>(lds, g, S, E);
    }
    xcd_barrier(bar);
    FOR_ROWS(m, MPAD) { float* hr = H + (size_t)m * DM; if (m < 8192) rms_row_bf16(hr, a.norm_ffn2, XN + (size_t)m * DM, nullptr, lane); else rms_row_bf16(hr, a.norm_ffn2, XN + (size_t)m * DM, hr, lane, SLAB, 1.0f, m); }
    xcd_barrier(bar);
    {
        pg8::Gemm g{XN, W2GU, MPAD, 2 * DFF, DM, DM, DM, 0}; pg8::StaticOrder S; S.init(MPAD, 2 * DFF, DM, G, bx);
        pg8::EpiSwiglu E{ACT, DFF};
        pg8::gemm_phase<pg8::EpiSwiglu, pg8::StaticOrder, true, true>(lds, g, S, E);
        constexpr int FULL = (MPAD / 256) * (2 * DFF / 256) % 256;
        if (bx >= FULL) convert_items(a, ws, IT_W2D, IT_END, (bx - FULL) * NWAVES + wave, (G - FULL) * NWAVES, lds, wave, lane);
    }
    xcd_barrier(bar);
    {
        pg8::Gemm g{ACT, W2D, MPAD, DM, DFF, DFF, DFF, 0}; pg8::TailOrder S; S.init(DFF, bx);
        pg8::EpiResid<false> E{H, DM, 0.5f, SLAB, nullptr, nullptr, nullptr};
        pg8::gemm_phase<pg8::EpiResid<false>, pg8::TailOrder, true, true>(lds, g, S, E);
    }
    xcd_barrier(bar);
    FOR_ROWS(m, MREAL) {
        float* dst;
        if (m < MP_ROWS) { const int b = m / LP, t = m - b * LP; if (t < NMETA) continue; dst = a.out + O_YP + ((size_t)b * SEQ + (t - NMETA)) * DM; }
        else dst = a.out + O_YS + (size_t)(m - MP_ROWS) * DM;
        const float* hr = H + (size_t)m * DM;
        f32x4 v[8]; float s = 0.f;
#pragma unroll
        for (int j = 0; j < 8; ++j) { v[j] = ((const f32x4*)hr)[lane + 64 * j]; if (m >= 8192) v[j] += slab_sum(SLAB, m, j, lane) * 0.5f; s += (v[j].x * v[j].x + v[j].y * v[j].y) + (v[j].z * v[j].z + v[j].w * v[j].w); }
        const float r = 1.0f / sqrtf(wave_sum(s) * (1.0f / DM) + EPS);
#pragma unroll
        for (int j = 0; j < 8; ++j) { const f32x4 gg = ((const f32x4*)a.norm_final)[lane + 64 * j]; ((f32x4*)dst)[lane + 64 * j] = v[j] * r * gg; }
    }
}

extern "C" void kernel_launch(void* const* d_in, const int* in_sizes, int n_in, void* d_out, int out_size, void* d_ws, size_t ws_size, hipStream_t stream) {
    static int grid = 0;
    if (grid == 0) {
        if (n_in != 21 || (size_t)out_size != O_END || ws_size < WS_END) { fprintf(stderr, "kernel_launch: unexpected shapes: n_in %d out %d ws %zu (need %zu)\n", n_in, out_size, ws_size, (size_t)WS_END); grid = -1; return; }
        int dev = 0, cus = 0, per_cu = 0;
        hipGetDevice(&dev); hipDeviceGetAttribute(&cus, hipDeviceAttributeMultiprocessorCount, dev);
        if (hipFuncSetAttribute((const void*)fwd_megakernel, hipFuncAttributeMaxDynamicSharedMemorySize, LDS_BYTES) != hipSuccess) { fprintf(stderr, "kernel_launch: hipFuncSetAttribute failed\n"); grid = -1; return; }
        if (hipOccupancyMaxActiveBlocksPerMultiprocessor(&per_cu, (const void*)fwd_megakernel, NWAVES * 64, LDS_BYTES) != hipSuccess || per_cu < 1) { fprintf(stderr, "kernel_launch: occupancy query failed (%d)\n", per_cu); (void)hipGetLastError(); per_cu = 1; }
        grid = cus * 1;
        fprintf(stderr, "kernel_launch: grid %d (cus %d, per_cu %d)\n", grid, cus, per_cu);
    }
    if (grid < 0) return;
    Args a{};
    a.x_prompt = (const float*)d_in[0]; a.x_sample = (const float*)d_in[1]; a.state_conv = (const float*)d_in[2]; a.state_pool = (const float*)d_in[3]; a.meta = (const float*)d_in[4];
    a.norm_ffn1 = (const float*)d_in[5]; a.w1g = (const float*)d_in[6]; a.w1u = (const float*)d_in[7]; a.w1d = (const float*)d_in[8]; a.norm_mix = (const float*)d_in[9]; a.w_in = (const float*)d_in[10];
    a.conv_w = (const float*)d_in[11]; a.w_conv_out = (const float*)d_in[12]; a.w_pool = (const float*)d_in[13]; a.pool_scale = (const float*)d_in[14]; a.w_o = (const float*)d_in[15];
    a.norm_ffn2 = (const float*)d_in[16]; a.w2g = (const float*)d_in[17]; a.w2u = (const float*)d_in[18]; a.w2d = (const float*)d_in[19]; a.norm_final = (const float*)d_in[20];
    a.out = (float*)d_out; a.ws = (unsigned char*)d_ws;
    void* args[] = {&a};
    hipError_t e = hipLaunchCooperativeKernel((const void*)fwd_megakernel, dim3(grid), dim3(NWAVES * 64), args, LDS_BYTES, stream);
    if (e != hipSuccess) fprintf(stderr, "kernel_launch: cooperative launch failed: %s (grid %d)\n", hipGetErrorString(e), grid);
}
```

```cpp
#include <hip/hip_runtime.h>
#include <hip/hip_cooperative_groups.h>
#include <cstdio>
#include <cstdint>
namespace cg = cooperative_groups;

namespace pg8 {
#define PG8_LAS __attribute__((address_space(3)))
typedef unsigned short bf16_t;
typedef short bf16x8 __attribute__((ext_vector_type(8)));
typedef float f32x4 __attribute__((ext_vector_type(4)));
typedef unsigned u32x4 __attribute__((ext_vector_type(4)));
constexpr int BM = 256, BK = 64, HALF = 128, HTB = HALF * BK * 2  , STAGE_BYTES = 8 * HTB, NXCD = 8, WGM = 8;

__host__ __device__ __forceinline__ int lds_byte(int r, int c) { const int st = (r >> 4) * 2 + (c >> 5), rr = r & 15, cc = c & 31, ob = rr * 64 + cc * 2; return st * 1024 + (ob ^ (((ob >> 9) & 1) << 5)); }
__host__ __device__ __forceinline__ void stage_rc(int b, int& R, int& C) { const int st = b / 1024, sb = b % 1024, swz = sb ^ (((sb >> 9) & 1) << 5); R = (st >> 1) * 16 + swz / 64; C = (st & 1) * 32 + (swz % 64) / 2; }
__host__ __device__ __forceinline__ int perm32(int rho) { const int n = rho >> 4, i = rho & 15; return 8 * (i >> 2) + 4 * n + (i & 3); }

struct Unit { int pm, pn, kt0, nkt, slab; };
struct Gemm { const bf16_t* A; const bf16_t* Bt; int M, N, K, lda, ldb, agrp; };
__device__ __forceinline__ size_t acolb(const Gemm& g, const Unit& u) { return g.agrp ? (size_t)((u.pn >> 1) * 256) * 2 : (size_t)0; }

struct StaticOrder {
    int nM, nN, nwg, G, c, nt;
    __host__ __device__ void init(int M, int N, int K, int G_, int c_) { nM = M / BM; nN = N / BM; nwg = nM * nN; G = G_; c = c_; nt = K / BK; }
    __host__ __device__ bool next(int i, Unit& u) const {
        const long L = (long)i * G + c; if (L >= nwg) return false;
        int wgid = (int)L; { const int q = nwg / NXCD, r = nwg % NXCD, xcd = wgid % NXCD, off = wgid / NXCD; wgid = (xcd < r ? xcd * (q + 1) : r * (q + 1) + (xcd - r) * q) + off; }
        const int nig = WGM * nN, gid = wgid / nig, fm = gid * WGM, gsz = (nM - fm) < WGM ? (nM - fm) : WGM;
        u.pm = fm + ((wgid % nig) % gsz); u.pn = (wgid % nig) / gsz; u.kt0 = 0; u.nkt = nt; u.slab = -1; return true;
    }
    __device__ __forceinline__ void a_ready(const Unit&) const {}
    __device__ __forceinline__ void done(const Unit&) const {}
};
struct TailOrder {
    int c, nt;
    __host__ __device__ void init(int K, int c_) { c = c_; nt = K / BK; }
    __host__ __device__ bool next(int i, Unit& u) const {
        if (i == 0) { const int x = c & 7, idx = c >> 3; u.pm = 4 * x + (idx >> 3); u.pn = idx & 7; u.kt0 = 0; u.nkt = nt; u.slab = -1; return true; }
        if (i == 1 && c < 240) {
            const int x = c & 7, idx = c >> 3, q = idx / 6, r6 = idx - 6 * q, ch = x < 6 ? x : r6, pn = x < 6 ? r6 : x;
            const int np = nt >> 1, base = np / 6, rem = np % 6, p0 = ch * base + (ch < rem ? ch : rem), pc = base + (ch < rem ? 1 : 0);
            u.pm = 32 + q; u.pn = pn; u.kt0 = 2 * p0; u.nkt = 2 * pc; u.slab = (q * 8 + pn) * 6 + ch; return true; }
        return false;
    }
    __device__ __forceinline__ void a_ready(const Unit&) const {}
    __device__ __forceinline__ void done(const Unit&) const {}
};

__device__ __forceinline__ unsigned cvt_pk_bf16(float lo, float hi) { unsigned r; asm volatile("v_cvt_pk_bf16_f32 %0, %1, %2" : "=v"(r) : "v"(lo), "v"(hi)); return r; }
__device__ __forceinline__ float bf_lo(unsigned w) { return __uint_as_float(w << 16); }
__device__ __forceinline__ float bf_hi(unsigned w) { return __uint_as_float(w & 0xffff0000u); }
__device__ __forceinline__ float sigmoidf_(float x) { return __builtin_amdgcn_rcpf(1.0f + __builtin_amdgcn_exp2f(-1.4426950408889634f * x)); }
__device__ __forceinline__ u32x4 pack8(const f32x4& a, const f32x4& b) { u32x4 w; w.x = cvt_pk_bf16(a[0], a[1]); w.y = cvt_pk_bf16(a[2], a[3]); w.z = cvt_pk_bf16(b[0], b[1]); w.w = cvt_pk_bf16(b[2], b[3]); return w; }
__device__ __forceinline__ void unpack8(const u32x4& w, f32x4& a, f32x4& b) { a = (f32x4){bf_lo(w.x), bf_hi(w.x), bf_lo(w.y), bf_hi(w.y)}; b = (f32x4){bf_lo(w.z), bf_hi(w.z), bf_lo(w.w), bf_hi(w.w)}; }

struct EpiSwiglu {
    static constexpr bool PERM = true, AFTER_DRAIN = false;
    bf16_t* O; int ldc;
    __device__ __forceinline__ void operator()(const f32x4 (&acc)[2][2][4][2], const Unit& u, int wr, int wc, int fr, int fq) const {
        const int row0 = u.pm * BM + wr * 64 + fr, col0 = u.pn * HALF + wc * 32 + 8 * fq;
#pragma unroll
        for (int ai = 0; ai < 2; ++ai)
#pragma unroll
            for (int m = 0; m < 4; ++m) {
                f32x4 v[2];
#pragma unroll
                for (int n = 0; n < 2; ++n) { const f32x4 gt = acc[ai][0][m][n], up = acc[ai][1][m][n];
#pragma unroll
                    for (int e = 0; e < 4; ++e) v[n][e] = gt[e] * sigmoidf_(gt[e]) * up[e]; }
                *(u32x4*)(O + (size_t)(row0 + ai * HALF + m * 16) * ldc + col0) = pack8(v[0], v[1]);
            }
    }
};
template <bool FROMX> struct EpiResid {
    static constexpr bool PERM = true, AFTER_DRAIN = false;
    float* H; int ldc; float s; float* SL;
    const float *xp, *xs, *meta;
    __device__ __forceinline__ void operator()(const f32x4 (&acc)[2][2][4][2], const Unit& u, int wr, int wc, int fr, int fq) const {
        if (u.slab >= 0) {
            bf16_t* base = (bf16_t*)SL + (size_t)u.slab * (BM * BM) + (size_t)(wr * 64 + fr) * BM + wc * 32 + 8 * fq;
#pragma unroll
            for (int ai = 0; ai < 2; ++ai)
#pragma unroll
                for (int m = 0; m < 4; ++m)
#pragma unroll
                    for (int bj = 0; bj < 2; ++bj) *(u32x4*)(base + (size_t)(ai * HALF + m * 16) * BM + bj * HALF) = pack8(acc[ai][bj][m][0], acc[ai][bj][m][1]);
            return;
        }
        const int row0 = u.pm * BM + wr * 64 + fr, col0 = u.pn * BM + wc * 32 + 8 * fq;
#pragma unroll
        for (int ai = 0; ai < 2; ++ai)
#pragma unroll
            for (int m = 0; m < 4; ++m) { const int r = row0 + ai * HALF + m * 16; float* rowp = H + (size_t)r * ldc + col0;
                const float* srcp = rowp;
                if (FROMX) {
                    const int b = r / 2064, t = r - b * 2064;
                    srcp = (t < 16 ? meta + (size_t)t * 2048 : xp + ((size_t)b * 2048 + (t - 16)) * 2048) + col0;
                }
#pragma unroll
                for (int bj = 0; bj < 2; ++bj)
#pragma unroll
                    for (int n = 0; n < 2; ++n) { const f32x4 h = *(const f32x4*)(srcp + bj * HALF + n * 4); *(f32x4*)(rowp + bj * HALF + n * 4) = h + acc[ai][bj][m][n] * s; }
                if (m & 1) asm volatile("" ::: "memory"); }
    }
};
struct EpiProj {
    static constexpr bool PERM = true, AFTER_DRAIN = false;
    bf16_t *BG, *CV, *Z, *SGC, *SGP;
    __device__ __forceinline__ void operator()(const f32x4 (&acc)[2][2][4][2], const Unit& u, int wr, int wc, int fr, int fq) const {
        const int row0 = u.pm * BM + wr * 64 + fr, pn = u.pn;
        if (pn >= 8 && pn < 24) {
            const int col0 = (pn - 8) * HALF + wc * 32 + 8 * fq;
#pragma unroll
            for (int ai = 0; ai < 2; ++ai)
#pragma unroll
                for (int m = 0; m < 4; ++m)
                    *(u32x4*)(CV + (size_t)(row0 + ai * HALF + m * 16) * 2048 + col0) = pack8(acc[ai][0][m][0] * acc[ai][1][m][0], acc[ai][0][m][1] * acc[ai][1][m][1]);
        } else {
            bf16_t* base; int ld, ct; bool sg;
            if (pn < 8) { base = BG; ld = 2048; ct = pn; sg = false; }
            else if (pn < 28) { base = Z; ld = 1024; ct = pn - 24; sg = false; }
            else if (pn < 36) { base = SGC; ld = 2048; ct = pn - 28; sg = true; }
            else { base = SGP; ld = 2048; ct = pn - 36; sg = true; }
            const int col0 = ct * BM + wc * 32 + 8 * fq;
#pragma unroll
            for (int ai = 0; ai < 2; ++ai)
#pragma unroll
                for (int m = 0; m < 4; ++m) { bf16_t* rowp = base + (size_t)(row0 + ai * HALF + m * 16) * ld + col0;
#pragma unroll
                    for (int bj = 0; bj < 2; ++bj) { f32x4 v0 = acc[ai][bj][m][0], v1 = acc[ai][bj][m][1];
                        if (sg) {
#pragma unroll
                            for (int e = 0; e < 4; ++e) { v0[e] = sigmoidf_(v0[e]); v1[e] = sigmoidf_(v1[e]); } }
                        *(u32x4*)(rowp + bj * HALF) = pack8(v0, v1); } }
        }
    }
};
struct EpiPool {
    static constexpr bool PERM = true, AFTER_DRAIN = false;
    bf16_t* SGP; const float* ps;
    __device__ __forceinline__ void operator()(const f32x4 (&acc)[2][2][4][2], const Unit& u, int wr, int wc, int fr, int fq) const {
        const int row0 = u.pm * BM + wr * 64 + fr, col0 = u.pn * BM + wc * 32 + 8 * fq;
#pragma unroll
        for (int ai = 0; ai < 2; ++ai)
#pragma unroll
            for (int m = 0; m < 4; ++m) { bf16_t* rowp = SGP + (size_t)(row0 + ai * HALF + m * 16) * 2048 + col0;
#pragma unroll
                for (int bj = 0; bj < 2; ++bj) { u32x4* p = (u32x4*)(rowp + bj * HALF); f32x4 g0, g1; unpack8(*p, g0, g1);
                    const f32x4 s0 = *(const f32x4*)(ps + col0 + bj * HALF), s1 = *(const f32x4*)(ps + col0 + bj * HALF + 4);
                    *p = pack8(g0 * s0 * acc[ai][bj][m][0], g1 * s1 * acc[ai][bj][m][1]); }
                asm volatile("" ::: "memory"); }
    }
};
struct EpiMerge {
    static constexpr bool PERM = true, AFTER_DRAIN = false;
    bf16_t* SGC; const bf16_t* MP;
    __device__ __forceinline__ void operator()(const f32x4 (&acc)[2][2][4][2], const Unit& u, int wr, int wc, int fr, int fq) const {
        const int row0 = u.pm * BM + wr * 64 + fr, col0 = u.pn * BM + wc * 32 + 8 * fq;
#pragma unroll
        for (int ai = 0; ai < 2; ++ai)
#pragma unroll
            for (int m = 0; m < 4; ++m) { const size_t off = (size_t)(row0 + ai * HALF + m * 16) * 2048 + col0;
#pragma unroll
                for (int bj = 0; bj < 2; ++bj) { u32x4* p = (u32x4*)(SGC + off + bj * HALF); f32x4 g0, g1, q0, q1; unpack8(*p, g0, g1); unpack8(*(const u32x4*)(MP + off + bj * HALF), q0, q1);
                    *p = pack8(g0 * acc[ai][bj][m][0] + q0, g1 * acc[ai][bj][m][1] + q1); }
                if (m & 1) asm volatile("" ::: "memory"); }
    }
};

template <class Epi, class Sched, bool ALIGN_EPI = false, bool SP2 = false>
__device__ __forceinline__ void gemm_phase(PG8_LAS unsigned char* lds, const Gemm g, const Sched& S, const Epi& E) {
    int tid_ = threadIdx.x; asm volatile("" : "+v"(tid_));
    const int tid = tid_, wid = __builtin_amdgcn_readfirstlane(tid >> 6), lane = tid & 63, wr = wid >> 2, wc = wid & 3, fr = lane & 15, fq = lane >> 4;

    unsigned voffA[2], voffB[2];
#pragma unroll
    for (int i = 0; i < 2; ++i) { int R, C; stage_rc(tid * 16 + i * 8192, R, C); const int Rb = Epi::PERM ? ((R & ~31) + perm32(R & 31)) : R;
        voffA[i] = (unsigned)(R * g.lda + C) * 2u; voffB[i] = (unsigned)(Rb * g.ldb + C) * 2u; }
    const size_t kstep = (size_t)(BK * 2);
    const size_t hstepA = (size_t)HALF * g.lda * 2, hstepB = (size_t)HALF * g.ldb * 2;
    const size_t tstepA = 2 * hstepA, tstepB = 2 * hstepB;
    const unsigned ldsw = (unsigned)wid * 1024u;
    const int aoff = lds_byte(wr * 64 + fr, fq * 8), boff = lds_byte(wc * 32 + fr, fq * 8);
#define PG8_SA(b, h) (((b) * 2 + (h)) * HTB)
#define PG8_SB(b, h) ((4 + (b) * 2 + (h)) * HTB)
#define PG8_STAGE(bufoff, gbase, voff) do { _Pragma("unroll") for (int _i = 0; _i < 2; ++_i) \
        __builtin_amdgcn_global_load_lds((const unsigned*)((const char*)(gbase) + (voff)[_i]), (PG8_LAS unsigned*)(lds + (bufoff) + ldsw + _i * 8192), 16, 0, 0); } while (0)
#define PG8_LDA(dst, b, h) do { _Pragma("unroll") for (int m = 0; m < 4; ++m) _Pragma("unroll") for (int k = 0; k < 2; ++k) dst[m][k] = *(const PG8_LAS bf16x8*)(lds + PG8_SA(b, h) + aoff + m * 2048 + k * 1024); } while (0)
#define PG8_LDB(dst, b, h) do { _Pragma("unroll") for (int n = 0; n < 2; ++n) _Pragma("unroll") for (int k = 0; k < 2; ++k) dst[n][k] = *(const PG8_LAS bf16x8*)(lds + PG8_SB(b, h) + boff + n * 2048 + k * 1024); } while (0)
#define PG8_MMA(ai, bj, At, Bt) do { __builtin_amdgcn_s_setprio(1); _Pragma("unroll") for (int m = 0; m < 4; ++m) _Pragma("unroll") for (int n = 0; n < 2; ++n) _Pragma("unroll") for (int k = 0; k < 2; ++k) \
        acc[ai][bj][m][n] = __builtin_amdgcn_mfma_f32_16x16x32_bf16(Bt[n][k], At[m][k], acc[ai][bj][m][n], 0, 0, 0); __builtin_amdgcn_s_setprio(0); } while (0)
#define PG8_WAIT_V(n) asm volatile("s_waitcnt vmcnt(" #n ")" ::: "memory")
#define PG8_WAIT_L(n) asm volatile("s_waitcnt lgkmcnt(" #n ")" ::: "memory")
#define PG8_BAR __builtin_amdgcn_s_barrier()
#define PG8_SCHED __builtin_amdgcn_sched_barrier(0)
    Unit cur, nxt; int ui = 0;
    if (!S.next(0, cur)) return;
    f32x4 acc[2][2][4][2];
#pragma unroll
    for (int a = 0; a < 2; ++a)
#pragma unroll
        for (int b = 0; b < 2; ++b)
#pragma unroll
            for (int m = 0; m < 4; ++m)
#pragma unroll
                for (int n = 0; n < 2; ++n) acc[a][b][m][n] = (f32x4){0.f, 0.f, 0.f, 0.f};
    bf16x8 At[4][2], B0[2][2], B1[2][2];
    const char* cA = (const char*)g.A + (size_t)cur.pm * tstepA + acolb(g, cur) + (size_t)cur.kt0 * kstep; const char* cB = (const char*)g.Bt + (size_t)cur.pn * tstepB + (size_t)cur.kt0 * kstep;
    S.a_ready(cur);
    if constexpr (SP2) {
        PG8_STAGE(PG8_SB(0, 0), cB, voffB); PG8_STAGE(PG8_SB(0, 1), cB + hstepB, voffB); PG8_STAGE(PG8_SA(0, 0), cA, voffA); PG8_STAGE(PG8_SA(0, 1), cA + hstepA, voffA);
        if (wr == 1) PG8_BAR;
        PG8_WAIT_V(2); PG8_BAR;
        PG8_STAGE(PG8_SB(1, 0), cB + kstep, voffB); PG8_STAGE(PG8_SA(1, 0), cA + kstep, voffA); PG8_STAGE(PG8_SB(1, 1), cB + hstepB + kstep, voffB);
        PG8_WAIT_V(6); PG8_BAR;
    } else {
        PG8_STAGE(PG8_SB(0, 0), cB, voffB); PG8_STAGE(PG8_SA(0, 0), cA, voffA); PG8_STAGE(PG8_SB(0, 1), cB + hstepB, voffB); PG8_STAGE(PG8_SA(0, 1), cA + hstepA, voffA);
        if (wr == 1) PG8_BAR;
        PG8_WAIT_V(4); PG8_BAR;
        PG8_STAGE(PG8_SB(1, 0), cB + kstep, voffB); PG8_STAGE(PG8_SA(1, 0), cA + kstep, voffA); PG8_STAGE(PG8_SB(1, 1), cB + hstepB + kstep, voffB);
        PG8_WAIT_V(6); PG8_BAR;
    }
    for (;;) {
        const bool has_next = S.next(ui + 1, nxt);
        const char* nA = has_next ? (const char*)g.A + (size_t)nxt.pm * tstepA + acolb(g, nxt) + (size_t)nxt.kt0 * kstep : cA; const char* nB = has_next ? (const char*)g.Bt + (size_t)nxt.pn * tstepB + (size_t)nxt.kt0 * kstep : cB;
        const int nt = cur.nkt;
        for (int t = 0; t < nt; t += 2) {
            const bool last = (t == nt - 2);
            const char* a1 = cA + (size_t)(t + 1) * kstep;
            const char* a2 = last ? nA : cA + (size_t)(t + 2) * kstep; const char* b2 = last ? nB : cB + (size_t)(t + 2) * kstep;
            const char* a3 = a2 + kstep; const char* b3 = b2 + kstep;
            if (last && has_next) S.a_ready(nxt);
            if constexpr (SP2) {
            PG8_LDB(B0, 0, 0); PG8_LDB(B1, 0, 1); PG8_SCHED; PG8_LDA(At, 0, 0); PG8_STAGE(PG8_SA(1, 1), a1 + hstepA, voffA);
            PG8_WAIT_V(8); PG8_WAIT_L(0); PG8_BAR; PG8_MMA(0, 0, At, B0); PG8_MMA(0, 1, At, B1); PG8_BAR; PG8_SCHED;
            PG8_LDA(At, 0, 1); PG8_STAGE(PG8_SB(0, 0), b2, voffB); PG8_STAGE(PG8_SB(0, 1), b2 + hstepB, voffB); PG8_STAGE(PG8_SA(0, 0), a2, voffA);
            PG8_WAIT_V(8); PG8_WAIT_L(0); PG8_BAR; PG8_MMA(1, 0, At, B0); PG8_MMA(1, 1, At, B1); PG8_BAR; PG8_SCHED;
            PG8_LDB(B0, 1, 0); PG8_LDB(B1, 1, 1); PG8_SCHED; PG8_LDA(At, 1, 0); PG8_STAGE(PG8_SA(0, 1), a2 + hstepA, voffA);
            PG8_WAIT_V(8); PG8_WAIT_L(0); PG8_BAR; PG8_MMA(0, 0, At, B0); PG8_MMA(0, 1, At, B1); PG8_BAR; PG8_SCHED;
            PG8_LDA(At, 1, 1); PG8_STAGE(PG8_SB(1, 0), b3, voffB); PG8_STAGE(PG8_SB(1, 1), b3 + hstepB, voffB); PG8_STAGE(PG8_SA(1, 0), a3, voffA);
            PG8_WAIT_V(8); PG8_WAIT_L(0); PG8_BAR; PG8_MMA(1, 0, At, B0); PG8_MMA(1, 1, At, B1); PG8_BAR; PG8_SCHED;
            } else {
            PG8_LDB(B0, 0, 0); PG8_SCHED; PG8_LDA(At, 0, 0); PG8_STAGE(PG8_SA(1, 1), a1 + hstepA, voffA);
            PG8_WAIT_L(8); PG8_BAR; PG8_WAIT_L(0); PG8_MMA(0, 0, At, B0); PG8_BAR; PG8_SCHED;
            PG8_LDB(B1, 0, 1); PG8_STAGE(PG8_SB(0, 0), b2, voffB);
            PG8_BAR; PG8_WAIT_L(0); PG8_MMA(0, 1, At, B1); PG8_BAR;
            PG8_LDA(At, 0, 1); PG8_STAGE(PG8_SA(0, 0), a2, voffA);
            PG8_BAR; PG8_WAIT_L(0); PG8_MMA(1, 0, At, B0); PG8_BAR; PG8_SCHED;
            PG8_STAGE(PG8_SB(0, 1), b2 + hstepB, voffB);
            PG8_WAIT_V(6); PG8_BAR; PG8_MMA(1, 1, At, B1); PG8_BAR;
            PG8_LDB(B0, 1, 0); PG8_SCHED; PG8_LDA(At, 1, 0); PG8_STAGE(PG8_SA(0, 1), a2 + hstepA, voffA);
            PG8_WAIT_L(8); PG8_BAR; PG8_WAIT_L(0); PG8_MMA(0, 0, At, B0); PG8_BAR; PG8_SCHED;
            PG8_LDB(B1, 1, 1); PG8_STAGE(PG8_SB(1, 0), b3, voffB);
            PG8_BAR; PG8_WAIT_L(0); PG8_MMA(0, 1, At, B1); PG8_BAR;
            PG8_LDA(At, 1, 1); PG8_STAGE(PG8_SA(1, 0), a3, voffA);
            PG8_BAR; PG8_WAIT_L(0); PG8_MMA(1, 0, At, B0); PG8_BAR; PG8_SCHED;
            PG8_STAGE(PG8_SB(1, 1), b3 + hstepB, voffB);
            PG8_WAIT_V(6); PG8_BAR; PG8_MMA(1, 1, At, B1); PG8_BAR;
            }
        }
        if constexpr (ALIGN_EPI) { if (wr == 0) PG8_BAR; }
        if constexpr (!Epi::AFTER_DRAIN) { E(acc, cur, wr, wc, fr, fq); S.done(cur); }
        if (!has_next) break;
#pragma unroll
        for (int a = 0; a < 2; ++a)
#pragma unroll
            for (int b = 0; b < 2; ++b)
#pragma unroll
                for (int m = 0; m < 4; ++m)
#pragma unroll
                    for (int n = 0; n < 2; ++n) acc[a][b][m][n] = (f32x4){0.f, 0.f, 0.f, 0.f};
        cur = nxt; cA = nA; cB = nB; ++ui;
        if constexpr (ALIGN_EPI) { if (wr == 1) PG8_BAR; }
    }
    PG8_WAIT_V(0);
    if constexpr (!ALIGN_EPI) { if (wr == 0) PG8_BAR; }
    PG8_BAR;
    if constexpr (Epi::AFTER_DRAIN) { E.fused(acc, cur, wr, wc, fr, fq, lds, wid, lane); S.done(cur); }
#undef PG8_SA
#undef PG8_SB
#undef PG8_STAGE
#undef PG8_LDA
#undef PG8_LDB
#undef PG8_MMA
#undef PG8_WAIT_V
#undef PG8_WAIT_L
#undef PG8_BAR
#undef PG8_SCHED
}
}

constexpr int DM = 2048, NB = 4, SEQ = 2048, NMETA = 16, LP = SEQ + NMETA  , DECB = 128, DECS = 8;
constexpr int DFF = 5632, DPOOL = 1024, DIN = 11264;
constexpr int MP_ROWS = NB * LP;
constexpr int MS_ROWS = DECB * DECS;
constexpr int MREAL = MP_ROWS + MS_ROWS;
constexpr int MPAD = 9472;
constexpr float EPS = 1e-6f;
constexpr int NWAVES = 8;

constexpr size_t O_YP = 0, O_YS = O_YP + (size_t)NB * SEQ * DM, O_NCP = O_YS + (size_t)MS_ROWS * DM, O_NPP = O_NCP + (size_t)NB * 2 * DM,
                 O_NCS = O_NPP + (size_t)NB * 15 * DPOOL, O_NPS = O_NCS + (size_t)DECB * 2 * DM, O_END = O_NPS + (size_t)DECB * 15 * DPOOL;

constexpr size_t MiB = 1u << 20;
constexpr size_t WS_W1GU = 1 * MiB;
constexpr size_t WS_W1D = WS_W1GU + 44 * MiB;
constexpr size_t WS_WIN = WS_W1D + 22 * MiB;
constexpr size_t WS_WCO = WS_WIN + 44 * MiB;
constexpr size_t WS_WPG = WS_WCO + 8 * MiB;
constexpr size_t WS_WO = WS_WPG + 1 * MiB;
constexpr size_t WS_W2GU = WS_WO + 8 * MiB;
constexpr size_t WS_W2D = WS_W2GU + 44 * MiB;
constexpr size_t WS_H = WS_W2D + 22 * MiB;
constexpr size_t WS_R = WS_H + 74 * MiB;
constexpr size_t WS_BG = WS_R, WS_CV = WS_R + 37 * MiB, WS_SGC = WS_R + 74 * MiB, WS_SGP = WS_R + 111 * MiB, WS_Z = WS_R + 148 * MiB, WS_PL = WS_Z + 19 * MiB;
constexpr size_t WS_XN1 = WS_SGP;
constexpr size_t WS_END = WS_PL + 19 * MiB;
static_assert((size_t)MPAD * DFF * 2 <= 111 * MiB, "ACT fits below XN1");

#define GAS __attribute__((address_space(1)))
#define LAS __attribute__((address_space(3)))
typedef unsigned short bf16;
typedef unsigned v4u __attribute__((ext_vector_type(4)));
typedef float f32x4 __attribute__((ext_vector_type(4)));
#define LDS_WAIT() asm volatile("s_waitcnt lgkmcnt(0)" ::: "memory")
constexpr int LDS_BYTES = 147456;

struct Args {
    const float *x_prompt, *x_sample, *state_conv, *state_pool, *meta, *norm_ffn1, *w1g, *w1u, *w1d, *norm_mix, *w_in, *conv_w, *w_conv_out, *w_pool, *pool_scale, *w_o, *norm_ffn2, *w2g, *w2u, *w2d, *norm_final;
    float* out; unsigned char* ws;
};

__device__ __forceinline__ unsigned pk2(float lo, float hi) { return pg8::cvt_pk_bf16(lo, hi); }
__device__ __forceinline__ float wave_sum(float v) {
#pragma unroll
    for (int o = 1; o < 64; o <<= 1) v += __shfl_xor(v, o);
    return v;
}
__device__ __forceinline__ const float* src_row(const Args& a, int r) {
    if (r < MP_ROWS) { const int b = r / LP, t = r - b * LP; return t < NMETA ? a.meta + (size_t)t * DM : a.x_prompt + ((size_t)b * SEQ + (t - NMETA)) * DM; }
    if (r < MREAL) return a.x_sample + (size_t)(r - MP_ROWS) * DM;
    return nullptr;
}
__device__ __forceinline__ void p0_transpose_item(const float* W, int N, bf16* WT, int K, int k0, int n0, int drow0, LAS float* scr, int lane) {
    const int lr = lane >> 4, lc = (lane & 15) * 4;
    f32x4 v[16];
#pragma unroll
    for (int i = 0; i < 16; ++i) v[i] = __builtin_nontemporal_load((const f32x4*)(W + (size_t)(k0 + 4 * i + lr) * N + n0 + lc));
#pragma unroll
    for (int i = 0; i < 16; ++i) { LAS float* s = scr + (4 * i + lr) * 65 + lc; s[0] = v[i].x; s[1] = v[i].y; s[2] = v[i].z; s[3] = v[i].w; }
    LDS_WAIT(); asm volatile("" ::: "memory");
    const int c = lane & 7;
#pragma unroll
    for (int j = 0; j < 8; ++j) { const int n = (lane >> 3) + 8 * j; const LAS float* s = scr + (8 * c) * 65 + n;
        v4u o; o.x = pk2(s[0 * 65], s[1 * 65]); o.y = pk2(s[2 * 65], s[3 * 65]); o.z = pk2(s[4 * 65], s[5 * 65]); o.w = pk2(s[6 * 65], s[7 * 65]);
        *(v4u*)(WT + (size_t)(drow0 + n) * K + k0 + 8 * c) = o; }
    LDS_WAIT(); asm volatile("" ::: "memory");
}
__device__ __forceinline__ bool p0_job(int& r, const float* W, int K, int N, bf16* WT, int kind, int roff, LAS float* scr, int lane) {
    const int nb = N / 64, items = (K / 64) * nb;
    if (r >= items) { r -= items; return false; }
    const int kb = r / nb, n0 = (r % nb) * 64;
    int d;
    if (kind == 0) d = roff + n0;
    else if (kind == 1) d = (n0 >> 7) * 256 + (n0 & 127);
    else if (kind == 2) d = (n0 >> 7) * 256 + 128 + (n0 & 127);
    else { if (n0 < 2048 || n0 >= 6144) d = n0; else if (n0 < 4096) { const int j = n0 - 2048; d = 2048 + (j >> 7) * 256 + (j & 127); } else { const int j = n0 - 4096; d = 2048 + (j >> 7) * 256 + 128 + (j & 127); } }
    p0_transpose_item(W, N, WT, K, kb * 64, n0, d, scr, lane);
    return true;
}
__device__ __forceinline__ f32x4 slab_sum(const float* SL, int m, int j, int lane) {
    typedef unsigned u32x2 __attribute__((ext_vector_type(2)));
    const bf16* p = (const bf16*)SL + (size_t)(((m >> 8) - 32) * 8 + j) * 6 * 65536 + (size_t)(m & 255) * 256 + 4 * lane;
    f32x4 a = (f32x4){0.f, 0.f, 0.f, 0.f};
#pragma unroll
    for (int ch = 0; ch < 6; ++ch) { const u32x2 w = *(const u32x2*)(p + (size_t)ch * 65536); a += (f32x4){pg8::bf_lo(w.x), pg8::bf_hi(w.x), pg8::bf_lo(w.y), pg8::bf_hi(w.y)}; }
    return a;
}
__device__ __forceinline__ void rms_row_bf16(const float* xrow, const float* g, bf16* orow, float* hout, int lane, const float* SL = nullptr, float sc = 0.f, int m = 0) {
    f32x4 v[8]; float s = 0.f;
    const bool red = SL && m >= 8192;
#pragma unroll
    for (int j = 0; j < 8; ++j) {
        v[j] = xrow ? ((const f32x4*)xrow)[lane + 64 * j] : (f32x4){0.f, 0.f, 0.f, 0.f};
        if (red) v[j] += slab_sum(SL, m, j, lane) * sc;
        s += (v[j].x * v[j].x + v[j].y * v[j].y) + (v[j].z * v[j].z + v[j].w * v[j].w);
    }
    const float r = 1.0f / sqrtf(wave_sum(s) * (1.0f / DM) + EPS);
#pragma unroll
    for (int j = 0; j < 8; ++j) {
        if (hout) ((f32x4*)hout)[lane + 64 * j] = v[j];
        const f32x4 gg = ((const f32x4*)g)[lane + 64 * j];
        const unsigned lo = pk2(v[j].x * r * gg.x, v[j].y * r * gg.y), hi = pk2(v[j].z * r * gg.z, v[j].w * r * gg.w);
        ((unsigned long long*)orow)[lane + 64 * j] = (unsigned long long)lo | ((unsigned long long)hi << 32);
    }
}
__device__ __forceinline__ void load8_bf16(const bf16* p, float (&o)[8]) { const v4u w = *(const v4u*)p; o[0] = pg8::bf_lo(w.x); o[1] = pg8::bf_hi(w.x); o[2] = pg8::bf_lo(w.y); o[3] = pg8::bf_hi(w.y); o[4] = pg8::bf_lo(w.z); o[5] = pg8::bf_hi(w.z); o[6] = pg8::bf_lo(w.w); o[7] = pg8::bf_hi(w.w); }
__device__ __forceinline__ void load8_f32(const float* p, float (&o)[8]) { const f32x4 a = ((const f32x4*)p)[0], b = ((const f32x4*)p)[1]; o[0] = a.x; o[1] = a.y; o[2] = a.z; o[3] = a.w; o[4] = b.x; o[5] = b.y; o[6] = b.z; o[7] = b.w; }
__device__ __forceinline__ void store8_f32(float* p, const float (&o)[8]) { ((f32x4*)p)[0] = (f32x4){o[0], o[1], o[2], o[3]}; ((f32x4*)p)[1] = (f32x4){o[4], o[5], o[6], o[7]}; }


__device__ __forceinline__ void acc8_bf16(const v4u& w, float msk, float (&s)[8]) {
    s[0] += msk * pg8::bf_lo(w.x); s[1] += msk * pg8::bf_hi(w.x); s[2] += msk * pg8::bf_lo(w.y); s[3] += msk * pg8::bf_hi(w.y);
    s[4] += msk * pg8::bf_lo(w.z); s[5] += msk * pg8::bf_hi(w.z); s[6] += msk * pg8::bf_lo(w.w); s[7] += msk * pg8::bf_hi(w.w);
}
template <bool SMP>
__device__ __forceinline__ void p3b_row(const Args& a, int m, int lane, bf16* BG, const bf16* CV, const bf16* Z, bf16* PL) {
    int sq, t;
    if (SMP) { sq = (m - MP_ROWS) >> 3; t = (m - MP_ROWS) & 7; } else { sq = m / LP; t = m - sq * LP; }
    constexpr int L = SMP ? DECS : LP;
    const float* sc = a.state_conv + (size_t)sq * 2 * DM;
    const float* sp = a.state_pool + (size_t)sq * 15 * DPOOL;
    float* ncv = (t >= L - 2) ? a.out + (SMP ? O_NCS : O_NCP) + ((size_t)sq * 2 + (t - (L - 2))) * DM : nullptr;
    const float m1 = t >= 1 ? 1.f : 0.f, m2 = t >= 2 ? 1.f : 0.f;
    const int r1 = t >= 1 ? m - 1 : m, r2 = t >= 2 ? m - 2 : m;
#pragma unroll 2
    for (int j = 0; j < 4; ++j) {
        const int col = 512 * j + 8 * lane;
        float c0[8], c1[8], c2[8], bg[8], w0[8], w1[8], w2[8], o[8];
        load8_bf16(CV + (size_t)m * DM + col, c2); load8_bf16(CV + (size_t)r1 * DM + col, c1); load8_bf16(CV + (size_t)r2 * DM + col, c0);
        load8_bf16(BG + (size_t)m * DM + col, bg);
        load8_f32(a.conv_w + col, w0); load8_f32(a.conv_w + DM + col, w1); load8_f32(a.conv_w + 2 * DM + col, w2);
#pragma unroll
        for (int e = 0; e < 8; ++e) { c1[e] *= m1; c0[e] *= m2; }
        if (SMP) {
            float s1[8], s0[8];
            load8_f32(sc + (size_t)DM + col, s1); load8_f32(sc + (size_t)(t == 1 ? DM : 0) + col, s0);
#pragma unroll
            for (int e = 0; e < 8; ++e) { c1[e] += (1.f - m1) * s1[e]; c0[e] += (1.f - m2) * s0[e]; }
        }
#pragma unroll
        for (int e = 0; e < 8; ++e) o[e] = bg[e] * (w0[e] * c0[e] + w1[e] * c1[e] + w2[e] * c2[e]);
        v4u w; w.x = pk2(o[0], o[1]); w.y = pk2(o[2], o[3]); w.z = pk2(o[4], o[5]); w.w = pk2(o[6], o[7]);
        *(v4u*)(BG + (size_t)m * DM + col) = w;
        if (ncv) store8_f32(ncv + col, c2);
    }
    float* npp = nullptr;
    if (SMP) npp = a.out + O_NPS + ((size_t)sq * 15 + 7 + t) * DPOOL; else if (t >= L - 15) npp = a.out + O_NPP + ((size_t)sq * 15 + (t - (L - 15))) * DPOOL;
#pragma unroll
    for (int j = 0; j < 2; ++j) {
        const int col = 512 * j + 8 * lane, gq = col >> 8, k = 2 << gq;
        float z0[8], s[8];
        load8_bf16(Z + (size_t)m * DPOOL + col, z0);
#pragma unroll
        for (int e = 0; e < 8; ++e) s[e] = z0[e];
        if (j == 0) {
#pragma unroll
            for (int i = 1; i < 4; ++i) { const bool in = t - i >= 0; const v4u w = *(const v4u*)(Z + (size_t)(in ? m - i : m) * DPOOL + col); acc8_bf16(w, (in && i < k) ? 1.f : 0.f, s); }
            if (SMP) {
#pragma unroll
                for (int i = 1; i < 4; ++i) { const bool st = t - i < 0; float q[8]; load8_f32(sp + (size_t)(st ? 15 + t - i : 0) * DPOOL + col, q); const float mk = (st && i < k) ? 1.f : 0.f;
#pragma unroll
                    for (int e = 0; e < 8; ++e) s[e] += mk * q[e]; }
            }
        } else {
#pragma unroll
            for (int i = 1; i < 16; ++i) { const bool in = t - i >= 0; const v4u w = *(const v4u*)(Z + (size_t)(in ? m - i : m) * DPOOL + col); acc8_bf16(w, (in && i < k) ? 1.f : 0.f, s); }
            if (SMP) {
#pragma unroll
                for (int i = 1; i < 16; ++i) { const bool st = t - i < 0; float q[8]; load8_f32(sp + (size_t)(st ? 15 + t - i : 0) * DPOOL + col, q); const float mk = (st && i < k) ? 1.f : 0.f;
#pragma unroll
                    for (int e = 0; e < 8; ++e) s[e] += mk * q[e]; }
            }
        }
        const int cnt = SMP ? k : (k < t + 1 ? k : t + 1);
        const float inv = 1.0f / (float)cnt;
        float o[8];
#pragma unroll
        for (int e = 0; e < 8; ++e) o[e] = s[e] * inv - z0[e];
        v4u w; w.x = pk2(o[0], o[1]); w.y = pk2(o[2], o[3]); w.z = pk2(o[4], o[5]); w.w = pk2(o[6], o[7]);
        *(v4u*)(PL + (size_t)m * DPOOL + col) = w;
        if (npp) store8_f32(npp + col, z0);
        if (SMP && t < 7) { float q[8]; load8_f32(sp + (size_t)(8 + t) * DPOOL + col, q); store8_f32(a.out + O_NPS + ((size_t)sq * 15 + t) * DPOOL + col, q); }
    }
}

constexpr int NI_GU = (DM / 64) * (DFF / 64), NI_D = (DFF / 64) * (DM / 64), NI_IN = (DM / 64) * (DIN / 64), NI_SQ = (DM / 64) * (DM / 64), NI_PG = (256 / 64) * (512 / 64);
constexpr int IT_W1G = 0, IT_W1D = 2 * NI_GU, IT_WCO = IT_W1D + NI_D + NI_IN, IT_W2G = IT_WCO + 2 * NI_SQ + 4 * NI_PG, IT_W2D = IT_W2G + 2 * NI_GU, IT_END = IT_W2D + NI_D;
__device__ __forceinline__ void convert_items(const Args& a, unsigned char* ws, int it_lo, int it_hi, int widx, int nw, LAS unsigned char* lds, int wave, int lane) {
    LAS float* scr = (LAS float*)(lds + wave * 16640);
    bf16 *W1GU = (bf16*)(ws + WS_W1GU), *W1D = (bf16*)(ws + WS_W1D), *WIN = (bf16*)(ws + WS_WIN), *WCO = (bf16*)(ws + WS_WCO), *WPG = (bf16*)(ws + WS_WPG), *WO = (bf16*)(ws + WS_WO),
         *W2GU = (bf16*)(ws + WS_W2GU), *W2D = (bf16*)(ws + WS_W2D);
    for (int it = it_lo + widx; it < it_hi; it += nw) {
        int r = it;
        if (p0_job(r, a.w1g, DM, DFF, W1GU, 1, 0, scr, lane)) continue;
        if (p0_job(r, a.w1u, DM, DFF, W1GU, 2, 0, scr, lane)) continue;
        if (p0_job(r, a.w1d, DFF, DM, W1D, 0, 0, scr, lane)) continue;
        if (p0_job(r, a.w_in, DM, DIN, WIN, 3, 0, scr, lane)) continue;
        if (p0_job(r, a.w_conv_out, DM, DM, WCO, 0, 0, scr, lane)) continue;
        if (p0_job(r, a.w_o, DM, DM, WO, 0, 0, scr, lane)) continue;
        if (p0_job(r, a.w_pool + 0 * 256 * 512, 256, 512, WPG, 0, 0, scr, lane)) continue;
        if (p0_job(r, a.w_pool + 1 * 256 * 512, 256, 512, WPG, 0, 512, scr, lane)) continue;
        if (p0_job(r, a.w_pool + 2 * 256 * 512, 256, 512, WPG, 0, 1024, scr, lane)) continue;
        if (p0_job(r, a.w_pool + 3 * 256 * 512, 256, 512, WPG, 0, 1536, scr, lane)) continue;
        if (p0_job(r, a.w2g, DM, DFF, W2GU, 1, 0, scr, lane)) continue;
        if (p0_job(r, a.w2u, DM, DFF, W2GU, 2, 0, scr, lane)) continue;
        p0_job(r, a.w2d, DFF, DM, W2D, 0, 0, scr, lane);
    }
}

#define XB_TMO      128
#define XB_XCNT(j)  (256  + 64 * (j))
#define XB_XSUB(j)  (1280 + 64 * (j))
#define XB_XGEN(j)  (2304 + 64 * (j))
#define XB_TOP      3328
#define XB_TOPGEN   3392
#define XCD_BAR_WORDS 3456
#define XB_SPIN_CAP (1u << 18)

__device__ __forceinline__ unsigned xb_ld(unsigned* p)              { return __hip_atomic_load(p, __ATOMIC_RELAXED, __HIP_MEMORY_SCOPE_AGENT); }
__device__ __forceinline__ unsigned xb_add(unsigned* p, unsigned v) { return __hip_atomic_fetch_add(p, v, __ATOMIC_RELAXED, __HIP_MEMORY_SCOPE_AGENT); }
__device__ __forceinline__ unsigned xb_xcc_id() { return (unsigned)__builtin_amdgcn_s_getreg((3 << 11) | 20) & 0xFu; }
#define XB_SPIN(cond, bar) do { unsigned _sp = 0; while (cond) { __builtin_amdgcn_s_sleep(1); \
    if ((++_sp & 255u) == 0u) { if (xb_ld(&(bar)[XB_TMO])) break; if (_sp > XB_SPIN_CAP) { atomicAdd(&(bar)[XB_TMO], 1u); break; } } } } while (0)

struct XcdBarrier {
    unsigned* bar; unsigned x;
    volatile LAS unsigned* st;
};

__device__ __forceinline__ XcdBarrier xcd_barrier_post(unsigned* bar, volatile LAS unsigned* st) {
    XcdBarrier b; b.bar = bar; b.x = xb_xcc_id(); b.st = st;
    if (threadIdx.x == 0) (void)xb_add(&bar[XB_XCNT(b.x)], 1u);
    return b;
}
__device__ __forceinline__ void xcd_barrier_complete(unsigned* bar, unsigned x, unsigned& nloc, unsigned& nx) {
    const unsigned G = gridDim.x * gridDim.y * gridDim.z;
    unsigned sum, cnt, mine, sp = 0u;
    for (;;) {
        sum = 0u; cnt = 0u; mine = 0u;
#pragma unroll
        for (unsigned j = 0; j < 16; ++j) { const unsigned c = xb_ld(&bar[XB_XCNT(j)]); sum += c; cnt += (c > 0u) ? 1u : 0u; mine = (j == x) ? c : mine; }
        if (sum == G) break;
        __builtin_amdgcn_s_sleep(1);
        if ((++sp & 255u) == 0u) { if (xb_ld(&bar[XB_TMO])) break; if (sp > XB_SPIN_CAP) { atomicAdd(&bar[XB_TMO], 1u); break; } }
    }
    nloc = mine > 0u ? mine : 1u; nx = cnt > 0u ? cnt : 1u;
}

__device__ __forceinline__ void xcd_barrier(const XcdBarrier& b) {
    asm volatile("s_waitcnt vmcnt(0)" ::: "memory");
    __syncthreads();
    if (threadIdx.x == 0) {
        unsigned* bar = b.bar;
        __builtin_amdgcn_s_waitcnt(0);
        unsigned nloc = b.st[0], nx = b.st[1];
        if (nloc == 0u) { xcd_barrier_complete(bar, b.x, nloc, nx); b.st[0] = nloc; b.st[1] = nx; }
        const unsigned old = xb_add(&bar[XB_XSUB(b.x)], 1u);
        const unsigned gen = old / nloc;
        if (old + 1u == (gen + 1u) * nloc) {
            __builtin_amdgcn_fence(__ATOMIC_RELEASE, "agent");
            asm volatile("s_waitcnt vmcnt(0)" ::: "memory");
            const unsigned og = xb_add(&bar[XB_TOP], 1u);
            const unsigned tg = og / nx;
            if (og + 1u == (tg + 1u) * nx) xb_add(&bar[XB_TOPGEN], 1u);
            else XB_SPIN(xb_ld(&bar[XB_TOPGEN]) == tg, bar);
            __builtin_amdgcn_fence(__ATOMIC_ACQUIRE, "agent");
            xb_add(&bar[XB_XGEN(b.x)], 1u);
            asm volatile("s_waitcnt vmcnt(0)" ::: "memory");
        } else {
            XB_SPIN(xb_ld(&bar[XB_XGEN(b.x)]) == gen, bar);
            __builtin_amdgcn_fence(__ATOMIC_ACQUIRE, "agent");
            asm volatile("s_waitcnt vmcnt(0)" ::: "memory");
        }
    }
    __syncthreads();
}

__global__ void __launch_bounds__(NWAVES * 64) fwd_megakernel(Args a) {
    extern __shared__ __attribute__((aligned(16))) unsigned char lds_raw[];
    cg::grid_group grid = cg::this_grid();
    LAS unsigned char* lds = (LAS unsigned char*)lds_raw;
    const int tid = threadIdx.x, lane = tid & 63, wave = __builtin_amdgcn_readfirstlane(tid >> 6);
    const int G = gridDim.x, bx = blockIdx.x;
    const int gw = bx * NWAVES + wave, NGW = G * NWAVES;
#define FOR_ROWS(m, total) for (int it_ = 0, m = gw; (it_ < 4) || ((m = 8192 + bx + G * (wave + NWAVES * (it_ - 4))) < (total)); ++it_, m = gw + it_ * NGW)
    unsigned char* ws = a.ws;
    bf16 *W1GU = (bf16*)(ws + WS_W1GU), *W1D = (bf16*)(ws + WS_W1D), *WIN = (bf16*)(ws + WS_WIN), *WCO = (bf16*)(ws + WS_WCO), *WPG = (bf16*)(ws + WS_WPG), *WO = (bf16*)(ws + WS_WO),
         *W2GU = (bf16*)(ws + WS_W2GU), *W2D = (bf16*)(ws + WS_W2D);
    float* H = (float*)(ws + WS_H);
    bf16 *ACT = (bf16*)(ws + WS_R), *BG = (bf16*)(ws + WS_BG), *CV = (bf16*)(ws + WS_CV), *SGC = (bf16*)(ws + WS_SGC), *SGP = (bf16*)(ws + WS_SGP), *Z = (bf16*)(ws + WS_Z), *PL = (bf16*)(ws + WS_PL);
    bf16 *XN1 = (bf16*)(ws + WS_XN1), *XN = (bf16*)(ws + WS_W1GU);
    float* SLAB = (float*)(ws + WS_SGP);
    volatile LAS unsigned* MISC = (volatile LAS unsigned*)(lds + LDS_BYTES - 128);
    if (tid < 32) MISC[tid] = 0u;
    unsigned* barw = (unsigned*)ws;
    if (bx == 0) for (int i = tid; i < XCD_BAR_WORDS; i += NWAVES * 64) __hip_atomic_store(barw + i, 0u, __ATOMIC_RELAXED, __HIP_MEMORY_SCOPE_AGENT);
    __syncthreads();

    {
        convert_items(a, ws, IT_W1G, IT_W1D, gw, NGW, lds, wave, lane);
        for (int m = gw; m < MPAD; m += NGW) rms_row_bf16(src_row(a, m), a.norm_ffn1, XN1 + (size_t)m * DM, nullptr, lane);
    }
    grid.sync();
    const XcdBarrier bar = xcd_barrier_post(barw, MISC + 8);

    {
        pg8::Gemm g{XN1, W1GU, MPAD, 2 * DFF, DM, DM, DM, 0}; pg8::StaticOrder S; S.init(MPAD, 2 * DFF, DM, G, bx);
        pg8::EpiSwiglu E{ACT, DFF};
        pg8::gemm_phase<pg8::EpiSwiglu, pg8::StaticOrder, true, true>(lds, g, S, E);
        constexpr int FULL = (MPAD / 256) * (2 * DFF / 256) % 256;
        if (bx >= FULL) convert_items(a, ws, IT_W1D, IT_WCO, (bx - FULL) * NWAVES + wave, (G - FULL) * NWAVES, lds, wave, lane);
    }
    xcd_barrier(bar);
    {
        pg8::Gemm g{ACT, W1D, MPAD, DM, DFF, DFF, DFF, 0}; pg8::TailOrder S; S.init(DFF, bx);
        pg8::EpiResid<true> E{H, DM, 0.5f, SLAB, a.x_prompt, a.x_sample, a.meta};
        pg8::gemm_phase<pg8::EpiResid<true>, pg8::TailOrder, true, true>(lds, g, S, E);
    }
    xcd_barrier(bar);
    FOR_ROWS(m, MPAD) { float* hr = H + (size_t)m * DM; if (m < 8192) rms_row_bf16(hr, a.norm_mix, XN + (size_t)m * DM, nullptr, lane); else rms_row_bf16(src_row(a, m), a.norm_mix, XN + (size_t)m * DM, hr, lane, SLAB, 0.5f, m); }
    xcd_barrier(bar);
    {
        pg8::Gemm g{XN, WIN, MPAD, DIN, DM, DM, DM, 0}; pg8::StaticOrder S; S.init(MPAD, DIN, DM, G, bx);
        pg8::EpiProj E{BG, CV, Z, SGC, SGP};
        pg8::gemm_phase<pg8::EpiProj, pg8::StaticOrder, true, true>(lds, g, S, E);
        constexpr int FULL = (MPAD / 256) * (DIN / 256) % 256;
        if (bx >= FULL) convert_items(a, ws, IT_WCO, IT_W2G, (bx - FULL) * NWAVES + wave, (G - FULL) * NWAVES, lds, wave, lane);
    }
    xcd_barrier(bar);
    FOR_ROWS(m, MREAL) {
        if (m >= MP_ROWS) p3b_row<true>(a, m, lane, BG, CV, Z, PL); else p3b_row<false>(a, m, lane, BG, CV, Z, PL);
    }
    xcd_barrier(bar);
    {
        pg8::Gemm g{PL, WPG, MPAD, DM, 256, DPOOL, 256, 1}; pg8::StaticOrder S; S.init(MPAD, DM, 256, G, bx);
        pg8::EpiPool E{SGP, a.pool_scale};
        pg8::gemm_phase<pg8::EpiPool, pg8::StaticOrder, true, true>(lds, g, S, E);
    }
    __syncthreads();
    {
        pg8::Gemm g{BG, WCO, MPAD, DM, DM, DM, DM, 0}; pg8::StaticOrder S; S.init(MPAD, DM, DM, G, bx);
        pg8::EpiMerge E{SGC, SGP};
        pg8::gemm_phase<pg8::EpiMerge, pg8::StaticOrder, true, true>(lds, g, S, E);
        constexpr int FULL = (MPAD / 256) * (DM / 256) % 256;
        if (bx >= FULL) convert_items(a, ws, IT_W2G, IT_W2D, (bx - FULL) * NWAVES + wave, (G - FULL) * NWAVES, lds, wave, lane);
    }
    xcd_barrier(bar);
    {
        pg8::Gemm g{SGC, WO, MPAD, DM, DM, DM, DM, 0}; pg8::TailOrder S; S.init(DM, bx);
        pg8::EpiResid<false> E{H, DM, 1.0f, SLAB, nullptr, nullptr, nullptr};
        pg8::gemm_phase<pg8::EpiResid<false>, pg8::TailOrder, true, true>(lds, g, S, E);
    }
    xcd_barrier(bar);
    FOR_ROWS(m, MPAD) { float* hr = H + (size_t)m * DM; if (m < 8192) rms_row_bf16(hr, a.norm_ffn2, XN + (size_t)m * DM, nullptr, lane); else rms_row_bf16(hr, a.norm_ffn2, XN + (size_t)m * DM, hr, lane, SLAB, 1.0f, m); }
    xcd_barrier(bar);
    {
        pg8::Gemm g{XN, W2GU, MPAD, 2 * DFF, DM, DM, DM, 0}; pg8::StaticOrder S; S.init(MPAD, 2 * DFF, DM, G, bx);
        pg8::EpiSwiglu E{ACT, DFF};
        pg8::gemm_phase<pg8::EpiSwiglu, pg8::StaticOrder, true, true>(lds, g, S, E);
        constexpr int FULL = (MPAD / 256) * (2 * DFF / 256) % 256;
        if (bx >= FULL) convert_items(a, ws, IT_W2D, IT_END, (bx - FULL) * NWAVES + wave, (G - FULL) * NWAVES, lds, wave, lane);
    }
    xcd_barrier(bar);
    {
        pg8::Gemm g{ACT, W2D, MPAD, DM, DFF, DFF, DFF, 0}; pg8::TailOrder S; S.init(DFF, bx);
        pg8::EpiResid<false> E{H, DM, 0.5f, SLAB, nullptr, nullptr, nullptr};
        pg8::gemm_phase<pg8::EpiResid<false>, pg8::TailOrder, true, true>(lds, g, S, E);
    }
    xcd_barrier(bar);
    FOR_ROWS(m, MREAL) {
        float* dst;
        if (m < MP_ROWS) { const int b = m / LP, t = m - b * LP; if (t < NMETA) continue; dst = a.out + O_YP + ((size_t)b * SEQ + (t - NMETA)) * DM; }
        else dst = a.out + O_YS + (size_t)(m - MP_ROWS) * DM;
        const float* hr = H + (size_t)m * DM;
        f32x4 v[8]; float s = 0.f;
#pragma unroll
        for (int j = 0; j < 8; ++j) { v[j] = ((const f32x4*)hr)[lane + 64 * j]; if (m >= 8192) v[j] += slab_sum(SLAB, m, j, lane) * 0.5f; s += (v[j].x * v[j].x + v[j].y * v[j].y) + (v[j].z * v[j].z + v[j].w * v[j].w); }
        const float r = 1.0f / sqrtf(wave_sum(s) * (1.0f / DM) + EPS);
#pragma unroll
        for (int j = 0; j < 8; ++j) { const f32x4 gg = ((const f32x4*)a.norm_final)[lane + 64 * j]; ((f32x4*)dst)[lane + 64 * j] = v[j] * r * gg; }
    }
}

extern "C" void kernel_launch(void* const* d_in, const int* in_sizes, int n_in, void* d_out, int out_size, void* d_ws, size_t ws_size, hipStream_t stream) {
    static int grid = 0;
    if (grid == 0) {
        if (n_in != 21 || (size_t)out_size != O_END || ws_size < WS_END) { fprintf(stderr, "kernel_launch: unexpected shapes: n_in %d out %d ws %zu (need %zu)\n", n_in, out_size, ws_size, (size_t)WS_END); grid = -1; return; }
        int dev = 0, cus = 0, per_cu = 0;
        hipGetDevice(&dev); hipDeviceGetAttribute(&cus, hipDeviceAttributeMultiprocessorCount, dev);
        if (hipFuncSetAttribute((const void*)fwd_megakernel, hipFuncAttributeMaxDynamicSharedMemorySize, LDS_BYTES) != hipSuccess) { fprintf(stderr, "kernel_launch: hipFuncSetAttribute failed\n"); grid = -1; return; }
        if (hipOccupancyMaxActiveBlocksPerMultiprocessor(&per_cu, (const void*)fwd_megakernel, NWAVES * 64, LDS_BYTES) != hipSuccess || per_cu < 1) { fprintf(stderr, "kernel_launch: occupancy query failed (%d)\n", per_cu); (void)hipGetLastError(); per_cu = 1; }
        grid = cus * 1;
        fprintf(stderr, "kernel_launch: grid %d (cus %d, per_cu %d)\n", grid, cus, per_cu);
    }
    if (grid < 0) return;
    Args a{};
    a.x_prompt = (const float*)d_in[0]; a.x_sample = (const float*)d_in[1]; a.state_conv = (const float*)d_in[2]; a.state_pool = (const float*)d_in[3]; a.meta = (const float*)d_in[4];
    a.norm_ffn1 = (const float*)d_in[5]; a.w1g = (const float*)d_in[6]; a.w1u = (const float*)d_in[7]; a.w1d = (const float*)d_in[8]; a.norm_mix = (const float*)d_in[9]; a.w_in = (const float*)d_in[10];
    a.conv_w = (const float*)d_in[11]; a.w_conv_out = (const float*)d_in[12]; a.w_pool = (const float*)d_in[13]; a.pool_scale = (const float*)d_in[14]; a.w_o = (const float*)d_in[15];
    a.norm_ffn2 = (const float*)d_in[16]; a.w2g = (const float*)d_in[17]; a.w2u = (const float*)d_in[18]; a.w2d = (const float*)d_in[19]; a.norm_final = (const float*)d_in[20];
    a.out = (float*)d_out; a.ws = (unsigned char*)d_ws;
    void* args[] = {&a};
    hipError_t e = hipLaunchCooperativeKernel((const void*)fwd_megakernel, dim3(grid), dim3(NWAVES * 64), args, LDS_BYTES, stream);
    if (e != hipSuccess) fprintf(stderr, "kernel_launch: cooperative launch failed: %s (grid %d)\n", hipGetErrorString(e), grid);
}
```

```cpp
#include <hip/hip_runtime.h>
#include <hip/hip_cooperative_groups.h>
#include <cstdio>
#include <cstdint>
namespace cg = cooperative_groups;

namespace pg8 {
#define PG8_LAS __attribute__((address_space(3)))
typedef unsigned short bf16_t;
typedef short bf16x8 __attribute__((ext_vector_type(8)));
typedef float f32x4 __attribute__((ext_vector_type(4)));
typedef unsigned u32x4 __attribute__((ext_vector_type(4)));
constexpr int BM = 256, BK = 64, HALF = 128, HTB = HALF * BK * 2  , STAGE_BYTES = 8 * HTB, NXCD = 8, WGM = 8;

__host__ __device__ __forceinline__ int lds_byte(int r, int c) { const int st = (r >> 4) * 2 + (c >> 5), rr = r & 15, cc = c & 31, ob = rr * 64 + cc * 2; return st * 1024 + (ob ^ (((ob >> 9) & 1) << 5)); }
__host__ __device__ __forceinline__ void stage_rc(int b, int& R, int& C) { const int st = b / 1024, sb = b % 1024, swz = sb ^ (((sb >> 9) & 1) << 5); R = (st >> 1) * 16 + swz / 64; C = (st & 1) * 32 + (swz % 64) / 2; }
__host__ __device__ __forceinline__ int perm32(int rho) { const int n = rho >> 4, i = rho & 15; return 8 * (i >> 2) + 4 * n + (i & 3); }

struct Unit { int pm, pn, kt0, nkt, slab; };
struct Gemm { const bf16_t* A; const bf16_t* Bt; int M, N, K, lda, ldb, agrp; };
__device__ __forceinline__ size_t acolb(const Gemm& g, const Unit& u) { return g.agrp ? (size_t)((u.pn >> 1) * 256) * 2 : (size_t)0; }

struct StaticOrder {
    int nM, nN, nwg, G, c, nt;
    __host__ __device__ void init(int M, int N, int K, int G_, int c_) { nM = M / BM; nN = N / BM; nwg = nM * nN; G = G_; c = c_; nt = K / BK; }
    __host__ __device__ bool next(int i, Unit& u) const {
        const long L = (long)i * G + c; if (L >= nwg) return false;
        int wgid = (int)L; { const int q = nwg / NXCD, r = nwg % NXCD, xcd = wgid % NXCD, off = wgid / NXCD; wgid = (xcd < r ? xcd * (q + 1) : r * (q + 1) + (xcd - r) * q) + off; }
        const int nig = WGM * nN, gid = wgid / nig, fm = gid * WGM, gsz = (nM - fm) < WGM ? (nM - fm) : WGM;
        u.pm = fm + ((wgid % nig) % gsz); u.pn = (wgid % nig) / gsz; u.kt0 = 0; u.nkt = nt; u.slab = -1; return true;
    }
    __device__ __forceinline__ void a_ready(const Unit&) const {}
    __device__ __forceinline__ void done(const Unit&) const {}
};
struct TailOrder {
    int c, nt;
    __host__ __device__ void init(int K, int c_) { c = c_; nt = K / BK; }
    __host__ __device__ bool next(int i, Unit& u) const {
        if (i == 0) { const int x = c & 7, idx = c >> 3; u.pm = 4 * x + (idx >> 3); u.pn = idx & 7; u.kt0 = 0; u.nkt = nt; u.slab = -1; return true; }
        if (i == 1 && c < 240) {
            const int x = c & 7, idx = c >> 3, q = idx / 6, r6 = idx - 6 * q, ch = x < 6 ? x : r6, pn = x < 6 ? r6 : x;
            const int np = nt >> 1, base = np / 6, rem = np % 6, p0 = ch * base + (ch < rem ? ch : rem), pc = base + (ch < rem ? 1 : 0);
            u.pm = 32 + q; u.pn = pn; u.kt0 = 2 * p0; u.nkt = 2 * pc; u.slab = (q * 8 + pn) * 6 + ch; return true; }
        return false;
    }
    __device__ __forceinline__ void a_ready(const Unit&) const {}
    __device__ __forceinline__ void done(const Unit&) const {}
};

__device__ __forceinline__ unsigned cvt_pk_bf16(float lo, float hi) { unsigned r; asm volatile("v_cvt_pk_bf16_f32 %0, %1, %2" : "=v"(r) : "v"(lo), "v"(hi)); return r; }
__device__ __forceinline__ float bf_lo(unsigned w) { return __uint_as_float(w << 16); }
__device__ __forceinline__ float bf_hi(unsigned w) { return __uint_as_float(w & 0xffff0000u); }
__device__ __forceinline__ float sigmoidf_(float x) { return __builtin_amdgcn_rcpf(1.0f + __builtin_amdgcn_exp2f(-1.4426950408889634f * x)); }
__device__ __forceinline__ u32x4 pack8(const f32x4& a, const f32x4& b) { u32x4 w; w.x = cvt_pk_bf16(a[0], a[1]); w.y = cvt_pk_bf16(a[2], a[3]); w.z = cvt_pk_bf16(b[0], b[1]); w.w = cvt_pk_bf16(b[2], b[3]); return w; }
__device__ __forceinline__ void unpack8(const u32x4& w, f32x4& a, f32x4& b) { a = (f32x4){bf_lo(w.x), bf_hi(w.x), bf_lo(w.y), bf_hi(w.y)}; b = (f32x4){bf_lo(w.z), bf_hi(w.z), bf_lo(w.w), bf_hi(w.w)}; }

struct EpiSwiglu {
    static constexpr bool PERM = true, AFTER_DRAIN = false;
    bf16_t* O; int ldc;
    __device__ __forceinline__ void operator()(const f32x4 (&acc)[2][2][4][2], const Unit& u, int wr, int wc, int fr, int fq) const {
        const int row0 = u.pm * BM + wr * 64 + fr, col0 = u.pn * HALF + wc * 32 + 8 * fq;
#pragma unroll
        for (int ai = 0; ai < 2; ++ai)
#pragma unroll
            for (int m = 0; m < 4; ++m) {
                f32x4 v[2];
#pragma unroll
                for (int n = 0; n < 2; ++n) { const f32x4 gt = acc[ai][0][m][n], up = acc[ai][1][m][n];
#pragma unroll
                    for (int e = 0; e < 4; ++e) v[n][e] = gt[e] * sigmoidf_(gt[e]) * up[e]; }
                *(u32x4*)(O + (size_t)(row0 + ai * HALF + m * 16) * ldc + col0) = pack8(v[0], v[1]);
            }
    }
};
template <bool FROMX> struct EpiResid {
    static constexpr bool PERM = true, AFTER_DRAIN = false;
    float* H; int ldc; float s; float* SL;
    const float *xp, *xs, *meta;
    __device__ __forceinline__ void operator()(const f32x4 (&acc)[2][2][4][2], const Unit& u, int wr, int wc, int fr, int fq) const {
        if (u.slab >= 0) {
            bf16_t* base = (bf16_t*)SL + (size_t)u.slab * (BM * BM) + (size_t)(wr * 64 + fr) * BM + wc * 32 + 8 * fq;
#pragma unroll
            for (int ai = 0; ai < 2; ++ai)
#pragma unroll
                for (int m = 0; m < 4; ++m)
#pragma unroll
                    for (int bj = 0; bj < 2; ++bj) *(u32x4*)(base + (size_t)(ai * HALF + m * 16) * BM + bj * HALF) = pack8(acc[ai][bj][m][0], acc[ai][bj][m][1]);
            return;
        }
        const int row0 = u.pm * BM + wr * 64 + fr, col0 = u.pn * BM + wc * 32 + 8 * fq;
#pragma unroll
        for (int ai = 0; ai < 2; ++ai)
#pragma unroll
            for (int m = 0; m < 4; ++m) { const int r = row0 + ai * HALF + m * 16; float* rowp = H + (size_t)r * ldc + col0;
                const float* srcp = rowp;
                if (FROMX) {
                    const int b = r / 2064, t = r - b * 2064;
                    srcp = (t < 16 ? meta + (size_t)t * 2048 : xp + ((size_t)b * 2048 + (t - 16)) * 2048) + col0;
                }
#pragma unroll
                for (int bj = 0; bj < 2; ++bj)
#pragma unroll
                    for (int n = 0; n < 2; ++n) { const f32x4 h = *(const f32x4*)(srcp + bj * HALF + n * 4); *(f32x4*)(rowp + bj * HALF + n * 4) = h + acc[ai][bj][m][n] * s; }
                if (m & 1) asm volatile("" ::: "memory"); }
    }
};
struct EpiProj {
    static constexpr bool PERM = true, AFTER_DRAIN = false;
    bf16_t *BG, *CV, *Z, *SGC, *SGP;
    __device__ __forceinline__ void operator()(const f32x4 (&acc)[2][2][4][2], const Unit& u, int wr, int wc, int fr, int fq) const {
        const int row0 = u.pm * BM + wr * 64 + fr, pn = u.pn;
        if (pn >= 8 && pn < 24) {
            const int col0 = (pn - 8) * HALF + wc * 32 + 8 * fq;
#pragma unroll
            for (int ai = 0; ai < 2; ++ai)
#pragma unroll
                for (int m = 0; m < 4; ++m)
                    *(u32x4*)(CV + (size_t)(row0 + ai * HALF + m * 16) * 2048 + col0) = pack8(acc[ai][0][m][0] * acc[ai][1][m][0], acc[ai][0][m][1] * acc[ai][1][m][1]);
        } else {
            bf16_t* base; int ld, ct; bool sg;
            if (pn < 8) { base = BG; ld = 2048; ct = pn; sg = false; }
            else if (pn < 28) { base = Z; ld = 1024; ct = pn - 24; sg = false; }
            else if (pn < 36) { base = SGC; ld = 2048; ct = pn - 28; sg = true; }
            else { base = SGP; ld = 2048; ct = pn - 36; sg = true; }
            const int col0 = ct * BM + wc * 32 + 8 * fq;
#pragma unroll
            for (int ai = 0; ai < 2; ++ai)
#pragma unroll
                for (int m = 0; m < 4; ++m) { bf16_t* rowp = base + (size_t)(row0 + ai * HALF + m * 16) * ld + col0;
#pragma unroll
                    for (int bj = 0; bj < 2; ++bj) { f32x4 v0 = acc[ai][bj][m][0], v1 = acc[ai][bj][m][1];
                        if (sg) {
#pragma unroll
                            for (int e = 0; e < 4; ++e) { v0[e] = sigmoidf_(v0[e]); v1[e] = sigmoidf_(v1[e]); } }
                        *(u32x4*)(rowp + bj * HALF) = pack8(v0, v1); } }
        }
    }
};
struct EpiPool {
    static constexpr bool PERM = true, AFTER_DRAIN = false;
    bf16_t* SGP; const float* ps;
    __device__ __forceinline__ void operator()(const f32x4 (&acc)[2][2][4][2], const Unit& u, int wr, int wc, int fr, int fq) const {
        const int row0 = u.pm * BM + wr * 64 + fr, col0 = u.pn * BM + wc * 32 + 8 * fq;
#pragma unroll
        for (int ai = 0; ai < 2; ++ai)
#pragma unroll
            for (int m = 0; m < 4; ++m) { bf16_t* rowp = SGP + (size_t)(row0 + ai * HALF + m * 16) * 2048 + col0;
#pragma unroll
                for (int bj = 0; bj < 2; ++bj) { u32x4* p = (u32x4*)(rowp + bj * HALF); f32x4 g0, g1; unpack8(*p, g0, g1);
                    const f32x4 s0 = *(const f32x4*)(ps + col0 + bj * HALF), s1 = *(const f32x4*)(ps + col0 + bj * HALF + 4);
                    *p = pack8(g0 * s0 * acc[ai][bj][m][0], g1 * s1 * acc[ai][bj][m][1]); }
                asm volatile("" ::: "memory"); }
    }
};
struct EpiMerge {
    static constexpr bool PERM = true, AFTER_DRAIN = false;
    bf16_t* SGC; const bf16_t* MP;
    __device__ __forceinline__ void operator()(const f32x4 (&acc)[2][2][4][2], const Unit& u, int wr, int wc, int fr, int fq) const {
        const int row0 = u.pm * BM + wr * 64 + fr, col0 = u.pn * BM + wc * 32 + 8 * fq;
#pragma unroll
        for (int ai = 0; ai < 2; ++ai)
#pragma unroll
            for (int m = 0; m < 4; ++m) { const size_t off = (size_t)(row0 + ai * HALF + m * 16) * 2048 + col0;
#pragma unroll
                for (int bj = 0; bj < 2; ++bj) { u32x4* p = (u32x4*)(SGC + off + bj * HALF); f32x4 g0, g1, q0, q1; unpack8(*p, g0, g1); unpack8(*(const u32x4*)(MP + off + bj * HALF), q0, q1);
                    *p = pack8(g0 * acc[ai][bj][m][0] + q0, g1 * acc[ai][bj][m][1] + q1); }
                if (m & 1) asm volatile("" ::: "memory"); }
    }
};

template <class Epi, class Sched, bool ALIGN_EPI = false, bool SP2 = false>
__device__ __forceinline__ void gemm_phase(PG8_LAS unsigned char* lds, const Gemm g, const Sched& S, const Epi& E) {
    int tid_ = threadIdx.x; asm volatile("" : "+v"(tid_));
    const int tid = tid_, wid = __builtin_amdgcn_readfirstlane(tid >> 6), lane = tid & 63, wr = wid >> 2, wc = wid & 3, fr = lane & 15, fq = lane >> 4;

    unsigned voffA[2], voffB[2];
#pragma unroll
    for (int i = 0; i < 2; ++i) { int R, C; stage_rc(tid * 16 + i * 8192, R, C); const int Rb = Epi::PERM ? ((R & ~31) + perm32(R & 31)) : R;
        voffA[i] = (unsigned)(R * g.lda + C) * 2u; voffB[i] = (unsigned)(Rb * g.ldb + C) * 2u; }
    const size_t kstep = (size_t)(BK * 2);
    const size_t hstepA = (size_t)HALF * g.lda * 2, hstepB = (size_t)HALF * g.ldb * 2;
    const size_t tstepA = 2 * hstepA, tstepB = 2 * hstepB;
    const unsigned ldsw = (unsigned)wid * 1024u;
    const int aoff = lds_byte(wr * 64 + fr, fq * 8), boff = lds_byte(wc * 32 + fr, fq * 8);
#define PG8_SA(b, h) (((b) * 2 + (h)) * HTB)
#define PG8_SB(b, h) ((4 + (b) * 2 + (h)) * HTB)
#define PG8_STAGE(bufoff, gbase, voff) do { _Pragma("unroll") for (int _i = 0; _i < 2; ++_i) \
        __builtin_amdgcn_global_load_lds((const unsigned*)((const char*)(gbase) + (voff)[_i]), (PG8_LAS unsigned*)(lds + (bufoff) + ldsw + _i * 8192), 16, 0, 0); } while (0)
#define PG8_LDA(dst, b, h) do { _Pragma("unroll") for (int m = 0; m < 4; ++m) _Pragma("unroll") for (int k = 0; k < 2; ++k) dst[m][k] = *(const PG8_LAS bf16x8*)(lds + PG8_SA(b, h) + aoff + m * 2048 + k * 1024); } while (0)
#define PG8_LDB(dst, b, h) do { _Pragma("unroll") for (int n = 0; n < 2; ++n) _Pragma("unroll") for (int k = 0; k < 2; ++k) dst[n][k] = *(const PG8_LAS bf16x8*)(lds + PG8_SB(b, h) + boff + n * 2048 + k * 1024); } while (0)
#define PG8_MMA(ai, bj, At, Bt) do { __builtin_amdgcn_s_setprio(1); _Pragma("unroll") for (int m = 0; m < 4; ++m) _Pragma("unroll") for (int n = 0; n < 2; ++n) _Pragma("unroll") for (int k = 0; k < 2; ++k) \
        acc[ai][bj][m][n] = __builtin_amdgcn_mfma_f32_16x16x32_bf16(Bt[n][k], At[m][k], acc[ai][bj][m][n], 0, 0, 0); __builtin_amdgcn_s_setprio(0); } while (0)
#define PG8_WAIT_V(n) asm volatile("s_waitcnt vmcnt(" #n ")" ::: "memory")
#define PG8_WAIT_L(n) asm volatile("s_waitcnt lgkmcnt(" #n ")" ::: "memory")
#define PG8_BAR __builtin_amdgcn_s_barrier()
#define PG8_SCHED __builtin_amdgcn_sched_barrier(0)
    Unit cur, nxt; int ui = 0;
    if (!S.next(0, cur)) return;
    f32x4 acc[2][2][4][2];
#pragma unroll
    for (int a = 0; a < 2; ++a)
#pragma unroll
        for (int b = 0; b < 2; ++b)
#pragma unroll
            for (int m = 0; m < 4; ++m)
#pragma unroll
                for (int n = 0; n < 2; ++n) acc[a][b][m][n] = (f32x4){0.f, 0.f, 0.f, 0.f};
    bf16x8 At[4][2], B0[2][2], B1[2][2];
    const char* cA = (const char*)g.A + (size_t)cur.pm * tstepA + acolb(g, cur) + (size_t)cur.kt0 * kstep; const char* cB = (const char*)g.Bt + (size_t)cur.pn * tstepB + (size_t)cur.kt0 * kstep;
    S.a_ready(cur);
    if constexpr (SP2) {
        PG8_STAGE(PG8_SB(0, 0), cB, voffB); PG8_STAGE(PG8_SB(0, 1), cB + hstepB, voffB); PG8_STAGE(PG8_SA(0, 0), cA, voffA); PG8_STAGE(PG8_SA(0, 1), cA + hstepA, voffA);
        if (wr == 1) PG8_BAR;
        PG8_WAIT_V(2); PG8_BAR;
        PG8_STAGE(PG8_SB(1, 0), cB + kstep, voffB); PG8_STAGE(PG8_SA(1, 0), cA + kstep, voffA); PG8_STAGE(PG8_SB(1, 1), cB + hstepB + kstep, voffB);
        PG8_WAIT_V(6); PG8_BAR;
    } else {
        PG8_STAGE(PG8_SB(0, 0), cB, voffB); PG8_STAGE(PG8_SA(0, 0), cA, voffA); PG8_STAGE(PG8_SB(0, 1), cB + hstepB, voffB); PG8_STAGE(PG8_SA(0, 1), cA + hstepA, voffA);
        if (wr == 1) PG8_BAR;
        PG8_WAIT_V(4); PG8_BAR;
        PG8_STAGE(PG8_SB(1, 0), cB + kstep, voffB); PG8_STAGE(PG8_SA(1, 0), cA + kstep, voffA); PG8_STAGE(PG8_SB(1, 1), cB + hstepB + kstep, voffB);
        PG8_WAIT_V(6); PG8_BAR;
    }
    for (;;) {
        const bool has_next = S.next(ui + 1, nxt);
        const char* nA = has_next ? (const char*)g.A + (size_t)nxt.pm * tstepA + acolb(g, nxt) + (size_t)nxt.kt0 * kstep : cA; const char* nB = has_next ? (const char*)g.Bt + (size_t)nxt.pn * tstepB + (size_t)nxt.kt0 * kstep : cB;
        const int nt = cur.nkt;
        for (int t = 0; t < nt; t += 2) {
            const bool last = (t == nt - 2);
            const char* a1 = cA + (size_t)(t + 1) * kstep;
            const char* a2 = last ? nA : cA + (size_t)(t + 2) * kstep; const char* b2 = last ? nB : cB + (size_t)(t + 2) * kstep;
            const char* a3 = a2 + kstep; const char* b3 = b2 + kstep;
            if (last && has_next) S.a_ready(nxt);
            if constexpr (SP2) {
            PG8_LDB(B0, 0, 0); PG8_LDB(B1, 0, 1); PG8_SCHED; PG8_LDA(At, 0, 0); PG8_STAGE(PG8_SA(1, 1), a1 + hstepA, voffA);
            PG8_WAIT_V(8); PG8_WAIT_L(0); PG8_BAR; PG8_MMA(0, 0, At, B0); PG8_MMA(0, 1, At, B1); PG8_BAR; PG8_SCHED;
            PG8_LDA(At, 0, 1); PG8_STAGE(PG8_SB(0, 0), b2, voffB); PG8_STAGE(PG8_SB(0, 1), b2 + hstepB, voffB); PG8_STAGE(PG8_SA(0, 0), a2, voffA);
            PG8_WAIT_V(8); PG8_WAIT_L(0); PG8_BAR; PG8_MMA(1, 0, At, B0); PG8_MMA(1, 1, At, B1); PG8_BAR; PG8_SCHED;
            PG8_LDB(B0, 1, 0); PG8_LDB(B1, 1, 1); PG8_SCHED; PG8_LDA(At, 1, 0); PG8_STAGE(PG8_SA(0, 1), a2 + hstepA, voffA);
            PG8_WAIT_V(8); PG8_WAIT_L(0); PG8_BAR; PG8_MMA(0, 0, At, B0); PG8_MMA(0, 1, At, B1); PG8_BAR; PG8_SCHED;
            PG8_LDA(At, 1, 1); PG8_STAGE(PG8_SB(1, 0), b3, voffB); PG8_STAGE(PG8_SB(1, 1), b3 + hstepB, voffB); PG8_STAGE(PG8_SA(1, 0), a3, voffA);
            PG8_WAIT_V(8); PG8_WAIT_L(0); PG8_BAR; PG8_MMA(1, 0, At, B0); PG8_MMA(1, 1, At, B1); PG8_BAR; PG8_SCHED;
            } else {
            PG8_LDB(B0, 0, 0); PG8_SCHED; PG8_LDA(At, 0, 0); PG8_STAGE(PG8_SA(1, 1), a1 + hstepA, voffA);
            PG8_WAIT_L(8); PG8_BAR; PG8_WAIT_L(0); PG8_MMA(0, 0, At, B0); PG8_BAR; PG8_SCHED;
            PG8_LDB(B1, 0, 1); PG8_STAGE(PG8_SB(0, 0), b2, voffB);
            PG8_BAR; PG8_WAIT_L(0); PG8_MMA(0, 1, At, B1); PG8_BAR;
            PG8_LDA(At, 0, 1); PG8_STAGE(PG8_SA(0, 0), a2, voffA);
            PG8_BAR; PG8_WAIT_L(0); PG8_MMA(1, 0, At, B0); PG8_BAR; PG8_SCHED;
            PG8_STAGE(PG8_SB(0, 1), b2 + hstepB, voffB);
            PG8_WAIT_V(6); PG8_BAR; PG8_MMA(1, 1, At, B1); PG8_BAR;
            PG8_LDB(B0, 1, 0); PG8_SCHED; PG8_LDA(At, 1, 0); PG8_STAGE(PG8_SA(0, 1), a2 + hstepA, voffA);
            PG8_WAIT_L(8); PG8_BAR; PG8_WAIT_L(0); PG8_MMA(0, 0, At, B0); PG8_BAR; PG8_SCHED;
            PG8_LDB(B1, 1, 1); PG8_STAGE(PG8_SB(1, 0), b3, voffB);
            PG8_BAR; PG8_WAIT_L(0); PG8_MMA(0, 1, At, B1); PG8_BAR;
            PG8_LDA(At, 1, 1); PG8_STAGE(PG8_SA(1, 0), a3, voffA);
            PG8_BAR; PG8_WAIT_L(0); PG8_MMA(1, 0, At, B0); PG8_BAR; PG8_SCHED;
            PG8_STAGE(PG8_SB(1, 1), b3 + hstepB, voffB);
            PG8_WAIT_V(6); PG8_BAR; PG8_MMA(1, 1, At, B1); PG8_BAR;
            }
        }
        if constexpr (ALIGN_EPI) { if (wr == 0) PG8_BAR; }
        if constexpr (!Epi::AFTER_DRAIN) { E(acc, cur, wr, wc, fr, fq); S.done(cur); }
        if (!has_next) break;
#pragma unroll
        for (int a = 0; a < 2; ++a)
#pragma unroll
            for (int b = 0; b < 2; ++b)
#pragma unroll
                for (int m = 0; m < 4; ++m)
#pragma unroll
                    for (int n = 0; n < 2; ++n) acc[a][b][m][n] = (f32x4){0.f, 0.f, 0.f, 0.f};
        cur = nxt; cA = nA; cB = nB; ++ui;
        if constexpr (ALIGN_EPI) { if (wr == 1) PG8_BAR; }
    }
    PG8_WAIT_V(0);
    if constexpr (!ALIGN_EPI) { if (wr == 0) PG8_BAR; }
    PG8_BAR;
    if constexpr (Epi::AFTER_DRAIN) { E.fused(acc, cur, wr, wc, fr, fq, lds, wid, lane); S.done(cur); }
#undef PG8_SA
#undef PG8_SB
#undef PG8_STAGE
#undef PG8_LDA
#undef PG8_LDB
#undef PG8_MMA
#undef PG8_WAIT_V
#undef PG8_WAIT_L
#undef PG8_BAR
#undef PG8_SCHED
}
}

constexpr int DM = 2048, NB = 4, SEQ = 2048, NMETA = 16, LP = SEQ + NMETA  , DECB = 128, DECS = 8;
constexpr int DFF = 5632, DPOOL = 1024, DIN = 11264;
constexpr int MP_ROWS = NB * LP;
constexpr int MS_ROWS = DECB * DECS;
constexpr int MREAL = MP_ROWS + MS_ROWS;
constexpr int MPAD = 9472;
constexpr float EPS = 1e-6f;
constexpr int NWAVES = 8;

constexpr size_t O_YP = 0, O_YS = O_YP + (size_t)NB * SEQ * DM, O_NCP = O_YS + (size_t)MS_ROWS * DM, O_NPP = O_NCP + (size_t)NB * 2 * DM,
                 O_NCS = O_NPP + (size_t)NB * 15 * DPOOL, O_NPS = O_NCS + (size_t)DECB * 2 * DM, O_END = O_NPS + (size_t)DECB * 15 * DPOOL;

constexpr size_t MiB = 1u << 20;
constexpr size_t WS_W1GU = 1 * MiB;
constexpr size_t WS_W1D = WS_W1GU + 44 * MiB;
constexpr size_t WS_WIN = WS_W1D + 22 * MiB;
constexpr size_t WS_WCO = WS_WIN + 44 * MiB;
constexpr size_t WS_WPG = WS_WCO + 8 * MiB;
constexpr size_t WS_WO = WS_WPG + 1 * MiB;
constexpr size_t WS_W2GU = WS_WO + 8 * MiB;
constexpr size_t WS_W2D = WS_W2GU + 44 * MiB;
constexpr size_t WS_H = WS_W2D + 22 * MiB;
constexpr size_t WS_R = WS_H + 74 * MiB;
constexpr size_t WS_BG = WS_R, WS_CV = WS_R + 37 * MiB, WS_SGC = WS_R + 74 * MiB, WS_SGP = WS_R + 111 * MiB, WS_Z = WS_R + 148 * MiB, WS_PL = WS_Z + 19 * MiB;
constexpr size_t WS_XN1 = WS_SGP;
constexpr size_t WS_END = WS_PL + 19 * MiB;
static_assert((size_t)MPAD * DFF * 2 <= 111 * MiB, "ACT fits below XN1");

#define GAS __attribute__((address_space(1)))
#define LAS __attribute__((address_space(3)))
typedef unsigned short bf16;
typedef unsigned v4u __attribute__((ext_vector_type(4)));
typedef float f32x4 __attribute__((ext_vector_type(4)));
#define LDS_WAIT() asm volatile("s_waitcnt lgkmcnt(0)" ::: "memory")
constexpr int LDS_BYTES = 147456;

struct Args {
    const float *x_prompt, *x_sample, *state_conv, *state_pool, *meta, *norm_ffn1, *w1g, *w1u, *w1d, *norm_mix, *w_in, *conv_w, *w_conv_out, *w_pool, *pool_scale, *w_o, *norm_ffn2, *w2g, *w2u, *w2d, *norm_final;
    float* out; unsigned char* ws;
};

__device__ __forceinline__ unsigned pk2(float lo, float hi) { return pg8::cvt_pk_bf16(lo, hi); }
__device__ __forceinline__ float wave_sum(float v) {
#pragma unroll
    for (int o = 1; o < 64; o <<= 1) v += __shfl_xor(v, o);
    return v;
}
__device__ __forceinline__ const float* src_row(const Args& a, int r) {
    if (r < MP_ROWS) { const int b = r / LP, t = r - b * LP; return t < NMETA ? a.meta + (size_t)t * DM : a.x_prompt + ((size_t)b * SEQ + (t - NMETA)) * DM; }
    if (r < MREAL) return a.x_sample + (size_t)(r - MP_ROWS) * DM;
    return nullptr;
}
__device__ __forceinline__ void p0_transpose_item(const float* W, int N, bf16* WT, int K, int k0, int n0, int drow0, LAS float* scr, int lane) {
    const int lr = lane >> 4, lc = (lane & 15) * 4;
    f32x4 v[16];
#pragma unroll
    for (int i = 0; i < 16; ++i) v[i] = __builtin_nontemporal_load((const f32x4*)(W + (size_t)(k0 + 4 * i + lr) * N + n0 + lc));
#pragma unroll
    for (int i = 0; i < 16; ++i) { LAS float* s = scr + (4 * i + lr) * 65 + lc; s[0] = v[i].x; s[1] = v[i].y; s[2] = v[i].z; s[3] = v[i].w; }
    LDS_WAIT(); asm volatile("" ::: "memory");
    const int c = lane & 7;
#pragma unroll
    for (int j = 0; j < 8; ++j) { const int n = (lane >> 3) + 8 * j; const LAS float* s = scr + (8 * c) * 65 + n;
        v4u o; o.x = pk2(s[0 * 65], s[1 * 65]); o.y = pk2(s[2 * 65], s[3 * 65]); o.z = pk2(s[4 * 65], s[5 * 65]); o.w = pk2(s[6 * 65], s[7 * 65]);
        *(v4u*)(WT + (size_t)(drow0 + n) * K + k0 + 8 * c) = o; }
    LDS_WAIT(); asm volatile("" ::: "memory");
}
__device__ __forceinline__ bool p0_job(int& r, const float* W, int K, int N, bf16* WT, int kind, int roff, LAS float* scr, int lane) {
    const int nb = N / 64, items = (K / 64) * nb;
    if (r >= items) { r -= items; return false; }
    const int kb = r / nb, n0 = (r % nb) * 64;
    int d;
    if (kind == 0) d = roff + n0;
    else if (kind == 1) d = (n0 >> 7) * 256 + (n0 & 127);
    else if (kind == 2) d = (n0 >> 7) * 256 + 128 + (n0 & 127);
    else { if (n0 < 2048 || n0 >= 6144) d = n0; else if (n0 < 4096) { const int j = n0 - 2048; d = 2048 + (j >> 7) * 256 + (j & 127); } else { const int j = n0 - 4096; d = 2048 + (j >> 7) * 256 + 128 + (j & 127); } }
    p0_transpose_item(W, N, WT, K, kb * 64, n0, d, scr, lane);
    return true;
}
__device__ __forceinline__ f32x4 slab_sum(const float* SL, int m, int j, int lane) {
    typedef unsigned u32x2 __attribute__((ext_vector_type(2)));
    const bf16* p = (const bf16*)SL + (size_t)(((m >> 8) - 32) * 8 + j) * 6 * 65536 + (size_t)(m & 255) * 256 + 4 * lane;
    f32x4 a = (f32x4){0.f, 0.f, 0.f, 0.f};
#pragma unroll
    for (int ch = 0; ch < 6; ++ch) { const u32x2 w = __builtin_nontemporal_load((const u32x2*)(p + (size_t)ch * 65536)); a += (f32x4){pg8::bf_lo(w.x), pg8::bf_hi(w.x), pg8::bf_lo(w.y), pg8::bf_hi(w.y)}; }
    return a;
}
__device__ __forceinline__ void rms_row_bf16(const float* xrow, const float* g, bf16* orow, float* hout, int lane, const float* SL = nullptr, float sc = 0.f, int m = 0) {
    f32x4 v[8]; float s = 0.f;
    const bool red = SL && m >= 8192;
#pragma unroll
    for (int j = 0; j < 8; ++j) {
        v[j] = xrow ? __builtin_nontemporal_load((const f32x4*)xrow + lane + 64 * j) : (f32x4){0.f, 0.f, 0.f, 0.f};
        if (red) v[j] += slab_sum(SL, m, j, lane) * sc;
        s += (v[j].x * v[j].x + v[j].y * v[j].y) + (v[j].z * v[j].z + v[j].w * v[j].w);
    }
    const float r = 1.0f / sqrtf(wave_sum(s) * (1.0f / DM) + EPS);
#pragma unroll
    for (int j = 0; j < 8; ++j) {
        if (hout) ((f32x4*)hout)[lane + 64 * j] = v[j];
        const f32x4 gg = ((const f32x4*)g)[lane + 64 * j];
        const unsigned lo = pk2(v[j].x * r * gg.x, v[j].y * r * gg.y), hi = pk2(v[j].z * r * gg.z, v[j].w * r * gg.w);
        ((unsigned long long*)orow)[lane + 64 * j] = (unsigned long long)lo | ((unsigned long long)hi << 32);
    }
}
__device__ __forceinline__ void load8_bf16(const bf16* p, float (&o)[8]) { const v4u w = *(const v4u*)p; o[0] = pg8::bf_lo(w.x); o[1] = pg8::bf_hi(w.x); o[2] = pg8::bf_lo(w.y); o[3] = pg8::bf_hi(w.y); o[4] = pg8::bf_lo(w.z); o[5] = pg8::bf_hi(w.z); o[6] = pg8::bf_lo(w.w); o[7] = pg8::bf_hi(w.w); }
__device__ __forceinline__ void load8_f32(const float* p, float (&o)[8]) { const f32x4 a = ((const f32x4*)p)[0], b = ((const f32x4*)p)[1]; o[0] = a.x; o[1] = a.y; o[2] = a.z; o[3] = a.w; o[4] = b.x; o[5] = b.y; o[6] = b.z; o[7] = b.w; }
__device__ __forceinline__ void store8_f32(float* p, const float (&o)[8]) { ((f32x4*)p)[0] = (f32x4){o[0], o[1], o[2], o[3]}; ((f32x4*)p)[1] = (f32x4){o[4], o[5], o[6], o[7]}; }


__device__ __forceinline__ void acc8_bf16(const v4u& w, float msk, float (&s)[8]) {
    s[0] += msk * pg8::bf_lo(w.x); s[1] += msk * pg8::bf_hi(w.x); s[2] += msk * pg8::bf_lo(w.y); s[3] += msk * pg8::bf_hi(w.y);
    s[4] += msk * pg8::bf_lo(w.z); s[5] += msk * pg8::bf_hi(w.z); s[6] += msk * pg8::bf_lo(w.w); s[7] += msk * pg8::bf_hi(w.w);
}
template <bool SMP>
__device__ __forceinline__ void p3b_row(const Args& a, int m, int lane, bf16* BG, const bf16* CV, const bf16* Z, bf16* PL) {
    int sq, t;
    if (SMP) { sq = (m - MP_ROWS) >> 3; t = (m - MP_ROWS) & 7; } else { sq = m / LP; t = m - sq * LP; }
    constexpr int L = SMP ? DECS : LP;
    const float* sc = a.state_conv + (size_t)sq * 2 * DM;
    const float* sp = a.state_pool + (size_t)sq * 15 * DPOOL;
    float* ncv = (t >= L - 2) ? a.out + (SMP ? O_NCS : O_NCP) + ((size_t)sq * 2 + (t - (L - 2))) * DM : nullptr;
    const float m1 = t >= 1 ? 1.f : 0.f, m2 = t >= 2 ? 1.f : 0.f;
    const int r1 = t >= 1 ? m - 1 : m, r2 = t >= 2 ? m - 2 : m;
#pragma unroll 2
    for (int j = 0; j < 4; ++j) {
        const int col = 512 * j + 8 * lane;
        float c0[8], c1[8], c2[8], bg[8], w0[8], w1[8], w2[8], o[8];
        load8_bf16(CV + (size_t)m * DM + col, c2); load8_bf16(CV + (size_t)r1 * DM + col, c1); load8_bf16(CV + (size_t)r2 * DM + col, c0);
        load8_bf16(BG + (size_t)m * DM + col, bg);
        load8_f32(a.conv_w + col, w0); load8_f32(a.conv_w + DM + col, w1); load8_f32(a.conv_w + 2 * DM + col, w2);
#pragma unroll
        for (int e = 0; e < 8; ++e) { c1[e] *= m1; c0[e] *= m2; }
        if (SMP) {
            float s1[8], s0[8];
            load8_f32(sc + (size_t)DM + col, s1); load8_f32(sc + (size_t)(t == 1 ? DM : 0) + col, s0);
#pragma unroll
            for (int e = 0; e < 8; ++e) { c1[e] += (1.f - m1) * s1[e]; c0[e] += (1.f - m2) * s0[e]; }
        }
#pragma unroll
        for (int e = 0; e < 8; ++e) o[e] = bg[e] * (w0[e] * c0[e] + w1[e] * c1[e] + w2[e] * c2[e]);
        v4u w; w.x = pk2(o[0], o[1]); w.y = pk2(o[2], o[3]); w.z = pk2(o[4], o[5]); w.w = pk2(o[6], o[7]);
        *(v4u*)(BG + (size_t)m * DM + col) = w;
        if (ncv) store8_f32(ncv + col, c2);
    }
    float* npp = nullptr;
    if (SMP) npp = a.out + O_NPS + ((size_t)sq * 15 + 7 + t) * DPOOL; else if (t >= L - 15) npp = a.out + O_NPP + ((size_t)sq * 15 + (t - (L - 15))) * DPOOL;
#pragma unroll
    for (int j = 0; j < 2; ++j) {
        const int col = 512 * j + 8 * lane, gq = col >> 8, k = 2 << gq;
        float z0[8], s[8];
        load8_bf16(Z + (size_t)m * DPOOL + col, z0);
#pragma unroll
        for (int e = 0; e < 8; ++e) s[e] = z0[e];
        if (j == 0) {
#pragma unroll
            for (int i = 1; i < 4; ++i) { const bool in = t - i >= 0; const v4u w = *(const v4u*)(Z + (size_t)(in ? m - i : m) * DPOOL + col); acc8_bf16(w, (in && i < k) ? 1.f : 0.f, s); }
            if (SMP) {
#pragma unroll
                for (int i = 1; i < 4; ++i) { const bool st = t - i < 0; float q[8]; load8_f32(sp + (size_t)(st ? 15 + t - i : 0) * DPOOL + col, q); const float mk = (st && i < k) ? 1.f : 0.f;
#pragma unroll
                    for (int e = 0; e < 8; ++e) s[e] += mk * q[e]; }
            }
        } else {
#pragma unroll
            for (int i = 1; i < 16; ++i) { const bool in = t - i >= 0; const v4u w = *(const v4u*)(Z + (size_t)(in ? m - i : m) * DPOOL + col); acc8_bf16(w, (in && i < k) ? 1.f : 0.f, s); }
            if (SMP) {
#pragma unroll
                for (int i = 1; i < 16; ++i) { const bool st = t - i < 0; float q[8]; load8_f32(sp + (size_t)(st ? 15 + t - i : 0) * DPOOL + col, q); const float mk = (st && i < k) ? 1.f : 0.f;
#pragma unroll
                    for (int e = 0; e < 8; ++e) s[e] += mk * q[e]; }
            }
        }
        const int cnt = SMP ? k : (k < t + 1 ? k : t + 1);
        const float inv = 1.0f / (float)cnt;
        float o[8];
#pragma unroll
        for (int e = 0; e < 8; ++e) o[e] = s[e] * inv - z0[e];
        v4u w; w.x = pk2(o[0], o[1]); w.y = pk2(o[2], o[3]); w.z = pk2(o[4], o[5]); w.w = pk2(o[6], o[7]);
        *(v4u*)(PL + (size_t)m * DPOOL + col) = w;
        if (npp) store8_f32(npp + col, z0);
        if (SMP && t < 7) { float q[8]; load8_f32(sp + (size_t)(8 + t) * DPOOL + col, q); store8_f32(a.out + O_NPS + ((size_t)sq * 15 + t) * DPOOL + col, q); }
    }
}

constexpr int NI_GU = (DM / 64) * (DFF / 64), NI_D = (DFF / 64) * (DM / 64), NI_IN = (DM / 64) * (DIN / 64), NI_SQ = (DM / 64) * (DM / 64), NI_PG = (256 / 64) * (512 / 64);
constexpr int IT_W1G = 0, IT_W1D = 2 * NI_GU, IT_WCO = IT_W1D + NI_D + NI_IN, IT_W2G = IT_WCO + 2 * NI_SQ + 4 * NI_PG, IT_W2D = IT_W2G + 2 * NI_GU, IT_END = IT_W2D + NI_D;
__device__ __forceinline__ void convert_items(const Args& a, unsigned char* ws, int it_lo, int it_hi, int widx, int nw, LAS unsigned char* lds, int wave, int lane) {
    LAS float* scr = (LAS float*)(lds + wave * 16640);
    bf16 *W1GU = (bf16*)(ws + WS_W1GU), *W1D = (bf16*)(ws + WS_W1D), *WIN = (bf16*)(ws + WS_WIN), *WCO = (bf16*)(ws + WS_WCO), *WPG = (bf16*)(ws + WS_WPG), *WO = (bf16*)(ws + WS_WO),
         *W2GU = (bf16*)(ws + WS_W2GU), *W2D = (bf16*)(ws + WS_W2D);
    for (int it = it_lo + widx; it < it_hi; it += nw) {
        int r = it;
        if (p0_job(r, a.w1g, DM, DFF, W1GU, 1, 0, scr, lane)) continue;
        if (p0_job(r, a.w1u, DM, DFF, W1GU, 2, 0, scr, lane)) continue;
        if (p0_job(r, a.w1d, DFF, DM, W1D, 0, 0, scr, lane)) continue;
        if (p0_job(r, a.w_in, DM, DIN, WIN, 3, 0, scr, lane)) continue;
        if (p0_job(r, a.w_conv_out, DM, DM, WCO, 0, 0, scr, lane)) continue;
        if (p0_job(r, a.w_o, DM, DM, WO, 0, 0, scr, lane)) continue;
        if (p0_job(r, a.w_pool + 0 * 256 * 512, 256, 512, WPG, 0, 0, scr, lane)) continue;
        if (p0_job(r, a.w_pool + 1 * 256 * 512, 256, 512, WPG, 0, 512, scr, lane)) continue;
        if (p0_job(r, a.w_pool + 2 * 256 * 512, 256, 512, WPG, 0, 1024, scr, lane)) continue;
        if (p0_job(r, a.w_pool + 3 * 256 * 512, 256, 512, WPG, 0, 1536, scr, lane)) continue;
        if (p0_job(r, a.w2g, DM, DFF, W2GU, 1, 0, scr, lane)) continue;
        if (p0_job(r, a.w2u, DM, DFF, W2GU, 2, 0, scr, lane)) continue;
        p0_job(r, a.w2d, DFF, DM, W2D, 0, 0, scr, lane);
    }
}

#define XB_TMO      128
#define XB_XCNT(j)  (256  + 64 * (j))
#define XB_XSUB(j)  (1280 + 64 * (j))
#define XB_XGEN(j)  (2304 + 64 * (j))
#define XB_TOP      3328
#define XB_TOPGEN   3392
#define XCD_BAR_WORDS 3456
#define XB_SPIN_CAP (1u << 18)

__device__ __forceinline__ unsigned xb_ld(unsigned* p)              { return __hip_atomic_load(p, __ATOMIC_RELAXED, __HIP_MEMORY_SCOPE_AGENT); }
__device__ __forceinline__ unsigned xb_add(unsigned* p, unsigned v) { return __hip_atomic_fetch_add(p, v, __ATOMIC_RELAXED, __HIP_MEMORY_SCOPE_AGENT); }
__device__ __forceinline__ unsigned xb_xcc_id() { return (unsigned)__builtin_amdgcn_s_getreg((3 << 11) | 20) & 0xFu; }
#define XB_SPIN(cond, bar) do { unsigned _sp = 0; while (cond) { __builtin_amdgcn_s_sleep(1); \
    if ((++_sp & 255u) == 0u) { if (xb_ld(&(bar)[XB_TMO])) break; if (_sp > XB_SPIN_CAP) { atomicAdd(&(bar)[XB_TMO], 1u); break; } } } } while (0)

struct XcdBarrier {
    unsigned* bar; unsigned x;
    volatile LAS unsigned* st;
};

__device__ __forceinline__ XcdBarrier xcd_barrier_post(unsigned* bar, volatile LAS unsigned* st) {
    XcdBarrier b; b.bar = bar; b.x = xb_xcc_id(); b.st = st;
    if (threadIdx.x == 0) (void)xb_add(&bar[XB_XCNT(b.x)], 1u);
    return b;
}
__device__ __forceinline__ void xcd_barrier_complete(unsigned* bar, unsigned x, unsigned& nloc, unsigned& nx) {
    const unsigned G = gridDim.x * gridDim.y * gridDim.z;
    unsigned sum, cnt, mine, sp = 0u;
    for (;;) {
        sum = 0u; cnt = 0u; mine = 0u;
#pragma unroll
        for (unsigned j = 0; j < 16; ++j) { const unsigned c = xb_ld(&bar[XB_XCNT(j)]); sum += c; cnt += (c > 0u) ? 1u : 0u; mine = (j == x) ? c : mine; }
        if (sum == G) break;
        __builtin_amdgcn_s_sleep(1);
        if ((++sp & 255u) == 0u) { if (xb_ld(&bar[XB_TMO])) break; if (sp > XB_SPIN_CAP) { atomicAdd(&bar[XB_TMO], 1u); break; } }
    }
    nloc = mine > 0u ? mine : 1u; nx = cnt > 0u ? cnt : 1u;
}

__device__ __forceinline__ void xcd_barrier(const XcdBarrier& b) {
    asm volatile("s_waitcnt vmcnt(0)" ::: "memory");
    __syncthreads();
    if (threadIdx.x == 0) {
        unsigned* bar = b.bar;
        __builtin_amdgcn_s_waitcnt(0);
        unsigned nloc = b.st[0], nx = b.st[1];
        if (nloc == 0u) { xcd_barrier_complete(bar, b.x, nloc, nx); b.st[0] = nloc; b.st[1] = nx; }
        const unsigned old = xb_add(&bar[XB_XSUB(b.x)], 1u);
        const unsigned gen = old / nloc;
        if (old + 1u == (gen + 1u) * nloc) {
            __builtin_amdgcn_fence(__ATOMIC_RELEASE, "agent");
            asm volatile("s_waitcnt vmcnt(0)" ::: "memory");
            const unsigned og = xb_add(&bar[XB_TOP], 1u);
            const unsigned tg = og / nx;
            if (og + 1u == (tg + 1u) * nx) xb_add(&bar[XB_TOPGEN], 1u);
            else XB_SPIN(xb_ld(&bar[XB_TOPGEN]) == tg, bar);
            __builtin_amdgcn_fence(__ATOMIC_ACQUIRE, "agent");
            xb_add(&bar[XB_XGEN(b.x)], 1u);
            asm volatile("s_waitcnt vmcnt(0)" ::: "memory");
        } else {
            XB_SPIN(xb_ld(&bar[XB_XGEN(b.x)]) == gen, bar);
            __builtin_amdgcn_fence(__ATOMIC_ACQUIRE, "agent");
            asm volatile("s_waitcnt vmcnt(0)" ::: "memory");
        }
    }
    __syncthreads();
}

__global__ void __launch_bounds__(NWAVES * 64) fwd_megakernel(Args a) {
    extern __shared__ __attribute__((aligned(16))) unsigned char lds_raw[];
    cg::grid_group grid = cg::this_grid();
    LAS unsigned char* lds = (LAS unsigned char*)lds_raw;
    const int tid = threadIdx.x, lane = tid & 63, wave = __builtin_amdgcn_readfirstlane(tid >> 6);
    const int G = gridDim.x, bx = blockIdx.x;
    const int gw = bx * NWAVES + wave, NGW = G * NWAVES;
#define FOR_ROWS(m, total) for (int it_ = 0, m = gw; (it_ < 4) || ((m = 8192 + bx + G * (wave + NWAVES * (it_ - 4))) < (total)); ++it_, m = gw + it_ * NGW)
    unsigned char* ws = a.ws;
    bf16 *W1GU = (bf16*)(ws + WS_W1GU), *W1D = (bf16*)(ws + WS_W1D), *WIN = (bf16*)(ws + WS_WIN), *WCO = (bf16*)(ws + WS_WCO), *WPG = (bf16*)(ws + WS_WPG), *WO = (bf16*)(ws + WS_WO),
         *W2GU = (bf16*)(ws + WS_W2GU), *W2D = (bf16*)(ws + WS_W2D);
    float* H = (float*)(ws + WS_H);
    bf16 *ACT = (bf16*)(ws + WS_R), *BG = (bf16*)(ws + WS_BG), *CV = (bf16*)(ws + WS_CV), *SGC = (bf16*)(ws + WS_SGC), *SGP = (bf16*)(ws + WS_SGP), *Z = (bf16*)(ws + WS_Z), *PL = (bf16*)(ws + WS_PL);
    bf16 *XN1 = (bf16*)(ws + WS_XN1), *XN = (bf16*)(ws + WS_W1GU);
    float* SLAB = (float*)(ws + WS_SGP);
    volatile LAS unsigned* MISC = (volatile LAS unsigned*)(lds + LDS_BYTES - 128);
    if (tid < 32) MISC[tid] = 0u;
    unsigned* barw = (unsigned*)ws;
    if (bx == 0) for (int i = tid; i < XCD_BAR_WORDS; i += NWAVES * 64) __hip_atomic_store(barw + i, 0u, __ATOMIC_RELAXED, __HIP_MEMORY_SCOPE_AGENT);
    __syncthreads();

    {
        convert_items(a, ws, IT_W1G, IT_W1D, gw, NGW, lds, wave, lane);
        for (int m = gw; m < MPAD; m += NGW) rms_row_bf16(src_row(a, m), a.norm_ffn1, XN1 + (size_t)m * DM, nullptr, lane);
    }
    grid.sync();
    const XcdBarrier bar = xcd_barrier_post(barw, MISC + 8);

    {
        pg8::Gemm g{XN1, W1GU, MPAD, 2 * DFF, DM, DM, DM, 0}; pg8::StaticOrder S; S.init(MPAD, 2 * DFF, DM, G, bx);
        pg8::EpiSwiglu E{ACT, DFF};
        pg8::gemm_phase<pg8::EpiSwiglu, pg8::StaticOrder, true, true>(lds, g, S, E);
        constexpr int FULL = (MPAD / 256) * (2 * DFF / 256) % 256;
        if (bx >= FULL) convert_items(a, ws, IT_W1D, IT_WCO, (bx - FULL) * NWAVES + wave, (G - FULL) * NWAVES, lds, wave, lane);
    }
    xcd_barrier(bar);
    {
        pg8::Gemm g{ACT, W1D, MPAD, DM, DFF, DFF, DFF, 0}; pg8::TailOrder S; S.init(DFF, bx);
        pg8::EpiResid<true> E{H, DM, 0.5f, SLAB, a.x_prompt, a.x_sample, a.meta};
        pg8::gemm_phase<pg8::EpiResid<true>, pg8::TailOrder, true, true>(lds, g, S, E);
    }
    xcd_barrier(bar);
    FOR_ROWS(m, MPAD) { float* hr = H + (size_t)m * DM; if (m < 8192) rms_row_bf16(hr, a.norm_mix, XN + (size_t)m * DM, nullptr, lane); else rms_row_bf16(src_row(a, m), a.norm_mix, XN + (size_t)m * DM, hr, lane, SLAB, 0.5f, m); }
    xcd_barrier(bar);
    {
        pg8::Gemm g{XN, WIN, MPAD, DIN, DM, DM, DM, 0}; pg8::StaticOrder S; S.init(MPAD, DIN, DM, G, bx);
        pg8::EpiProj E{BG, CV, Z, SGC, SGP};
        pg8::gemm_phase<pg8::EpiProj, pg8::StaticOrder, true, true>(lds, g, S, E);
        constexpr int FULL = (MPAD / 256) * (DIN / 256) % 256;
        if (bx >= FULL) convert_items(a, ws, IT_WCO, IT_W2G, (bx - FULL) * NWAVES + wave, (G - FULL) * NWAVES, lds, wave, lane);
    }
    xcd_barrier(bar);
    FOR_ROWS(m, MREAL) {
        if (m >= MP_ROWS) p3b_row<true>(a, m, lane, BG, CV, Z, PL); else p3b_row<false>(a, m, lane, BG, CV, Z, PL);
    }
    xcd_barrier(bar);
    {
        pg8::Gemm g{PL, WPG, MPAD, DM, 256, DPOOL, 256, 1}; pg8::StaticOrder S; S.init(MPAD, DM, 256, G, bx);
        pg8::EpiPool E{SGP, a.pool_scale};
        pg8::gemm_phase<pg8::EpiPool, pg8::StaticOrder, true, true>(lds, g, S, E);
    }
    __syncthreads();
    {
        pg8::Gemm g{BG, WCO, MPAD, DM, DM, DM, DM, 0}; pg8::StaticOrder S; S.init(MPAD, DM, DM, G, bx);
        pg8::EpiMerge E{SGC, SGP};
        pg8::gemm_phase<pg8::EpiMerge, pg8::StaticOrder, true, true>(lds, g, S, E);
        constexpr int FULL = (MPAD / 256) * (DM / 256) % 256;
        if (bx >= FULL) convert_items(a, ws, IT_W2G, IT_W2D, (bx - FULL) * NWAVES + wave, (G - FULL) * NWAVES, lds, wave, lane);
    }
    xcd_barrier(bar);
    {
        pg8::Gemm g{SGC, WO, MPAD, DM, DM, DM, DM, 0}; pg8::TailOrder S; S.init(DM, bx);
        pg8::EpiResid<false> E{H, DM, 1.0f, SLAB, nullptr, nullptr, nullptr};
        pg8::gemm_phase<pg8::EpiResid<false>, pg8::TailOrder, true, true>(lds, g, S, E);
    }
    xcd_barrier(bar);
    FOR_ROWS(m, MPAD) { float* hr = H + (size_t)m * DM; if (m < 8192) rms_row_bf16(hr, a.norm_ffn2, XN + (size_t)m * DM, nullptr, lane); else rms_row_bf16(hr, a.norm_ffn2, XN + (size_t)m * DM, hr, lane, SLAB, 1.0f, m); }
    xcd_barrier(bar);
    {
        pg8::Gemm g{XN, W2GU, MPAD, 2 * DFF, DM, DM, DM, 0}; pg8::StaticOrder S; S.init(MPAD, 2 * DFF, DM, G, bx);
        pg8::EpiSwiglu E{ACT, DFF};
        pg8::gemm_phase<pg8::EpiSwiglu, pg8::StaticOrder, true, true>(lds, g, S, E);
        constexpr int FULL = (MPAD / 256) * (2 * DFF / 256) % 256;
        if (bx >= FULL) convert_items(a, ws, IT_W2D, IT_END, (bx - FULL) * NWAVES + wave, (G - FULL) * NWAVES, lds, wave, lane);
    }
    xcd_barrier(bar);
    {
        pg8::Gemm g{ACT, W2D, MPAD, DM, DFF, DFF, DFF, 0}; pg8::TailOrder S; S.init(DFF, bx);
        pg8::EpiResid<false> E{H, DM, 0.5f, SLAB, nullptr, nullptr, nullptr};
        pg8::gemm_phase<pg8::EpiResid<false>, pg8::TailOrder, true, true>(lds, g, S, E);
    }
    xcd_barrier(bar);
    FOR_ROWS(m, MREAL) {
        float* dst;
        if (m < MP_ROWS) { const int b = m / LP, t = m - b * LP; if (t < NMETA) continue; dst = a.out + O_YP + ((size_t)b * SEQ + (t - NMETA)) * DM; }
        else dst = a.out + O_YS + (size_t)(m - MP_ROWS) * DM;
        const float* hr = H + (size_t)m * DM;
        f32x4 v[8]; float s = 0.f;
#pragma unroll
        for (int j = 0; j < 8; ++j) { v[j] = __builtin_nontemporal_load((const f32x4*)hr + lane + 64 * j); if (m >= 8192) v[j] += slab_sum(SLAB, m, j, lane) * 0.5f; s += (v[j].x * v[j].x + v[j].y * v[j].y) + (v[j].z * v[j].z + v[j].w * v[j].w); }
        const float r = 1.0f / sqrtf(wave_sum(s) * (1.0f / DM) + EPS);
#pragma unroll
        for (int j = 0; j < 8; ++j) { const f32x4 gg = ((const f32x4*)a.norm_final)[lane + 64 * j]; __builtin_nontemporal_store(v[j] * r * gg, (f32x4*)dst + lane + 64 * j); }
    }
}

extern "C" void kernel_launch(void* const* d_in, const int* in_sizes, int n_in, void* d_out, int out_size, void* d_ws, size_t ws_size, hipStream_t stream) {
    static int grid = 0;
    if (grid == 0) {
        if (n_in != 21 || (size_t)out_size != O_END || ws_size < WS_END) { fprintf(stderr, "kernel_launch: unexpected shapes: n_in %d out %d ws %zu (need %zu)\n", n_in, out_size, ws_size, (size_t)WS_END); grid = -1; return; }
        int dev = 0, cus = 0, per_cu = 0;
        hipGetDevice(&dev); hipDeviceGetAttribute(&cus, hipDeviceAttributeMultiprocessorCount, dev);
        if (hipFuncSetAttribute((const void*)fwd_megakernel, hipFuncAttributeMaxDynamicSharedMemorySize, LDS_BYTES) != hipSuccess) { fprintf(stderr, "kernel_launch: hipFuncSetAttribute failed\n"); grid = -1; return; }
        if (hipOccupancyMaxActiveBlocksPerMultiprocessor(&per_cu, (const void*)fwd_megakernel, NWAVES * 64, LDS_BYTES) != hipSuccess || per_cu < 1) { fprintf(stderr, "kernel_launch: occupancy query failed (%d)\n", per_cu); (void)hipGetLastError(); per_cu = 1; }
        grid = cus * 1;
        fprintf(stderr, "kernel_launch: grid %d (cus %d, per_cu %d)\n", grid, cus, per_cu);
    }
    if (grid < 0) return;
    Args a{};
    a.x_prompt = (const float*)d_in[0]; a.x_sample = (const float*)d_in[1]; a.state_conv = (const float*)d_in[2]; a.state_pool = (const float*)d_in[3]; a.meta = (const float*)d_in[4];
    a.norm_ffn1 = (const float*)d_in[5]; a.w1g = (const float*)d_in[6]; a.w1u = (const float*)d_in[7]; a.w1d = (const float*)d_in[8]; a.norm_mix = (const float*)d_in[9]; a.w_in = (const float*)d_in[10];
    a.conv_w = (const float*)d_in[11]; a.w_conv_out = (const float*)d_in[12]; a.w_pool = (const float*)d_in[13]; a.pool_scale = (const float*)d_in[14]; a.w_o = (const float*)d_in[15];
    a.norm_ffn2 = (const float*)d_in[16]; a.w2g = (const float*)d_in[17]; a.w2u = (const float*)d_in[18]; a.w2d = (const float*)d_in[19]; a.norm_final = (const float*)d_in[20];
    a.out = (float*)d_out; a.ws = (unsigned char*)d_ws;
    void* args[] = {&a};
    hipError_t e = hipLaunchCooperativeKernel((const void*)fwd_megakernel, dim3(grid), dim3(NWAVES * 64), args, LDS_BYTES, stream);
    if (e != hipSuccess) fprintf(stderr, "kernel_launch: cooperative launch failed: %s (grid %d)\n", hipGetErrorString(e), grid);
}
```
